# Optimizing an MI355X kernel written in HIP

```python
import jax, jax.numpy as jnp
from jax import lax
import numpy as np

D_MODEL = 1024
BATCH = 16
SEQ = 256
DEPTH = 1
DEC_BATCH = 2
DEC_SEQ = 2048
PAST_LEN = 256

GRID_W = 64
N_DIR = 2
RWKV_HEADS = 8
RWKV_HEAD_DIM = 64
RWKV_WIDTH = RWKV_HEADS * RWKV_HEAD_DIM
DECAY_LORA = 64
ICLR_LORA = 64
GATE_LORA = 128
MLSTM_HEADS = 4
MLSTM_HEAD_DIM = 128
MLSTM_WIDTH = MLSTM_HEADS * MLSTM_HEAD_DIM
MLSTM_CHUNK = 64
D_FF = 2816
RMS_EPS = 1e-6
RWKV_GN_EPS = 64e-5
MLSTM_GN_EPS = 1e-5
DECAY_SCALE = 0.606531

RWKV_COLS = 3 * RWKV_WIDTH + N_DIR * DECAY_LORA + N_DIR * ICLR_LORA + GATE_LORA
MLSTM_COLS = 4 * MLSTM_WIDTH + 2 * N_DIR * MLSTM_HEADS
GATE_COLS = 2 * D_MODEL
IN_COLS = RWKV_COLS + MLSTM_COLS + GATE_COLS

kernel_name = 'bidir_rwkv7_mlstm_prefix_dit_step'


def rmsnorm(x, g):
    x32 = x.astype(jnp.float32)
    y = x32 * lax.rsqrt(jnp.mean(x32 * x32, axis=-1, keepdims=True) + RMS_EPS)
    return (y * g.astype(jnp.float32)).astype(x.dtype)


def centred_shift(z, mu):
    zp = jnp.pad(z, ((0, 0), (1, 1), (0, 0)))
    return z + mu * (0.5 * (zp[:, :-2] + zp[:, 2:]) - z)


def dwconv_grid(x, w, rows):
    b, t, ch = x.shape
    img = x.reshape(b, rows, t // rows, ch)
    out = lax.conv_general_dilated(img, w[:, :, None, :].astype(x.dtype), (1, 1), 'SAME',
                                   dimension_numbers=('NHWC', 'HWIO', 'NHWC'),
                                   feature_group_count=ch)
    return out.reshape(b, t, ch)


def flip_backward(x, dir_axis, time_axis):
    fwd = jnp.take(x, 0, axis=dir_axis)
    bwd = jnp.take(x, 1, axis=dir_axis)
    t_ax = time_axis - 1 if time_axis > dir_axis else time_axis
    return jnp.stack([fwd, jnp.flip(bwd, axis=t_ax)], axis=dir_axis)


def rwkv7_bidir(z, S0, w0, w_up, a0, a_up, g_up, kk_scale, k_a, r_k, lnx_g, lnx_b):
    f32 = jnp.float32
    z = z.astype(f32)
    B, T, _ = z.shape
    H, N = RWKV_HEADS, RWKV_HEAD_DIM
    o1 = RWKV_WIDTH
    o2 = 2 * RWKV_WIDTH
    o3 = 3 * RWKV_WIDTH
    o4 = o3 + N_DIR * DECAY_LORA
    o5 = o4 + N_DIR * ICLR_LORA
    r, k, v, wd, ad, gd = jnp.split(z, [o1, o2, o3, o4, o5], axis=-1)
    wd = wd.reshape(B, T, N_DIR, DECAY_LORA)
    ad = ad.reshape(B, T, N_DIR, ICLR_LORA)
    decay = jnp.exp(-DECAY_SCALE * jax.nn.sigmoid(w0 + jnp.einsum('btdr,drc->btdc', jnp.tanh(wd), w_up)))
    a = jax.nn.sigmoid(a0 + jnp.einsum('btdr,drc->btdc', ad, a_up))
    g = jax.nn.sigmoid(gd) @ g_up
    kk = (k * kk_scale).reshape(B, T, H, N)
    kk = kk / jnp.maximum(jnp.linalg.norm(kk, axis=-1, keepdims=True), 1e-12)
    k_dir = k[:, :, None, :] * (1.0 + (a - 1.0) * k_a)

    def shared(u):
        return jnp.broadcast_to(u[:, :, None, :], (B, T, N_DIR, u.shape[-1]))

    def per_dir(u):
        return jnp.moveaxis(flip_backward(u.reshape(B, T, N_DIR, H, N), 2, 1), 1, 0)

    xs = (per_dir(shared(r)), per_dir(decay), per_dir(k_dir), per_dir(shared(v)),
          per_dir(shared(kk.reshape(B, T, RWKV_WIDTH))), per_dir(a))

    def step(S, inp):
        r_t, w_t, k_t, v_t, kk_t, a_t = inp
        removed = jnp.einsum('bdhvk,bdhk->bdhv', S, kk_t)
        S = (S * w_t[..., None, :] - removed[..., :, None] * (kk_t * a_t)[..., None, :]
             + v_t[..., :, None] * k_t[..., None, :])
        return S, jnp.einsum('bdhvk,bdhk->bdhv', S, r_t)

    S_fin, ys = lax.scan(step, S0.astype(f32), xs)
    ys = flip_backward(jnp.moveaxis(ys, 0, 1), 2, 1).sum(axis=2)
    mean = jnp.mean(ys, axis=-1, keepdims=True)
    var = jnp.var(ys, axis=-1, keepdims=True)
    y = ((ys - mean) * lax.rsqrt(var + RWKV_GN_EPS)).reshape(B, T, RWKV_WIDTH) * lnx_g + lnx_b
    bonus = (jnp.einsum('bthn,btdhn,hn->bth', r.reshape(B, T, H, N),
                        k_dir.reshape(B, T, N_DIR, H, N), r_k)[..., None]
             * v.reshape(B, T, H, N))
    return (y + bonus.reshape(B, T, RWKV_WIDTH)) * g, S_fin


def mlstm_chunkwise(q, k, v, log_i, log_f, C0, n0, m0):
    T = q.shape[-2]
    L = MLSTM_CHUNK
    nc = T // L
    lead = q.shape[:-2]
    mask = jnp.tril(jnp.ones((L, L), dtype=bool))

    def chunk(u):
        return jnp.moveaxis(u.reshape(u.shape[:-2] + (nc, L, u.shape[-1])), -3, 0)

    def chunk_g(u):
        return jnp.moveaxis(u.reshape(u.shape[:-1] + (nc, L)), -2, 0)

    def step(carry, inp):
        C, n, m = carry
        qc, kc, vc, ic, fc = inp
        b = jnp.cumsum(fc, axis=-1)
        log_d = jnp.where(mask, b[..., :, None] - b[..., None, :] + ic[..., None, :], -jnp.inf)
        log_inter = b + m[..., None]
        m_s = jnp.maximum(log_inter, jnp.max(log_d, axis=-1))
        dmat = jnp.exp(log_d - m_s[..., None])
        inter = jnp.exp(log_inter - m_s)
        s = jnp.einsum('...sk,...jk->...sj', qc, kc) * dmat
        num = (inter[..., None] * jnp.einsum('...sk,...vk->...sv', qc, C)
               + jnp.einsum('...sj,...jv->...sv', s, vc))
        den = inter * jnp.einsum('...sk,...k->...s', qc, n) + jnp.sum(s, axis=-1)
        h = num / jnp.maximum(jnp.abs(den), jnp.exp(-m_s))[..., None]
        bL = b[..., -1]
        log_w = bL[..., None] - b + ic
        m_new = jnp.maximum(bL + m, jnp.max(log_w, axis=-1))
        wj = jnp.exp(log_w - m_new[..., None])
        carry_decay = jnp.exp(bL + m - m_new)
        C_new = carry_decay[..., None, None] * C + jnp.einsum('...j,...jv,...jk->...vk', wj, vc, kc)
        n_new = carry_decay[..., None] * n + jnp.einsum('...j,...jk->...k', wj, kc)
        return (C_new, n_new, m_new), h

    (C, n, m), hs = lax.scan(step, (C0, n0, m0),
                             (chunk(q), chunk(k), chunk(v), chunk_g(log_i), chunk_g(log_f)))
    h = jnp.moveaxis(hs, 0, -3).reshape(lead + (T, v.shape[-1]))
    return h, C, n, m


def mlstm_bidir(z, C0, n0, m0, rows, conv_w, gate_b, gn_g):
    f32 = jnp.float32
    B, T, _ = z.shape
    H, dh, W = MLSTM_HEADS, MLSTM_HEAD_DIM, MLSTM_WIDTH
    qk, v, o, gates = jnp.split(z, [2 * W, 3 * W, 4 * W], axis=-1)
    qk = jax.nn.silu(dwconv_grid(qk, conv_w, rows)).astype(f32)
    q, k = jnp.split(qk, 2, axis=-1)

    def heads(u):
        u = u.astype(f32).reshape(B, T, H, dh).transpose(0, 2, 1, 3)
        return flip_backward(jnp.broadcast_to(u[:, None], (B, N_DIR, H, T, dh)), 1, 3)

    gates = gates.astype(f32).reshape(B, T, 2, N_DIR, H) + gate_b
    gates = jnp.transpose(gates, (0, 2, 3, 4, 1))
    log_i = flip_backward(gates[:, 0], 1, 3)
    log_f = flip_backward(jax.nn.log_sigmoid(gates[:, 1]), 1, 3)
    h, C, n, m = mlstm_chunkwise(heads(q * dh ** -0.5), heads(k), heads(v), log_i, log_f,
                                 C0.astype(f32), n0.astype(f32), m0.astype(f32))
    h = flip_backward(h, 1, 3).sum(axis=1)
    mean = jnp.mean(h, axis=-1, keepdims=True)
    var = jnp.var(h, axis=-1, keepdims=True)
    h = ((h - mean) * lax.rsqrt(var + MLSTM_GN_EPS)).transpose(0, 2, 1, 3).reshape(B, T, W) * gn_g
    return h * jax.nn.sigmoid(o.astype(f32)), (C, n, m)


def trunk_layer(x, cond, rows, states, p):
    mod = (jax.nn.silu(cond) @ p['ada_w'] + p['ada_b'])[:, None, :]
    sh1, sc1, g1, sh2, sc2, g2 = jnp.split(mod, 6, axis=-1)
    h = rmsnorm(x, p['norm_g'][0]) * (1.0 + sc1) + sh1
    z = h @ p['w_in']
    z_r, z_m, z_g = jnp.split(z, [RWKV_COLS, RWKV_COLS + MLSTM_COLS], axis=-1)
    S0, C0, n0, m0 = states
    y_r, S = rwkv7_bidir(centred_shift(z_r, p['rwkv_mu']), S0, p['rwkv_w0'], p['rwkv_w_up'],
                         p['rwkv_a0'], p['rwkv_a_up'], p['rwkv_g_up'], p['rwkv_kk_scale'],
                         p['rwkv_k_a'], p['rwkv_r_k'], p['rwkv_lnx_g'], p['rwkv_lnx_b'])
    y_m, (C, n, m) = mlstm_bidir(z_m, C0, n0, m0, rows, p['mlstm_conv'], p['mlstm_gate_b'],
                                 p['mlstm_gn_g'])
    gate_r, gate_m = jnp.split(jax.nn.sigmoid(z_g), 2, axis=-1)
    merged = (gate_r * (y_r.astype(x.dtype) @ p['w_branch_rwkv'])
              + gate_m * (y_m.astype(x.dtype) @ p['w_branch_mlstm']))
    x = x + g1 * rmsnorm(merged @ p['w_out'], p['norm_g'][1])
    h = rmsnorm(x, p['norm_g'][2]) * (1.0 + sc2) + sh2
    u_act, u_val = jnp.split(h @ p['ffn_up'], 2, axis=-1)
    u_act = dwconv_grid(u_act, p['ffn_conv'], rows) + p['ffn_conv_b']
    f = (jax.nn.silu(u_act) * u_val) @ p['ffn_down']
    x = x + g2 * rmsnorm(f, p['norm_g'][3])
    return x, (S, C, n, m)


def setup_inputs(seed: int = 0) -> dict:
    key = jax.random.key(seed)
    ks = iter(jax.random.split(key, 40))
    f32 = jnp.float32

    def nrm(shape, scale):
        return jax.random.normal(next(ks), shape, f32) * scale

    L, D, H, N = DEPTH, D_MODEL, RWKV_HEADS, RWKV_HEAD_DIM
    MH, dh = MLSTM_HEADS, MLSTM_HEAD_DIM
    return {
        'x_prompt': nrm((BATCH, SEQ, D), 1.0),
        'x_sample': nrm((DEC_BATCH, DEC_SEQ, D), 1.0),
        'c': nrm((DEC_BATCH, D), 1.0),
        'state_rwkv': nrm((DEC_BATCH, L, N_DIR, H, N, N), 0.3),
        'state_mlstm_C': nrm((DEC_BATCH, L, N_DIR, MH, dh, dh), 0.1),
        'state_mlstm_n': nrm((DEC_BATCH, L, N_DIR, MH, dh), 0.5),
        'state_mlstm_m': nrm((DEC_BATCH, L, N_DIR, MH), 1.0),
        'c_ctx': nrm((D,), 1.0),
        'ada_w': nrm((L, D, 6 * D), 0.5 * D ** -0.5),
        'ada_b': nrm((L, 6 * D), 0.02),
        'norm_g': 1.0 + nrm((L, 4, D), 0.02),
        'w_in': nrm((L, D, IN_COLS), D ** -0.5),
        'rwkv_mu': jax.random.uniform(next(ks), (L, RWKV_COLS), f32),
        'rwkv_w0': nrm((L, N_DIR, RWKV_WIDTH), 1.0),
        'rwkv_w_up': nrm((L, N_DIR, DECAY_LORA, RWKV_WIDTH), 0.1),
        'rwkv_a0': nrm((L, N_DIR, RWKV_WIDTH), 0.5),
        'rwkv_a_up': nrm((L, N_DIR, ICLR_LORA, RWKV_WIDTH), 0.1),
        'rwkv_g_up': nrm((L, GATE_LORA, RWKV_WIDTH), GATE_LORA ** -0.5),
        'rwkv_kk_scale': 0.85 + nrm((L, RWKV_WIDTH), 0.02),
        'rwkv_k_a': 1.0 + nrm((L, RWKV_WIDTH), 0.02),
        'rwkv_r_k': nrm((L, H, N), 0.1),
        'rwkv_lnx_g': 1.0 + nrm((L, RWKV_WIDTH), 0.02),
        'rwkv_lnx_b': nrm((L, RWKV_WIDTH), 0.02),
        'mlstm_conv': nrm((L, 3, 3, 2 * MLSTM_WIDTH), 1.0 / 3.0),
        'mlstm_gate_b': jnp.stack([nrm((L, N_DIR, MH), 0.1), 3.0 + nrm((L, N_DIR, MH), 0.5)], axis=1),
        'mlstm_gn_g': 1.0 + nrm((L, MLSTM_WIDTH), 0.02),
        'w_branch_rwkv': nrm((L, RWKV_WIDTH, D), RWKV_WIDTH ** -0.5),
        'w_branch_mlstm': nrm((L, MLSTM_WIDTH, D), MLSTM_WIDTH ** -0.5),
        'w_out': nrm((L, D, D), D ** -0.5),
        'ffn_up': nrm((L, D, 2 * D_FF), D ** -0.5),
        'ffn_conv': nrm((L, 3, 3, D_FF), 1.0 / 3.0),
        'ffn_conv_b': nrm((L, D_FF), 0.02),
        'ffn_down': nrm((L, D_FF, D), D_FF ** -0.5),
    }


def reference(x_prompt, x_sample, c, state_rwkv, state_mlstm_C, state_mlstm_n, state_mlstm_m,
              c_ctx, ada_w, ada_b, norm_g, w_in, rwkv_mu, rwkv_w0, rwkv_w_up, rwkv_a0, rwkv_a_up,
              rwkv_g_up, rwkv_kk_scale, rwkv_k_a, rwkv_r_k, rwkv_lnx_g, rwkv_lnx_b, mlstm_conv,
              mlstm_gate_b, mlstm_gn_g, w_branch_rwkv, w_branch_mlstm, w_out, ffn_up, ffn_conv,
              ffn_conv_b, ffn_down):
    f32 = jnp.float32
    B = x_prompt.shape[0]
    ctx_init = (jnp.zeros((B, N_DIR, RWKV_HEADS, RWKV_HEAD_DIM, RWKV_HEAD_DIM), f32),
                jnp.zeros((B, N_DIR, MLSTM_HEADS, MLSTM_HEAD_DIM, MLSTM_HEAD_DIM), f32),
                jnp.zeros((B, N_DIR, MLSTM_HEADS, MLSTM_HEAD_DIM), f32),
                jnp.zeros((B, N_DIR, MLSTM_HEADS), f32))
    latent_rows = x_sample.shape[1] // GRID_W
    xp, xs = x_prompt, x_sample
    new_S, new_C, new_n, new_m = [], [], [], []
    for l in range(DEPTH):
        p = dict(ada_w=ada_w[l], ada_b=ada_b[l], norm_g=norm_g[l], w_in=w_in[l],
                 rwkv_mu=rwkv_mu[l], rwkv_w0=rwkv_w0[l], rwkv_w_up=rwkv_w_up[l],
                 rwkv_a0=rwkv_a0[l], rwkv_a_up=rwkv_a_up[l], rwkv_g_up=rwkv_g_up[l],
                 rwkv_kk_scale=rwkv_kk_scale[l], rwkv_k_a=rwkv_k_a[l], rwkv_r_k=rwkv_r_k[l],
                 rwkv_lnx_g=rwkv_lnx_g[l], rwkv_lnx_b=rwkv_lnx_b[l], mlstm_conv=mlstm_conv[l],
                 mlstm_gate_b=mlstm_gate_b[l], mlstm_gn_g=mlstm_gn_g[l],
                 w_branch_rwkv=w_branch_rwkv[l], w_branch_mlstm=w_branch_mlstm[l], w_out=w_out[l],
                 ffn_up=ffn_up[l], ffn_conv=ffn_conv[l], ffn_conv_b=ffn_conv_b[l],
                 ffn_down=ffn_down[l])
        xp, (S, C, n, m) = trunk_layer(xp, c_ctx[None, :], 1, ctx_init, p)
        new_S.append(S)
        new_C.append(C)
        new_n.append(n)
        new_m.append(m)
        xs, _ = trunk_layer(xs, c, latent_rows,
                            (state_rwkv[:, l], state_mlstm_C[:, l], state_mlstm_n[:, l],
                             state_mlstm_m[:, l]), p)
    out_dtype = x_prompt.dtype
    new_state_rwkv = jnp.stack(new_S, axis=1).astype(out_dtype)
    new_state_mlstm_C = jnp.stack(new_C, axis=1).astype(out_dtype)
    new_state_mlstm_n = jnp.stack(new_n, axis=1).astype(out_dtype)
    new_state_mlstm_m = jnp.stack(new_m, axis=1).astype(out_dtype)
    return (xp, xs, new_state_rwkv, new_state_mlstm_C, new_state_mlstm_n, new_state_mlstm_m)
```

```cpp
#include <hip/hip_runtime.h>
#include <cstdio>
#include <cstdint>

#define GAS __attribute__((address_space(1)))
#define LAS __attribute__((address_space(3)))
typedef unsigned short bf16_t;
typedef short bf16x8 __attribute__((ext_vector_type(8)));
typedef float f32x4 __attribute__((ext_vector_type(4)));
typedef float f32x2 __attribute__((ext_vector_type(2)));
typedef unsigned u32x4 __attribute__((ext_vector_type(4)));
typedef unsigned u32x2 __attribute__((ext_vector_type(2)));

#ifndef MK_ONE_LAUNCH
#define MK_ONE_LAUNCH 0
#endif

constexpr int D = 1024, NTOK = 8192, NCTX = 4096;
constexpr int ZC = 6144;
constexpr int DFF = 2816, UPC = 5632;
constexpr int NPH = 13;
constexpr int ZR_R = 0, ZR_K = 512, ZR_V = 1024, ZR_WD = 1536, ZR_AD = 1664, ZR_GD = 1792;
constexpr int ZM_Q = 1920, ZM_K = 2432, ZM_V = 2944, ZM_O = 3456, ZM_G = 3968;
constexpr int ZG_R = 3984, ZG_M = 5008;

constexpr size_t MiB = 1u << 20;
constexpr size_t WS_CTL = 0, CTL_ZERO_BYTES = 64 * 1024;
constexpr size_t WS_MOD = 1 * MiB;
constexpr size_t WS_LI = 1 * MiB + 256 * 1024;
constexpr size_t WS_LF = 1 * MiB + 512 * 1024;
constexpr size_t WS_BON = 1 * MiB + 768 * 1024;
constexpr size_t WS_WIN = 2 * MiB;
constexpr size_t WS_WBR = 14 * MiB;
constexpr size_t WS_WBM = 15 * MiB;
constexpr size_t WS_WOUT = 16 * MiB;
constexpr size_t WS_WUP = 18 * MiB;
constexpr size_t WS_WDN = 29 * MiB;
constexpr size_t WS_H = 35 * MiB;
constexpr size_t WS_Z = 51 * MiB;
constexpr size_t WS_P = 147 * MiB;
constexpr size_t WS_PR = WS_P, WS_PV = WS_P + 8 * MiB, WS_PKK = WS_P + 16 * MiB;
constexpr size_t WS_PW = WS_P + 24 * MiB, WS_PKD = WS_P + 40 * MiB, WS_PB = WS_P + 56 * MiB;
constexpr size_t WS_PG = WS_P + 72 * MiB;
constexpr size_t WS_YRB = WS_P, WS_YMB = WS_P + 16 * MiB;
constexpr size_t WS_FIN = WS_P;
constexpr size_t WS_MQ = 227 * MiB, WS_MK = 235 * MiB;
constexpr size_t WS_END = 243 * MiB;
constexpr size_t OUT_YP = 0, OUT_SR = 8388608, OUT_SC = OUT_SR + 1048576, OUT_SN = OUT_SC + 2097152, OUT_SM = OUT_SN + 16384, OUT_TOTAL = OUT_SM + 128;

constexpr int LDS_BYTES = 155648;
constexpr int MISC_OFF = LDS_BYTES - 256;

#define LDS_WAIT() asm volatile("s_waitcnt lgkmcnt(0)" ::: "memory")
#define VM_WAIT() asm volatile("s_waitcnt vmcnt(0)" ::: "memory")

__device__ __forceinline__ float bf2f(unsigned v) { return __builtin_bit_cast(float, v << 16); }
__device__ __forceinline__ unsigned f2bf(float f) { unsigned u = __builtin_bit_cast(unsigned, f); return (u + 0x7fffu + ((u >> 16) & 1u)) >> 16; }
__device__ __forceinline__ unsigned pk2(float lo, float hi) { return f2bf(lo) | (f2bf(hi) << 16); }
__device__ __forceinline__ float sigm(float x) { return 1.f / (1.f + __expf(-x)); }
__device__ __forceinline__ float silu(float x) { return x / (1.f + __expf(-x)); }
__device__ __forceinline__ float wave_sum(float v) {
#pragma unroll
    for (int o = 1; o < 64; o <<= 1) v += __shfl_xor(v, o);
    return v;
}
__device__ __forceinline__ void unpack8(const u32x4 w, float (&f)[8]) {
    f[0] = bf2f(w.x & 0xffffu); f[1] = bf2f(w.x >> 16); f[2] = bf2f(w.y & 0xffffu); f[3] = bf2f(w.y >> 16);
    f[4] = bf2f(w.z & 0xffffu); f[5] = bf2f(w.z >> 16); f[6] = bf2f(w.w & 0xffffu); f[7] = bf2f(w.w >> 16);
}
__device__ __forceinline__ u32x4 pack8(const float (&f)[8]) { u32x4 w; w.x = pk2(f[0], f[1]); w.y = pk2(f[2], f[3]); w.z = pk2(f[4], f[5]); w.w = pk2(f[6], f[7]); return w; }

#define XB_TMO      128
#define XB_XCNT(j)  (256  + 64 * (j))
#define XB_XSUB(j)  (1280 + 64 * (j))
#define XB_XGEN(j)  (2304 + 64 * (j))
#define XB_TOP      3328
#define XB_TOPGEN   3392
#define XCD_BAR_WORDS 3456
#define XB_SPIN_CAP (1u << 22)
__device__ __forceinline__ unsigned xb_ld(unsigned* p)              { return __hip_atomic_load(p, __ATOMIC_RELAXED, __HIP_MEMORY_SCOPE_AGENT); }
__device__ __forceinline__ unsigned xb_add(unsigned* p, unsigned v) { return __hip_atomic_fetch_add(p, v, __ATOMIC_RELAXED, __HIP_MEMORY_SCOPE_AGENT); }
__device__ __forceinline__ unsigned xb_xcc_id() { return (unsigned)__builtin_amdgcn_s_getreg((3 << 11) | 20) & 0xFu; }
#define XB_SPIN(cond, bar) do { unsigned _sp = 0; while (cond) { __builtin_amdgcn_s_sleep(1); \
    if ((++_sp & 255u) == 0u) { if (xb_ld(&(bar)[XB_TMO])) break; if (_sp > XB_SPIN_CAP) { atomicAdd(&(bar)[XB_TMO], 1u); break; } } } } while (0)
struct XcdBarrier { unsigned* bar; unsigned x; volatile LAS unsigned* st; };
__device__ __forceinline__ XcdBarrier xcd_barrier_post(unsigned* bar, volatile LAS unsigned* st) {
    XcdBarrier b; b.bar = bar; b.x = xb_xcc_id(); b.st = st;
    if (threadIdx.x == 0) (void)xb_add(&bar[XB_XCNT(b.x)], 1u);
    return b;
}
__device__ __forceinline__ void xcd_barrier_complete(unsigned* bar, unsigned x, unsigned& nloc, unsigned& nx) {
    const unsigned G = gridDim.x * gridDim.y * gridDim.z;
    unsigned sum, cnt, mine, sp = 0u;
    for (;;) {
        sum = 0u; cnt = 0u; mine = 0u;
#pragma unroll
        for (unsigned j = 0; j < 16; ++j) { const unsigned c = xb_ld(&bar[XB_XCNT(j)]); sum += c; cnt += (c > 0u) ? 1u : 0u; mine = (j == x) ? c : mine; }
        if (sum == G) break;
        __builtin_amdgcn_s_sleep(1);
        if ((++sp & 255u) == 0u) { if (xb_ld(&bar[XB_TMO])) break; if (sp > XB_SPIN_CAP) { atomicAdd(&bar[XB_TMO], 1u); break; } }
    }
    nloc = mine > 0u ? mine : 1u; nx = cnt > 0u ? cnt : 1u;
}
__device__ __forceinline__ void xcd_barrier(const XcdBarrier& b) {
    asm volatile("s_waitcnt vmcnt(0)" ::: "memory");
    __syncthreads();
    if (threadIdx.x == 0) {
        unsigned* bar = b.bar;
        __builtin_amdgcn_s_waitcnt(0);
        unsigned nloc = b.st[0], nx = b.st[1];
        if (nloc == 0u) { xcd_barrier_complete(bar, b.x, nloc, nx); b.st[0] = nloc; b.st[1] = nx; }
        const unsigned old = xb_add(&bar[XB_XSUB(b.x)], 1u);
        const unsigned gen = old / nloc;
        if (old + 1u == (gen + 1u) * nloc) {
            __builtin_amdgcn_fence(__ATOMIC_RELEASE, "agent");
            asm volatile("s_waitcnt vmcnt(0)" ::: "memory");
            const unsigned og = xb_add(&bar[XB_TOP], 1u);
            const unsigned tg = og / nx;
            if (og + 1u == (tg + 1u) * nx) xb_add(&bar[XB_TOPGEN], 1u);
            else XB_SPIN(xb_ld(&bar[XB_TOPGEN]) == tg, bar);
            __builtin_amdgcn_fence(__ATOMIC_ACQUIRE, "agent");
            xb_add(&bar[XB_XGEN(b.x)], 1u);
            asm volatile("s_waitcnt vmcnt(0)" ::: "memory");
        } else {
            XB_SPIN(xb_ld(&bar[XB_XGEN(b.x)]) == gen, bar);
            __builtin_amdgcn_fence(__ATOMIC_ACQUIRE, "agent");
            asm volatile("s_waitcnt vmcnt(0)" ::: "memory");
        }
    }
    __syncthreads();
}

namespace pg8 {
constexpr int BM = 256, BK = 64, HALF = 128, HTB = HALF * BK * 2, STAGE_BYTES = 8 * HTB, NXCD = 8, WGM = 8;
__host__ __device__ __forceinline__ int lds_byte(int r, int c) { const int st = (r >> 4) * 2 + (c >> 5), rr = r & 15, cc = c & 31, ob = rr * 64 + cc * 2; return st * 1024 + (ob ^ (((ob >> 9) & 1) << 5)); }
__host__ __device__ __forceinline__ void stage_rc(int b, int& R, int& C) { const int st = b / 1024, sb = b % 1024, swz = sb ^ (((sb >> 9) & 1) << 5); R = (st >> 1) * 16 + swz / 64; C = (st & 1) * 32 + (swz % 64) / 2; }
__host__ __device__ __forceinline__ int perm32(int rho) { const int n = rho >> 4, i = rho & 15; return 8 * (i >> 2) + 4 * n + (i & 3); }
struct Unit { int pm, pn; };
struct Gemm { const bf16_t* A; const bf16_t* Bt; int M, N, K; };
struct StaticOrder {
    int nM, nN, nwg, G, c;
    __host__ __device__ void init(int M, int N, int G_, int c_) { nM = M / BM; nN = N / BM; nwg = nM * nN; G = G_; c = c_; }
    __host__ __device__ bool next(int i, Unit& u) const {
        const long L = (long)i * G + c; if (L >= nwg) return false;
        int wgid = (int)L; { const int q = nwg / NXCD, r = nwg % NXCD, xcd = wgid % NXCD, off = wgid / NXCD; wgid = (xcd < r ? xcd * (q + 1) : r * (q + 1) + (xcd - r) * q) + off; }
        const int nig = WGM * nN, gid = wgid / nig, fm = gid * WGM, gsz = (nM - fm) < WGM ? (nM - fm) : WGM;
        u.pm = fm + ((wgid % nig) % gsz); u.pn = (wgid % nig) / gsz; return true;
    }
};

struct EpiBf16 {
    static constexpr bool PERM = true;
    bf16_t* O; int ldc;
    __device__ __forceinline__ void operator()(const f32x4 (&acc)[2][2][4][2], const Unit& u, int wr, int wc, int fr, int fq) const {
        const int row0 = u.pm * BM + wr * 64 + fr, col0 = u.pn * BM + wc * 32 + 8 * fq;
#pragma unroll
        for (int ai = 0; ai < 2; ++ai)
#pragma unroll
            for (int m = 0; m < 4; ++m) { bf16_t* rowp = O + (size_t)(row0 + ai * HALF + m * 16) * ldc + col0;
#pragma unroll
                for (int bj = 0; bj < 2; ++bj) { const f32x4 v0 = acc[ai][bj][m][0], v1 = acc[ai][bj][m][1];
                    u32x4 w; w.x = pk2(v0[0], v0[1]); w.y = pk2(v0[2], v0[3]); w.z = pk2(v1[0], v1[1]); w.w = pk2(v1[2], v1[3]);
                    *(u32x4*)(rowp + bj * HALF) = w; } }
    }
};
template <bool ADD> struct EpiGate {
    static constexpr bool PERM = true;
    bf16_t* O; const bf16_t* Z; int gcol0;
    __device__ __forceinline__ void operator()(const f32x4 (&acc)[2][2][4][2], const Unit& u, int wr, int wc, int fr, int fq) const {
        const int row0 = u.pm * BM + wr * 64 + fr, col0 = u.pn * BM + wc * 32 + 8 * fq;
#pragma unroll
        for (int ai = 0; ai < 2; ++ai)
#pragma unroll
            for (int m = 0; m < 4; ++m) { const int row = row0 + ai * HALF + m * 16; bf16_t* rowp = O + (size_t)row * D + col0; const bf16_t* gp = Z + (size_t)row * ZC + gcol0 + col0;
#pragma unroll
                for (int bj = 0; bj < 2; ++bj) { const f32x4 v0 = acc[ai][bj][m][0], v1 = acc[ai][bj][m][1];
                    float g[8], r[8]; unpack8(*(const u32x4*)(gp + bj * HALF), g);
                    r[0] = v0[0] * sigm(g[0]); r[1] = v0[1] * sigm(g[1]); r[2] = v0[2] * sigm(g[2]); r[3] = v0[3] * sigm(g[3]);
                    r[4] = v1[0] * sigm(g[4]); r[5] = v1[1] * sigm(g[5]); r[6] = v1[2] * sigm(g[6]); r[7] = v1[3] * sigm(g[7]);
                    if (ADD) { float p[8]; unpack8(*(const u32x4*)(rowp + bj * HALF), p);
#pragma unroll
                        for (int i = 0; i < 8; ++i) r[i] += p[i]; }
                    *(u32x4*)(rowp + bj * HALF) = pack8(r); } }
    }
};
struct EpiF32 {
    static constexpr bool PERM = false;
    float* O; int ldc;
    __device__ __forceinline__ void operator()(const f32x4 (&acc)[2][2][4][2], const Unit& u, int wr, int wc, int fr, int fq) const {
        const int row0 = u.pm * BM + wr * 64 + fr, col0 = u.pn * BM + wc * 32 + 4 * fq;
#pragma unroll
        for (int ai = 0; ai < 2; ++ai)
#pragma unroll
            for (int m = 0; m < 4; ++m) { float* rowp = O + (size_t)(row0 + ai * HALF + m * 16) * ldc + col0;
#pragma unroll
                for (int bj = 0; bj < 2; ++bj)
#pragma unroll
                    for (int n = 0; n < 2; ++n) *(f32x4*)(rowp + bj * HALF + n * 16) = acc[ai][bj][m][n]; }
    }
};

template <class Epi>
__device__ __forceinline__ void gemm_phase(LAS unsigned char* lds, const Gemm g, const StaticOrder& S, const Epi& E) {
    const int tid = threadIdx.x, wid = __builtin_amdgcn_readfirstlane(tid >> 6), lane = tid & 63, wr = wid >> 2, wc = wid & 3, fr = lane & 15, fq = lane >> 4;
    const int K = g.K, nt = K / BK;
    unsigned voffA[2], voffB[2];
#pragma unroll
    for (int i = 0; i < 2; ++i) { int R, C; stage_rc(tid * 16 + i * 8192, R, C); const int Rb = Epi::PERM ? ((R & ~31) + perm32(R & 31)) : R;
        voffA[i] = (unsigned)(R * K + C) * 2u; voffB[i] = (unsigned)(Rb * K + C) * 2u; }
    const size_t kstep = (size_t)(BK * 2);
    const size_t hstep = (size_t)HALF * K * 2;
    const size_t tstep = 2 * hstep;
    const unsigned ldsw = (unsigned)wid * 1024u;
    const int aoff = lds_byte(wr * 64 + fr, fq * 8), boff = lds_byte(wc * 32 + fr, fq * 8);
#define PG8_SA(b, h) (((b) * 2 + (h)) * HTB)
#define PG8_SB(b, h) ((4 + (b) * 2 + (h)) * HTB)
#define PG8_STAGE(bufoff, gbase, voff) do { _Pragma("unroll") for (int _i = 0; _i < 2; ++_i) \
        __builtin_amdgcn_global_load_lds((const unsigned*)((const char*)(gbase) + (voff)[_i]), (LAS unsigned*)(lds + (bufoff) + ldsw + _i * 8192), 16, 0, 0); } while (0)
#define PG8_LDA(dst, b, h) do { _Pragma("unroll") for (int m = 0; m < 4; ++m) _Pragma("unroll") for (int k = 0; k < 2; ++k) dst[m][k] = *(const LAS bf16x8*)(lds + PG8_SA(b, h) + aoff + m * 2048 + k * 1024); } while (0)
#define PG8_LDB(dst, b, h) do { _Pragma("unroll") for (int n = 0; n < 2; ++n) _Pragma("unroll") for (int k = 0; k < 2; ++k) dst[n][k] = *(const LAS bf16x8*)(lds + PG8_SB(b, h) + boff + n * 2048 + k * 1024); } while (0)
#define PG8_MMA(ai, bj, At, Bt) do { __builtin_amdgcn_s_setprio(1); _Pragma("unroll") for (int m = 0; m < 4; ++m) _Pragma("unroll") for (int n = 0; n < 2; ++n) _Pragma("unroll") for (int k = 0; k < 2; ++k) \
        acc[ai][bj][m][n] = __builtin_amdgcn_mfma_f32_16x16x32_bf16(Bt[n][k], At[m][k], acc[ai][bj][m][n], 0, 0, 0); __builtin_amdgcn_s_setprio(0); } while (0)
#define PG8_WAIT_V(n) asm volatile("s_waitcnt vmcnt(" #n ")" ::: "memory")
#define PG8_WAIT_L(n) asm volatile("s_waitcnt lgkmcnt(" #n ")" ::: "memory")
#define PG8_BAR __builtin_amdgcn_s_barrier()
#define PG8_SCHED __builtin_amdgcn_sched_barrier(0)
    Unit cur, nxt; int ui = 0;
    if (!S.next(0, cur)) return;
    f32x4 acc[2][2][4][2];
#pragma unroll
    for (int a = 0; a < 2; ++a)
#pragma unroll
        for (int b = 0; b < 2; ++b)
#pragma unroll
            for (int m = 0; m < 4; ++m)
#pragma unroll
                for (int n = 0; n < 2; ++n) acc[a][b][m][n] = (f32x4){0.f, 0.f, 0.f, 0.f};
    bf16x8 At[4][2], B0[2][2], B1[2][2];
    const char* cA = (const char*)g.A + (size_t)cur.pm * tstep; const char* cB = (const char*)g.Bt + (size_t)cur.pn * tstep;
    PG8_STAGE(PG8_SB(0, 0), cB, voffB); PG8_STAGE(PG8_SB(0, 1), cB + hstep, voffB); PG8_STAGE(PG8_SA(0, 0), cA, voffA); PG8_STAGE(PG8_SA(0, 1), cA + hstep, voffA);
    if (wr == 1) PG8_BAR;
    PG8_WAIT_V(2); PG8_BAR;
    PG8_STAGE(PG8_SB(1, 0), cB + kstep, voffB); PG8_STAGE(PG8_SA(1, 0), cA + kstep, voffA); PG8_STAGE(PG8_SB(1, 1), cB + hstep + kstep, voffB);
    PG8_WAIT_V(6); PG8_BAR;
    for (;;) {
        const bool has_next = S.next(ui + 1, nxt);
        const char* nA = has_next ? (const char*)g.A + (size_t)nxt.pm * tstep : cA; const char* nB = has_next ? (const char*)g.Bt + (size_t)nxt.pn * tstep : cB;
        for (int t = 0; t < nt; t += 2) {
            const bool last = (t == nt - 2);
            const char* a1 = cA + (size_t)(t + 1) * kstep;
            const char* a2 = last ? nA : cA + (size_t)(t + 2) * kstep; const char* b2 = last ? nB : cB + (size_t)(t + 2) * kstep;
            const char* a3 = a2 + kstep; const char* b3 = b2 + kstep;
            PG8_LDB(B0, 0, 0); PG8_LDB(B1, 0, 1); PG8_SCHED; PG8_LDA(At, 0, 0); PG8_STAGE(PG8_SA(1, 1), a1 + hstep, voffA);
            PG8_WAIT_V(8); PG8_WAIT_L(0); PG8_BAR; PG8_MMA(0, 0, At, B0); PG8_MMA(0, 1, At, B1); PG8_BAR; PG8_SCHED;
            PG8_LDA(At, 0, 1); PG8_STAGE(PG8_SB(0, 0), b2, voffB); PG8_STAGE(PG8_SB(0, 1), b2 + hstep, voffB); PG8_STAGE(PG8_SA(0, 0), a2, voffA);
            PG8_WAIT_V(8); PG8_WAIT_L(0); PG8_BAR; PG8_MMA(1, 0, At, B0); PG8_MMA(1, 1, At, B1); PG8_BAR; PG8_SCHED;
            PG8_LDB(B0, 1, 0); PG8_LDB(B1, 1, 1); PG8_SCHED; PG8_LDA(At, 1, 0); PG8_STAGE(PG8_SA(0, 1), a2 + hstep, voffA);
            PG8_WAIT_V(8); PG8_WAIT_L(0); PG8_BAR; PG8_MMA(0, 0, At, B0); PG8_MMA(0, 1, At, B1); PG8_BAR; PG8_SCHED;
            PG8_LDA(At, 1, 1); PG8_STAGE(PG8_SB(1, 0), b3, voffB); PG8_STAGE(PG8_SB(1, 1), b3 + hstep, voffB); PG8_STAGE(PG8_SA(1, 0), a3, voffA);
            PG8_WAIT_V(8); PG8_WAIT_L(0); PG8_BAR; PG8_MMA(1, 0, At, B0); PG8_MMA(1, 1, At, B1); PG8_BAR; PG8_SCHED;
        }
        if (wr == 0) PG8_BAR;
        E(acc, cur, wr, wc, fr, fq);
        if (!has_next) break;
#pragma unroll
        for (int a = 0; a < 2; ++a)
#pragma unroll
            for (int b = 0; b < 2; ++b)
#pragma unroll
                for (int m = 0; m < 4; ++m)
#pragma unroll
                    for (int n = 0; n < 2; ++n) acc[a][b][m][n] = (f32x4){0.f, 0.f, 0.f, 0.f};
        cur = nxt; cA = nA; cB = nB; ++ui;
        if (wr == 1) PG8_BAR;
    }
    PG8_WAIT_V(0);
    PG8_BAR;
#undef PG8_SA
#undef PG8_SB
#undef PG8_STAGE
#undef PG8_LDA
#undef PG8_LDB
#undef PG8_MMA
#undef PG8_WAIT_V
#undef PG8_WAIT_L
#undef PG8_BAR
#undef PG8_SCHED
}
}

struct Args { const float* in[33]; float* out; unsigned char* ws; int ph_lo, ph_hi; };
enum { I_XP = 0, I_XS, I_C, I_SR, I_SC, I_SN, I_SM, I_CCTX, I_ADAW, I_ADAB, I_NORMG, I_WIN, I_MU, I_W0, I_WUP, I_A0, I_AUP, I_GUP, I_KKS, I_KA, I_RK, I_LNG, I_LNB,
       I_MCONV, I_MGB, I_MGNG, I_WBR, I_WBM, I_WOUT, I_FUP, I_FCONV, I_FCB, I_FDN };

struct Frame {
    LAS unsigned char* lds; const Args* a;
    int tid, lane, wave, G, vcu, gw, NGW;
    unsigned char* ws; float* out;
};
__device__ __forceinline__ const float* xrow_ptr(const Args& a, int tok) { return tok < NCTX ? a.in[I_XP] + (size_t)tok * D : a.in[I_XS] + (size_t)(tok - NCTX) * D; }
__device__ __forceinline__ int cond_of(int tok) { return tok < NCTX ? 0 : 1 + ((tok - NCTX) >> 11); }
__device__ __forceinline__ int seq_base(int s) { return s < 16 ? s * 256 : NCTX + (s - 16) * 2048; }
__device__ __forceinline__ int seq_len(int s) { return s < 16 ? 256 : 2048; }

__device__ __forceinline__ void transpose_item(const float* W, int K, int N, bf16_t* WT, int nblk, LAS float* scr, int item, int lane) {
    const int kb = item / nblk, nb = item % nblk, k0 = 64 * kb, n0 = 32 * nb;
    const int nn = n0 + (lane & 31);
#pragma unroll 8
    for (int i = 0; i < 32; ++i) { const int kk = 2 * i + (lane >> 5); scr[kk * 33 + (lane & 31)] = (nn < N) ? W[(size_t)(k0 + kk) * N + nn] : 0.f; }
    LDS_WAIT(); asm volatile("" ::: "memory");
    const int c = lane & 7;
#pragma unroll
    for (int j = 0; j < 4; ++j) { const int n = (lane >> 3) + 8 * j; const LAS float* s = scr + (8 * c) * 33 + n;
        u32x4 o; o.x = pk2(s[0 * 33], s[1 * 33]); o.y = pk2(s[2 * 33], s[3 * 33]); o.z = pk2(s[4 * 33], s[5 * 33]); o.w = pk2(s[6 * 33], s[7 * 33]);
        *(u32x4*)(WT + (size_t)(n0 + n) * K + k0 + 8 * c) = o; }
    LDS_WAIT(); asm volatile("" ::: "memory");
}
__device__ __forceinline__ void p0_prologue(Frame& F) {
    const Args& a = *F.a;
    if (blockIdx.x < 96) {
        LAS float* sc = (LAS float*)(F.lds + 69632);
        LAS float* part = (LAS float*)(F.lds + 69632 + 12288);
        for (int i = F.tid; i < 3072; i += 512) { const int ci = i >> 10, k = i & 1023; const float cv = ci == 0 ? a.in[I_CCTX][k] : a.in[I_C][(ci - 1) * D + k]; sc[i] = silu(cv); }
        __syncthreads();
        const int col = blockIdx.x * 64 + F.lane; float a0 = 0.f, a1 = 0.f, a2 = 0.f;
        const float* aw = a.in[I_ADAW];
#pragma unroll 8
        for (int k = F.wave * 128; k < F.wave * 128 + 128; ++k) { const float w = aw[(size_t)k * 6144 + col]; a0 += sc[k] * w; a1 += sc[1024 + k] * w; a2 += sc[2048 + k] * w; }
        part[(F.wave * 3 + 0) * 64 + F.lane] = a0; part[(F.wave * 3 + 1) * 64 + F.lane] = a1; part[(F.wave * 3 + 2) * 64 + F.lane] = a2;
        __syncthreads();
        if (F.tid < 192) { const int ci = F.tid >> 6, l = F.tid & 63; float s = a.in[I_ADAB][blockIdx.x * 64 + l];
#pragma unroll
            for (int w = 0; w < 8; ++w) s += part[(w * 3 + ci) * 64 + l];
            ((float*)(F.ws + WS_MOD))[ci * 6144 + blockIdx.x * 64 + l] = s; }
        __syncthreads();
    }
    LAS float* scr = (LAS float*)(F.lds + F.wave * 8448);
    constexpr int I_1 = 16 * 192, I_2 = 8 * 32, I_3 = 8 * 32, I_4 = 16 * 32, I_5 = 16 * 176, I_6 = 44 * 32;
    constexpr int NITEMS = I_1 + I_2 + I_3 + I_4 + I_5 + I_6;
    for (int it = F.gw; it < NITEMS; it += F.NGW) {
        int r = it;
        if (r < I_1) { transpose_item(a.in[I_WIN], 1024, 6032, (bf16_t*)(F.ws + WS_WIN), 192, scr, r, F.lane); continue; } r -= I_1;
        if (r < I_2) { transpose_item(a.in[I_WBR], 512, 1024, (bf16_t*)(F.ws + WS_WBR), 32, scr, r, F.lane); continue; } r -= I_2;
        if (r < I_3) { transpose_item(a.in[I_WBM], 512, 1024, (bf16_t*)(F.ws + WS_WBM), 32, scr, r, F.lane); continue; } r -= I_3;
        if (r < I_4) { transpose_item(a.in[I_WOUT], 1024, 1024, (bf16_t*)(F.ws + WS_WOUT), 32, scr, r, F.lane); continue; } r -= I_4;
        if (r < I_5) { transpose_item(a.in[I_FUP], 1024, 5632, (bf16_t*)(F.ws + WS_WUP), 176, scr, r, F.lane); continue; } r -= I_5;
        transpose_item(a.in[I_FDN], 2816, 1024, (bf16_t*)(F.ws + WS_WDN), 32, scr, r, F.lane);
    }
}

__device__ __forceinline__ void p1_h1(Frame& F) {
    const Args& a = *F.a; const float* ng = a.in[I_NORMG];
    for (int row = F.gw; row < NTOK; row += F.NGW) {
        const f32x4* xr = (const f32x4*)xrow_ptr(a, row) + F.lane; const float* mod = (const float*)(F.ws + WS_MOD) + cond_of(row) * 6144;
        f32x4 v[4]; float ss = 0.f;
#pragma unroll
        for (int j = 0; j < 4; ++j) { v[j] = xr[64 * j]; ss += (v[j].x * v[j].x + v[j].y * v[j].y) + (v[j].z * v[j].z + v[j].w * v[j].w); }
        const float rstd = rsqrtf(wave_sum(ss) * (1.f / D) + 1e-6f);
        u32x2* o = (u32x2*)((bf16_t*)(F.ws + WS_H) + (size_t)row * D) + F.lane;
#pragma unroll
        for (int j = 0; j < 4; ++j) { const int col = 4 * (64 * j + F.lane);
            const f32x4 g = *(const f32x4*)(ng + col), sh = *(const f32x4*)(mod + col), sc = *(const f32x4*)(mod + 1024 + col);
            const f32x4 h = v[j] * rstd * g * (sc + 1.f) + sh;
            u32x2 w; w.x = pk2(h.x, h.y); w.y = pk2(h.z, h.w); o[64 * j] = w; }
    }
}

__device__ __forceinline__ void p3_prep(Frame& F) {
    const Args& a = *F.a;
    const bf16_t* Z = (const bf16_t*)(F.ws + WS_Z);
    LAS float* zs = (LAS float*)F.lds;
    const int c = F.tid, h = F.wave;
    for (int unit = blockIdx.x; unit < NTOK / 8; unit += F.G) {
        const int tok0 = unit * 8;
        const int s = tok0 < NCTX ? (tok0 >> 8) : 16 + ((tok0 - NCTX) >> 11);
        const int sb = seq_base(s), T = seq_len(s), t0 = tok0 - sb;
        __syncthreads();
        for (int idx = F.tid; idx < 8 * 1920; idx += 512) {
            const int j = idx / 1920, cc = idx - j * 1920, t = t0 + j;
            const bf16_t* zp = Z + (size_t)(tok0 + j) * ZC + cc;
            const float zc = bf2f(zp[0]), zl = t > 0 ? bf2f(zp[-ZC]) : 0.f, zr = t < T - 1 ? bf2f(zp[ZC]) : 0.f;
            float v = zc + a.in[I_MU][cc] * (0.5f * (zl + zr) - zc);
            if (cc >= ZR_WD && cc < ZR_AD) v = tanhf(v);
            else if (cc >= ZR_GD) v = sigm(v);
            zs[idx] = v;
        }
        __syncthreads();
        float aw[2][8], aa[2][8], ag[8];
#pragma unroll
        for (int j = 0; j < 8; ++j) { aw[0][j] = aw[1][j] = aa[0][j] = aa[1][j] = ag[j] = 0.f; }
        const float* wup = a.in[I_WUP]; const float* aup = a.in[I_AUP]; const float* gup = a.in[I_GUP];
        for (int r4 = 0; r4 < 16; ++r4) {
            float w0[4], w1[4], u0[4], u1[4];
#pragma unroll
            for (int i = 0; i < 4; ++i) { const int r = r4 * 4 + i; w0[i] = wup[(size_t)r * 512 + c]; w1[i] = wup[(size_t)(64 + r) * 512 + c]; u0[i] = aup[(size_t)r * 512 + c]; u1[i] = aup[(size_t)(64 + r) * 512 + c]; }
#pragma unroll
            for (int j = 0; j < 8; ++j) {
                const f32x4 t0v = *(const LAS f32x4*)(zs + j * 1920 + ZR_WD + r4 * 4), t1v = *(const LAS f32x4*)(zs + j * 1920 + ZR_WD + 64 + r4 * 4);
                const f32x4 d0v = *(const LAS f32x4*)(zs + j * 1920 + ZR_AD + r4 * 4), d1v = *(const LAS f32x4*)(zs + j * 1920 + ZR_AD + 64 + r4 * 4);
#pragma unroll
                for (int i = 0; i < 4; ++i) { aw[0][j] += t0v[i] * w0[i]; aw[1][j] += t1v[i] * w1[i]; aa[0][j] += d0v[i] * u0[i]; aa[1][j] += d1v[i] * u1[i]; }
            }
        }
        for (int r4 = 0; r4 < 32; ++r4) {
            float g0[4];
#pragma unroll
            for (int i = 0; i < 4; ++i) g0[i] = gup[(size_t)(r4 * 4 + i) * 512 + c];
#pragma unroll
            for (int j = 0; j < 8; ++j) { const f32x4 sv = *(const LAS f32x4*)(zs + j * 1920 + ZR_GD + r4 * 4);
#pragma unroll
                for (int i = 0; i < 4; ++i) ag[j] += sv[i] * g0[i]; }
        }
        const float w0c[2] = {a.in[I_W0][c], a.in[I_W0][512 + c]}, a0c[2] = {a.in[I_A0][c], a.in[I_A0][512 + c]};
        const float kks = a.in[I_KKS][c], ka = a.in[I_KA][c], rk = a.in[I_RK][c];
#pragma unroll
        for (int j = 0; j < 8; ++j) {
            const size_t tok = (size_t)(tok0 + j);
            const float r = zs[j * 1920 + ZR_R + c], k = zs[j * 1920 + ZR_K + c], v = zs[j * 1920 + ZR_V + c];
            const float kq = k * kks; const float nrm = sqrtf(wave_sum(kq * kq)); const float kk = kq / fmaxf(nrm, 1e-12f);
            float bon = 0.f;
#pragma unroll
            for (int d = 0; d < 2; ++d) {
                const float dec = __expf(-0.606531f * sigm(w0c[d] + aw[d][j])); const float av = sigm(a0c[d] + aa[d][j]);
                const float kd = k * (1.f + (av - 1.f) * ka), bv = kk * av;
                bon += r * kd * rk;
                ((bf16_t*)(F.ws + WS_PW))[((size_t)d * NTOK + tok) * 512 + c] = (bf16_t)f2bf(dec);
                ((bf16_t*)(F.ws + WS_PKD))[((size_t)d * NTOK + tok) * 512 + c] = (bf16_t)f2bf(kd);
                ((bf16_t*)(F.ws + WS_PB))[((size_t)d * NTOK + tok) * 512 + c] = (bf16_t)f2bf(bv);
            }
            bon = wave_sum(bon);
            if (F.lane == 0) ((float*)(F.ws + WS_BON))[tok * 8 + h] = bon;
            ((bf16_t*)(F.ws + WS_PR))[tok * 512 + c] = (bf16_t)f2bf(r);
            ((bf16_t*)(F.ws + WS_PV))[tok * 512 + c] = (bf16_t)f2bf(v);
            ((bf16_t*)(F.ws + WS_PKK))[tok * 512 + c] = (bf16_t)f2bf(kk);
            ((bf16_t*)(F.ws + WS_PG))[tok * 512 + c] = (bf16_t)f2bf(ag[j]);
        }
        {
            const float* cw = a.in[I_MCONV];
            float wq[9], wk[9];
#pragma unroll
            for (int i = 0; i < 9; ++i) { wq[i] = cw[i * 1024 + c]; wk[i] = cw[i * 1024 + 512 + c]; }
#pragma unroll 1
            for (int j = 0; j < 8; ++j) {
                const int tok = tok0 + j, t = t0 + j; float aq = 0.f, ak = 0.f;
                if (s < 16) {
#pragma unroll
                    for (int dx = -1; dx <= 1; ++dx) { const int tt = t + dx; if (tt >= 0 && tt < 256) { const bf16_t* zp = Z + (size_t)(tok + dx) * ZC + ZM_Q + c; aq += wq[3 + dx + 1] * bf2f(zp[0]); ak += wk[3 + dx + 1] * bf2f(zp[512]); } }
                } else {
                    const int y = t >> 6, x = t & 63;
#pragma unroll
                    for (int dy = -1; dy <= 1; ++dy)
#pragma unroll
                        for (int dx = -1; dx <= 1; ++dx) { const int yy = y + dy, xx = x + dx;
                            if (yy >= 0 && yy < 32 && xx >= 0 && xx < 64) { const bf16_t* zp = Z + (size_t)(tok + dy * 64 + dx) * ZC + ZM_Q + c; aq += wq[(dy + 1) * 3 + dx + 1] * bf2f(zp[0]); ak += wk[(dy + 1) * 3 + dx + 1] * bf2f(zp[512]); } }
                }
                ((bf16_t*)(F.ws + WS_MQ))[(size_t)tok * 512 + c] = (bf16_t)f2bf(silu(aq) * 0.08838834764831845f);
                ((bf16_t*)(F.ws + WS_MK))[(size_t)tok * 512 + c] = (bf16_t)f2bf(silu(ak));
            }
            if (F.tid < 128) { const int j = F.tid >> 4, gi = F.tid & 15, tok = tok0 + j;
                const float val = bf2f(Z[(size_t)tok * ZC + ZM_G + gi]) + a.in[I_MGB][gi];
                if (gi < 8) ((float*)(F.ws + WS_LI))[(size_t)gi * NTOK + tok] = val;
                else ((float*)(F.ws + WS_LF))[(size_t)(gi - 8) * NTOK + tok] = fminf(val, 0.f) - log1pf(__expf(-fabsf(val))); }
        }
    }
}

__device__ __forceinline__ void rwkv_scan_unit(Frame& F, int u, LAS float* wl  ) {
    const Args& a = *F.a;
    int s, dir, h;
    if (u < 32) { s = 16 + (u >> 4); dir = (u >> 3) & 1; h = u & 7; } else { const int v = u - 32; s = v >> 4; dir = (v >> 3) & 1; h = v & 7; }
    const int sb = seq_base(s), T = seq_len(s), lane = F.lane;
    const bf16_t* PR = (const bf16_t*)(F.ws + WS_PR) + h * 64 + lane; const bf16_t* PV = (const bf16_t*)(F.ws + WS_PV) + h * 64 + lane; const bf16_t* PKK = (const bf16_t*)(F.ws + WS_PKK) + h * 64 + lane;
    const bf16_t* PW = (const bf16_t*)(F.ws + WS_PW) + (size_t)dir * NTOK * 512 + h * 64 + lane; const bf16_t* PKD = (const bf16_t*)(F.ws + WS_PKD) + (size_t)dir * NTOK * 512 + h * 64 + lane;
    const bf16_t* PB = (const bf16_t*)(F.ws + WS_PB) + (size_t)dir * NTOK * 512 + h * 64 + lane;
    bf16_t* YS = (bf16_t*)F.out + (size_t)dir * NTOK * 512 + h * 64 + lane;
    float S[64];
    if (s >= 16) { const float* s0 = a.in[I_SR] + ((((size_t)(s - 16) * 2 + dir) * 8 + h) * 64 + lane) * 64;
#pragma unroll
        for (int k4 = 0; k4 < 16; ++k4) { const f32x4 v = *(const f32x4*)(s0 + 4 * k4); S[4 * k4] = v.x; S[4 * k4 + 1] = v.y; S[4 * k4 + 2] = v.z; S[4 * k4 + 3] = v.w; }
    } else {
#pragma unroll
        for (int k = 0; k < 64; ++k) S[k] = 0.f;
    }
    for (int st = 0; st < T; st += 8) {
#pragma unroll
        for (int i = 0; i < 8; ++i) { const int t = dir ? T - 1 - (st + i) : st + i; const size_t off = (size_t)(sb + t) * 512;
            wl[(i * 6 + 0) * 64 + lane] = bf2f(PKK[off]); wl[(i * 6 + 1) * 64 + lane] = bf2f(PW[off]); wl[(i * 6 + 2) * 64 + lane] = bf2f(PB[off]);
            wl[(i * 6 + 3) * 64 + lane] = bf2f(PKD[off]); wl[(i * 6 + 4) * 64 + lane] = bf2f(PR[off]); wl[(i * 6 + 5) * 64 + lane] = bf2f(PV[off]); }
        LDS_WAIT(); asm volatile("" ::: "memory");
#pragma unroll 1
        for (int i = 0; i < 8; ++i) {
            const LAS float* wb = wl + i * 384;
            const LAS f32x4* kkp = (const LAS f32x4*)(wb); const LAS f32x4* wp = (const LAS f32x4*)(wb + 64); const LAS f32x4* bp = (const LAS f32x4*)(wb + 128);
            const LAS f32x4* kdp = (const LAS f32x4*)(wb + 192); const LAS f32x4* rp = (const LAS f32x4*)(wb + 256);
            const float v = wb[320 + lane];
            float r0 = 0.f, r1 = 0.f, r2 = 0.f, r3 = 0.f;
#pragma unroll
            for (int k4 = 0; k4 < 16; ++k4) { const f32x4 q = kkp[k4]; r0 += S[4 * k4] * q.x; r1 += S[4 * k4 + 1] * q.y; r2 += S[4 * k4 + 2] * q.z; r3 += S[4 * k4 + 3] * q.w; }
            const float rem = (r0 + r1) + (r2 + r3);
            float y0 = 0.f, y1 = 0.f, y2 = 0.f, y3 = 0.f;
#pragma unroll
            for (int k4 = 0; k4 < 16; ++k4) { const f32x4 w = wp[k4], b = bp[k4], kd = kdp[k4], r = rp[k4];
                S[4 * k4]     = S[4 * k4]     * w.x - rem * b.x + v * kd.x; y0 += S[4 * k4] * r.x;
                S[4 * k4 + 1] = S[4 * k4 + 1] * w.y - rem * b.y + v * kd.y; y1 += S[4 * k4 + 1] * r.y;
                S[4 * k4 + 2] = S[4 * k4 + 2] * w.z - rem * b.z + v * kd.z; y2 += S[4 * k4 + 2] * r.z;
                S[4 * k4 + 3] = S[4 * k4 + 3] * w.w - rem * b.w + v * kd.w; y3 += S[4 * k4 + 3] * r.w; }
            const int t = dir ? T - 1 - (st + i) : st + i;
            YS[(size_t)(sb + t) * 512] = (bf16_t)f2bf((y0 + y1) + (y2 + y3));
        }
        asm volatile("" ::: "memory");
    }
    if (s < 16) { float* so = F.out + OUT_SR + ((((size_t)s * 2 + dir) * 8 + h) * 64 + lane) * 64;
#pragma unroll
        for (int k4 = 0; k4 < 16; ++k4) *(f32x4*)(so + 4 * k4) = (f32x4){S[4 * k4], S[4 * k4 + 1], S[4 * k4 + 2], S[4 * k4 + 3]}; }
}

__device__ __forceinline__ f32x4 mma16(const LAS unsigned char* A, int sa, const LAS unsigned char* B, int sb, int K, f32x4 acc, int fr, int fq) {
#pragma unroll
    for (int k0 = 0; k0 < K; k0 += 32) {
        const bf16x8 av = *(const LAS bf16x8*)(A + fr * sa + (k0 + fq * 8) * 2);
        const bf16x8 bv = *(const LAS bf16x8*)(B + fr * sb + (k0 + fq * 8) * 2);
        acc = __builtin_amdgcn_mfma_f32_16x16x32_bf16(av, bv, acc, 0, 0, 0);
    }
    return acc;
}
constexpr int ML_QS = 0, ML_KS = 17408, ML_CB = 34816, ML_VT = 69632, ML_KT = 88064, ML_SB = 106496, ML_F = 115712;
__device__ __forceinline__ void mlstm_unit(Frame& F, int u) {
    const Args& a = *F.a;
    int s, dir, h;
    if (u < 16) { s = 16 + (u >> 3); dir = (u >> 2) & 1; h = u & 3; } else { const int v = u - 16; s = v >> 3; dir = (v >> 2) & 1; h = v & 3; }
    const int sb = seq_base(s), T = seq_len(s), tid = F.tid, lane = F.lane, w = F.wave, fr = lane & 15, fq = lane >> 4;
    LAS unsigned char* L = F.lds;
    LAS float* fv = (LAS float*)(L + ML_F);
    LAS float *va = fv, *vM = fv + 64, *vinter = fv + 128, *veneg = fv + 192, *vwj = fv + 256, *vrs = fv + 320, *vden = fv + 384, *vli = fv + 448, *vlf = fv + 512, *vn = fv + 576, *scal = fv + 704;
    const bf16_t* MQ = (const bf16_t*)(F.ws + WS_MQ) + h * 128; const bf16_t* MK = (const bf16_t*)(F.ws + WS_MK) + h * 128;
    const bf16_t* ZV = (const bf16_t*)(F.ws + WS_Z) + ZM_V + h * 128;
    const float* LI = (const float*)(F.ws + WS_LI) + (size_t)(dir * 4 + h) * NTOK; const float* LF = (const float*)(F.ws + WS_LF) + (size_t)(dir * 4 + h) * NTOK;
    bf16_t* HS = (bf16_t*)F.out + (size_t)(2 + dir) * NTOK * 512 + h * 128;
    f32x4 accC[8];
    float m;
    __syncthreads();
    if (s >= 16) {
        const size_t sidx = ((size_t)(s - 16) * 2 + dir) * 4 + h;
        const float* c0 = a.in[I_SC] + sidx * 16384;
#pragma unroll
        for (int nt = 0; nt < 8; ++nt)
#pragma unroll
            for (int j = 0; j < 4; ++j) accC[nt][j] = c0[(size_t)(16 * w + fq * 4 + j) * 128 + 16 * nt + fr];
        if (tid < 128) vn[tid] = a.in[I_SN][sidx * 128 + tid];
        m = a.in[I_SM][sidx];
    } else {
#pragma unroll
        for (int nt = 0; nt < 8; ++nt) accC[nt] = (f32x4){0.f, 0.f, 0.f, 0.f};
        if (tid < 128) vn[tid] = 0.f;
        m = 0.f;
    }
#pragma unroll
    for (int nt = 0; nt < 8; ++nt)
#pragma unroll
        for (int j = 0; j < 4; ++j) *(LAS bf16_t*)(L + ML_CB + (16 * w + fq * 4 + j) * 272 + (16 * nt + fr) * 2) = (bf16_t)f2bf(accC[nt][j]);
    const int nch = T / 64;
    for (int ch = 0; ch < nch; ++ch) {
        {
            const int j = tid >> 3, part = tid & 7, p = ch * 64 + j, t = dir ? T - 1 - p : p; const size_t tok = (size_t)(sb + t);
            const u32x4 q0 = *(const u32x4*)(MQ + tok * 512 + part * 16), q1 = *(const u32x4*)(MQ + tok * 512 + part * 16 + 8);
            const u32x4 k0 = *(const u32x4*)(MK + tok * 512 + part * 16), k1 = *(const u32x4*)(MK + tok * 512 + part * 16 + 8);
            const u32x4 v0 = *(const u32x4*)(ZV + tok * ZC + part * 16), v1 = *(const u32x4*)(ZV + tok * ZC + part * 16 + 8);
            *(LAS u32x4*)(L + ML_QS + j * 272 + part * 32) = q0; *(LAS u32x4*)(L + ML_QS + j * 272 + part * 32 + 16) = q1;
            *(LAS u32x4*)(L + ML_KS + j * 272 + part * 32) = k0; *(LAS u32x4*)(L + ML_KS + j * 272 + part * 32 + 16) = k1;
            const unsigned kw[8] = {k0.x, k0.y, k0.z, k0.w, k1.x, k1.y, k1.z, k1.w}, vw[8] = {v0.x, v0.y, v0.z, v0.w, v1.x, v1.y, v1.z, v1.w};
#pragma unroll
            for (int i = 0; i < 8; ++i) { const int c0 = part * 16 + 2 * i;
                *(LAS bf16_t*)(L + ML_KT + c0 * 144 + j * 2) = (bf16_t)(kw[i] & 0xffffu); *(LAS bf16_t*)(L + ML_KT + (c0 + 1) * 144 + j * 2) = (bf16_t)(kw[i] >> 16);
                *(LAS bf16_t*)(L + ML_VT + c0 * 144 + j * 2) = (bf16_t)(vw[i] & 0xffffu); *(LAS bf16_t*)(L + ML_VT + (c0 + 1) * 144 + j * 2) = (bf16_t)(vw[i] >> 16); }
            if (tid < 64) { const int p2 = ch * 64 + tid, t2 = dir ? T - 1 - p2 : p2; vli[tid] = LI[sb + t2]; vlf[tid] = LF[sb + t2]; vrs[tid] = 0.f; }
        }
        __syncthreads();
        if (w == 0) {
            float b = vlf[lane];
#pragma unroll
            for (int o = 1; o < 64; o <<= 1) { const float t = __shfl_up(b, o); if (lane >= o) b += t; }
            const float av = vli[lane] - b; float mx = av;
#pragma unroll
            for (int o = 1; o < 64; o <<= 1) { const float t = __shfl_up(mx, o); if (lane >= o) mx = fmaxf(mx, t); }
            const float M = fmaxf(m, mx);
            va[lane] = av; vM[lane] = M; vinter[lane] = __expf(m - M); veneg[lane] = __expf(-b - M);
            const float bL = __shfl(b, 63), Mf = __shfl(M, 63);
            vwj[lane] = __expf(av - Mf);
            if (lane == 0) { scal[0] = __expf(m - Mf); scal[1] = bL + Mf; }
        }
        __syncthreads();
        const float carry = scal[0]; m = scal[1];
#pragma unroll
        for (int i = 0; i < 2; ++i) { const int t = 2 * w + i, tr = t >> 2, tc = t & 3;
            f32x4 acc = mma16(L + ML_QS + tr * 16 * 272, 272, L + ML_KS + tc * 16 * 272, 272, 128, (f32x4){0.f, 0.f, 0.f, 0.f}, fr, fq);
            const int jj = tc * 16 + fr; const float aj = va[jj];
#pragma unroll
            for (int j = 0; j < 4; ++j) { const int sr = tr * 16 + fq * 4 + j; const float val = (jj <= sr) ? acc[j] * __expf(aj - vM[sr]) : 0.f;
                *(LAS bf16_t*)(L + ML_SB + sr * 144 + jj * 2) = (bf16_t)f2bf(val); (void)__hip_atomic_fetch_add(vrs + sr, val, __ATOMIC_RELAXED, __HIP_MEMORY_SCOPE_WORKGROUP); } }
        __syncthreads();
        { const int sr = tid >> 3, part = tid & 7; float qn = 0.f;
#pragma unroll
            for (int i = 0; i < 16; ++i) qn += bf2f(*(const LAS bf16_t*)(L + ML_QS + sr * 272 + (part * 16 + i) * 2)) * vn[part * 16 + i];
            qn += __shfl_xor(qn, 1); qn += __shfl_xor(qn, 2); qn += __shfl_xor(qn, 4);
            if (part == 0) vden[sr] = vinter[sr] * qn + vrs[sr]; }
        __syncthreads();
#pragma unroll
        for (int i = 0; i < 4; ++i) { const int t = 4 * w + i, tr = t >> 3, tc = t & 7;
            const f32x4 a1 = mma16(L + ML_QS + tr * 16 * 272, 272, L + ML_CB + tc * 16 * 272, 272, 128, (f32x4){0.f, 0.f, 0.f, 0.f}, fr, fq);
            const f32x4 a2 = mma16(L + ML_SB + tr * 16 * 144, 144, L + ML_VT + tc * 16 * 144, 144, 64, (f32x4){0.f, 0.f, 0.f, 0.f}, fr, fq);
#pragma unroll
            for (int j = 0; j < 4; ++j) { const int sr = tr * 16 + fq * 4 + j, p = ch * 64 + sr, tt = dir ? T - 1 - p : p;
                const float hv = (vinter[sr] * a1[j] + a2[j]) / fmaxf(fabsf(vden[sr]), veneg[sr]);
                HS[(size_t)(sb + tt) * 512 + tc * 16 + fr] = (bf16_t)f2bf(hv); } }
        __syncthreads();
        { const int v = tid >> 2, c0 = (tid & 3) * 16;
#pragma unroll
            for (int i = 0; i < 16; ++i) { LAS bf16_t* p = (LAS bf16_t*)(L + ML_VT + v * 144 + (c0 + i) * 2); *p = (bf16_t)f2bf(bf2f(*p) * vwj[c0 + i]); }
            if (tid < 128) { float sacc = 0.f;
#pragma unroll 8
                for (int j = 0; j < 64; ++j) sacc += vwj[j] * bf2f(*(const LAS bf16_t*)(L + ML_KT + tid * 144 + j * 2));
                vn[tid] = carry * vn[tid] + sacc; } }
        __syncthreads();
#pragma unroll
        for (int nt = 0; nt < 8; ++nt) { accC[nt] = accC[nt] * carry;
            accC[nt] = mma16(L + ML_VT + 16 * w * 144, 144, L + ML_KT + 16 * nt * 144, 144, 64, accC[nt], fr, fq);
#pragma unroll
            for (int j = 0; j < 4; ++j) *(LAS bf16_t*)(L + ML_CB + (16 * w + fq * 4 + j) * 272 + (16 * nt + fr) * 2) = (bf16_t)f2bf(accC[nt][j]); }
        __syncthreads();
    }
    if (s < 16) {
        const size_t sidx = ((size_t)s * 2 + dir) * 4 + h;
        float* co = F.out + OUT_SC + sidx * 16384;
#pragma unroll
        for (int nt = 0; nt < 8; ++nt)
#pragma unroll
            for (int j = 0; j < 4; ++j) co[(size_t)(16 * w + fq * 4 + j) * 128 + 16 * nt + fr] = accC[nt][j];
        if (tid < 128) F.out[OUT_SN + sidx * 128 + tid] = vn[tid];
        if (tid == 0) F.out[OUT_SM + sidx] = m;
    }
}
__device__ __forceinline__ void p4_scans(Frame& F) {
    if (blockIdx.x < 144) { mlstm_unit(F, blockIdx.x); }
    else { const int u = F.wave * 112 + ((int)blockIdx.x - 144); if (u < 288) rwkv_scan_unit(F, u, (LAS float*)(F.lds + F.wave * 12288)); }
}

__device__ __forceinline__ void p5_post(Frame& F) {
    const Args& a = *F.a; const int lane = F.lane;
    const bf16_t* YS = (const bf16_t*)F.out; const bf16_t* HS = (const bf16_t*)F.out + (size_t)2 * NTOK * 512;
    for (int tok = F.gw; tok < NTOK; tok += F.NGW) {
        float y0[8], y1[8], v[8], g[8], o[8], r[8];
        unpack8(*(const u32x4*)(YS + (size_t)tok * 512 + 8 * lane), y0); unpack8(*(const u32x4*)(YS + ((size_t)NTOK + tok) * 512 + 8 * lane), y1);
        unpack8(*(const u32x4*)((const bf16_t*)(F.ws + WS_PV) + (size_t)tok * 512 + 8 * lane), v); unpack8(*(const u32x4*)((const bf16_t*)(F.ws + WS_PG) + (size_t)tok * 512 + 8 * lane), g);
        float sm = 0.f;
#pragma unroll
        for (int i = 0; i < 8; ++i) { y0[i] += y1[i]; sm += y0[i]; }
        sm += __shfl_xor(sm, 1); sm += __shfl_xor(sm, 2); sm += __shfl_xor(sm, 4);
        const float mean = sm * (1.f / 64.f); float vs = 0.f;
#pragma unroll
        for (int i = 0; i < 8; ++i) { y0[i] -= mean; vs += y0[i] * y0[i]; }
        vs += __shfl_xor(vs, 1); vs += __shfl_xor(vs, 2); vs += __shfl_xor(vs, 4);
        const float rstd = rsqrtf(vs * (1.f / 64.f) + 64e-5f), bon = ((const float*)(F.ws + WS_BON))[(size_t)tok * 8 + (lane >> 3)];
#pragma unroll
        for (int i = 0; i < 8; ++i) { const int c = 8 * lane + i; r[i] = (y0[i] * rstd * a.in[I_LNG][c] + a.in[I_LNB][c] + bon * v[i]) * g[i]; }
        *(u32x4*)((bf16_t*)(F.ws + WS_YRB) + (size_t)tok * 512 + 8 * lane) = pack8(r);
        unpack8(*(const u32x4*)(HS + (size_t)tok * 512 + 8 * lane), y0); unpack8(*(const u32x4*)(HS + ((size_t)NTOK + tok) * 512 + 8 * lane), y1);
        unpack8(*(const u32x4*)((const bf16_t*)(F.ws + WS_Z) + (size_t)tok * ZC + ZM_O + 8 * lane), o);
        sm = 0.f;
#pragma unroll
        for (int i = 0; i < 8; ++i) { y0[i] += y1[i]; sm += y0[i]; }
        sm += __shfl_xor(sm, 1); sm += __shfl_xor(sm, 2); sm += __shfl_xor(sm, 4); sm += __shfl_xor(sm, 8);
        const float mean2 = sm * (1.f / 128.f); vs = 0.f;
#pragma unroll
        for (int i = 0; i < 8; ++i) { y0[i] -= mean2; vs += y0[i] * y0[i]; }
        vs += __shfl_xor(vs, 1); vs += __shfl_xor(vs, 2); vs += __shfl_xor(vs, 4); vs += __shfl_xor(vs, 8);
        const float rstd2 = rsqrtf(vs * (1.f / 128.f) + 1e-5f);
#pragma unroll
        for (int i = 0; i < 8; ++i) { const int c = 8 * lane + i; r[i] = y0[i] * rstd2 * a.in[I_MGNG][c] * sigm(o[i]); }
        *(u32x4*)((bf16_t*)(F.ws + WS_YMB) + (size_t)tok * 512 + 8 * lane) = pack8(r);
    }
}

__device__ __forceinline__ void p8_rows(Frame& F) {
    const Args& a = *F.a; const float* ng = a.in[I_NORMG];
    for (int row = F.gw; row < NTOK; row += F.NGW) {
        const f32x4* xr = (const f32x4*)xrow_ptr(a, row) + F.lane; const f32x4* orow = (const f32x4*)((const float*)(F.ws + WS_Z) + (size_t)row * D) + F.lane;
        const float* mod = (const float*)(F.ws + WS_MOD) + cond_of(row) * 6144;
        f32x4 v[4]; float ss = 0.f;
#pragma unroll
        for (int j = 0; j < 4; ++j) { v[j] = orow[64 * j]; ss += (v[j].x * v[j].x + v[j].y * v[j].y) + (v[j].z * v[j].z + v[j].w * v[j].w); }
        const float rstd = rsqrtf(wave_sum(ss) * (1.f / D) + 1e-6f);
        f32x4* x1o = (f32x4*)(F.out + (size_t)row * D) + F.lane; ss = 0.f;
#pragma unroll
        for (int j = 0; j < 4; ++j) { const int col = 4 * (64 * j + F.lane);
            const f32x4 g = *(const f32x4*)(ng + 1024 + col), g1 = *(const f32x4*)(mod + 2048 + col);
            v[j] = xr[64 * j] + g1 * (v[j] * rstd * g); x1o[64 * j] = v[j];
            ss += (v[j].x * v[j].x + v[j].y * v[j].y) + (v[j].z * v[j].z + v[j].w * v[j].w); }
        const float rstd2 = rsqrtf(wave_sum(ss) * (1.f / D) + 1e-6f);
        u32x2* o = (u32x2*)((bf16_t*)(F.ws + WS_H) + (size_t)row * D) + F.lane;
#pragma unroll
        for (int j = 0; j < 4; ++j) { const int col = 4 * (64 * j + F.lane);
            const f32x4 g = *(const f32x4*)(ng + 2048 + col), sh = *(const f32x4*)(mod + 3072 + col), sc = *(const f32x4*)(mod + 4096 + col);
            const f32x4 h = v[j] * rstd2 * g * (sc + 1.f) + sh;
            u32x2 w; w.x = pk2(h.x, h.y); w.y = pk2(h.z, h.w); o[64 * j] = w; }
    }
}

__device__ __forceinline__ void p10_ffn_conv(Frame& F) {
    const Args& a = *F.a;
    const bf16_t* U = (const bf16_t*)(F.ws + WS_Z); bf16_t* FIN = (bf16_t*)(F.ws + WS_FIN);
    const float* cw = a.in[I_FCONV]; const float* cb = a.in[I_FCB];
    for (long it = (long)blockIdx.x * 512 + F.tid; it < (long)NTOK * 352; it += (long)F.G * 512) {
        const int tok = (int)(it / 352), c8 = (int)(it - (long)tok * 352) * 8;
        float acc[8], x[8];
#pragma unroll
        for (int i = 0; i < 8; ++i) acc[i] = cb[c8 + i];
        if (tok < NCTX) { const int t = tok & 255;
#pragma unroll
            for (int dx = -1; dx <= 1; ++dx) { const int tt = t + dx; if (tt >= 0 && tt < 256) { unpack8(*(const u32x4*)(U + (size_t)(tok + dx) * UPC + c8), x);
                const float* wp = cw + (3 + dx + 1) * DFF + c8;
#pragma unroll
                for (int i = 0; i < 8; ++i) acc[i] += wp[i] * x[i]; } }
        } else { const int t = (tok - NCTX) & 2047, y = t >> 6, xx0 = t & 63;
#pragma unroll
            for (int dy = -1; dy <= 1; ++dy)
#pragma unroll
                for (int dx = -1; dx <= 1; ++dx) { const int yy = y + dy, xx = xx0 + dx;
                    if (yy >= 0 && yy < 32 && xx >= 0 && xx < 64) { unpack8(*(const u32x4*)(U + (size_t)(tok + dy * 64 + dx) * UPC + c8), x);
                        const float* wp = cw + ((dy + 1) * 3 + dx + 1) * DFF + c8;
#pragma unroll
                        for (int i = 0; i < 8; ++i) acc[i] += wp[i] * x[i]; } }
        }
        unpack8(*(const u32x4*)(U + (size_t)tok * UPC + DFF + c8), x);
        float r[8];
#pragma unroll
        for (int i = 0; i < 8; ++i) r[i] = silu(acc[i]) * x[i];
        *(u32x4*)(FIN + (size_t)tok * DFF + c8) = pack8(r);
    }
}

__device__ __forceinline__ void p12_final(Frame& F) {
    const Args& a = *F.a; const float* ng = a.in[I_NORMG];
    for (int row = F.gw; row < NTOK; row += F.NGW) {
        const f32x4* fr_ = (const f32x4*)((const float*)(F.ws + WS_Z) + (size_t)row * D) + F.lane; f32x4* xo = (f32x4*)(F.out + (size_t)row * D) + F.lane;
        const float* mod = (const float*)(F.ws + WS_MOD) + cond_of(row) * 6144;
        f32x4 v[4]; float ss = 0.f;
#pragma unroll
        for (int j = 0; j < 4; ++j) { v[j] = fr_[64 * j]; ss += (v[j].x * v[j].x + v[j].y * v[j].y) + (v[j].z * v[j].z + v[j].w * v[j].w); }
        const float rstd = rsqrtf(wave_sum(ss) * (1.f / D) + 1e-6f);
#pragma unroll
        for (int j = 0; j < 4; ++j) { const int col = 4 * (64 * j + F.lane);
            const f32x4 g = *(const f32x4*)(ng + 3072 + col), g2 = *(const f32x4*)(mod + 5120 + col);
            xo[64 * j] = xo[64 * j] + g2 * (v[j] * rstd * g); }
    }
}

__global__ void __launch_bounds__(512, 2) trunk_fwd(Args args) {
    extern __shared__ __attribute__((aligned(16))) unsigned char lds_raw[];
    Frame F;
    F.lds = (LAS unsigned char*)lds_raw; F.a = &args;
    F.tid = threadIdx.x; F.lane = F.tid & 63; F.wave = __builtin_amdgcn_readfirstlane(F.tid >> 6);
    F.G = gridDim.x; { const int bx = blockIdx.x; F.vcu = (F.G % 8 == 0) ? (bx % 8) * (F.G / 8) + bx / 8 : bx; }
    F.gw = F.vcu * 8 + F.wave; F.NGW = F.G * 8;
    F.ws = args.ws; F.out = args.out;
    volatile LAS unsigned* MISC = (volatile LAS unsigned*)(F.lds + MISC_OFF);
    if (F.tid < 64) MISC[F.tid] = 0u;
    __syncthreads();
    const int lo = args.ph_lo, hi = args.ph_hi;
    XcdBarrier bar; bar.bar = (unsigned*)(F.ws + WS_CTL) + 4096; bar.x = 0; bar.st = nullptr;
    if (hi - lo > 1) bar = xcd_barrier_post((unsigned*)(F.ws + WS_CTL) + 4096, MISC + 8);
#define IN(k) (lo <= (k) && (k) < hi)
#define SEAM(k) do { if (IN(k) && IN((k) + 1)) xcd_barrier(bar); } while (0)
    if (IN(0)) { p0_prologue(F); } SEAM(0);
    if (IN(1)) { p1_h1(F); } SEAM(1);
    if (IN(2)) { pg8::Gemm g{(const bf16_t*)(F.ws + WS_H), (const bf16_t*)(F.ws + WS_WIN), NTOK, ZC, D}; pg8::StaticOrder S; S.init(NTOK, ZC, F.G, (int)blockIdx.x);
        pg8::EpiBf16 E{(bf16_t*)(F.ws + WS_Z), ZC}; pg8::gemm_phase(F.lds, g, S, E); } SEAM(2);
    if (IN(3)) { p3_prep(F); } SEAM(3);
    if (IN(4)) { p4_scans(F); } SEAM(4);
    if (IN(5)) { p5_post(F); } SEAM(5);
    if (IN(6)) { pg8::StaticOrder S; S.init(NTOK, D, F.G, (int)blockIdx.x);
        { pg8::Gemm g{(const bf16_t*)(F.ws + WS_YRB), (const bf16_t*)(F.ws + WS_WBR), NTOK, D, 512}; pg8::EpiGate<false> E{(bf16_t*)(F.ws + WS_H), (const bf16_t*)(F.ws + WS_Z), ZG_R}; pg8::gemm_phase(F.lds, g, S, E); }
        asm volatile("s_waitcnt vmcnt(0)" ::: "memory"); __syncthreads();
        { pg8::Gemm g{(const bf16_t*)(F.ws + WS_YMB), (const bf16_t*)(F.ws + WS_WBM), NTOK, D, 512}; pg8::EpiGate<true> E{(bf16_t*)(F.ws + WS_H), (const bf16_t*)(F.ws + WS_Z), ZG_M}; pg8::gemm_phase(F.lds, g, S, E); } } SEAM(6);
    if (IN(7)) { pg8::Gemm g{(const bf16_t*)(F.ws + WS_H), (const bf16_t*)(F.ws + WS_WOUT), NTOK, D, D}; pg8::StaticOrder S; S.init(NTOK, D, F.G, (int)blockIdx.x);
        pg8::EpiF32 E{(float*)(F.ws + WS_Z), D}; pg8::gemm_phase(F.lds, g, S, E); } SEAM(7);
    if (IN(8)) { p8_rows(F); } SEAM(8);
    if (IN(9)) { pg8::Gemm g{(const bf16_t*)(F.ws + WS_H), (const bf16_t*)(F.ws + WS_WUP), NTOK, UPC, D}; pg8::StaticOrder S; S.init(NTOK, UPC, F.G, (int)blockIdx.x);
        pg8::EpiBf16 E{(bf16_t*)(F.ws + WS_Z), UPC}; pg8::gemm_phase(F.lds, g, S, E); } SEAM(9);
    if (IN(10)) { p10_ffn_conv(F); } SEAM(10);
    if (IN(11)) { pg8::Gemm g{(const bf16_t*)(F.ws + WS_FIN), (const bf16_t*)(F.ws + WS_WDN), NTOK, D, DFF}; pg8::StaticOrder S; S.init(NTOK, D, F.G, (int)blockIdx.x);
        pg8::EpiF32 E{(float*)(F.ws + WS_Z), D}; pg8::gemm_phase(F.lds, g, S, E); } SEAM(11);
    if (IN(12)) { p12_final(F); }
#undef IN
#undef SEAM
}

extern "C" void kernel_launch(void* const* d_in, const int* in_sizes, int n_in, void* d_out, int out_size, void* d_ws, size_t ws_size, hipStream_t stream) {
    if (n_in != 33 || (size_t)out_size != OUT_TOTAL || ws_size < WS_END) {
        fprintf(stderr, "kernel_launch: unexpected problem (n_in %d, out %d, ws %zu)\n", n_in, out_size, ws_size); return; }
    (void)hipFuncSetAttribute((const void*)trunk_fwd, hipFuncAttributeMaxDynamicSharedMemorySize, LDS_BYTES);
    (void)hipMemsetAsync((char*)d_ws + WS_CTL, 0, CTL_ZERO_BYTES, stream);
    Args a{};
    for (int i = 0; i < 33; ++i) a.in[i] = (const float*)d_in[i];
    a.out = (float*)d_out; a.ws = (unsigned char*)d_ws;
#if MK_ONE_LAUNCH
    a.ph_lo = 0; a.ph_hi = NPH;
    hipLaunchKernelGGL(trunk_fwd, dim3(256), dim3(512), LDS_BYTES, stream, a);
#else
    for (int p = 0; p < NPH; ++p) { a.ph_lo = p; a.ph_hi = p + 1; hipLaunchKernelGGL(trunk_fwd, dim3(256), dim3(512), LDS_BYTES, stream, a); }
#endif
}
```

```cpp
#include <hip/hip_runtime.h>
#include <cstdio>
#include <cstdint>

#define GAS __attribute__((address_space(1)))
#define LAS __attribute__((address_space(3)))
typedef unsigned short bf16_t;
typedef short bf16x8 __attribute__((ext_vector_type(8)));
typedef float f32x4 __attribute__((ext_vector_type(4)));
typedef float f32x2 __attribute__((ext_vector_type(2)));
typedef unsigned u32x4 __attribute__((ext_vector_type(4)));
typedef unsigned u32x2 __attribute__((ext_vector_type(2)));

#ifndef MK_ONE_LAUNCH
#define MK_ONE_LAUNCH 1
#endif

constexpr int D = 1024, NTOK = 8192, NCTX = 4096;
constexpr int ZC = 6144;
constexpr int DFF = 2816, UPC = 5632;
constexpr int NPH = 13;
constexpr int ZR_R = 0, ZR_K = 512, ZR_V = 1024, ZR_WD = 1536, ZR_AD = 1664, ZR_GD = 1792;
constexpr int Z1C = 3072, Z2C = 3072;
constexpr int ZM_Q = 1920, ZM_K = 2432, ZM_G = 2944;
constexpr int Z2_V = 0, Z2_O = 512, Z2_GR = 1024, Z2_GM = 2048;

constexpr size_t MiB = 1u << 20;
constexpr size_t WS_CTL = 0, CTL_ZERO_BYTES = 64 * 1024;
constexpr size_t WS_MOD = 1 * MiB;
constexpr size_t WS_LI = 1 * MiB + 256 * 1024;
constexpr size_t WS_LF = 1 * MiB + 512 * 1024;
constexpr size_t WS_BON = 1 * MiB + 768 * 1024;
constexpr size_t WS_WIN = 2 * MiB;
constexpr size_t WS_WBR = 14 * MiB;
constexpr size_t WS_WBM = 15 * MiB;
constexpr size_t WS_WOUT = 16 * MiB;
constexpr size_t WS_WUP = 18 * MiB;
constexpr size_t WS_WDN = 29 * MiB;
constexpr size_t WS_H = 35 * MiB;
constexpr size_t WS_Z = 51 * MiB;
constexpr size_t WS_Z1 = WS_Z, WS_Z2 = WS_Z + 48 * MiB;
constexpr size_t WS_P = 147 * MiB;
constexpr size_t WS_PR = WS_P, WS_PV = WS_P + 8 * MiB, WS_PKK = WS_P + 16 * MiB;
constexpr size_t WS_PW = WS_P + 24 * MiB, WS_PKD = WS_P + 40 * MiB, WS_PB = WS_P + 56 * MiB;
constexpr size_t WS_PG = WS_P + 72 * MiB;
constexpr size_t WS_YRB = WS_P, WS_YMB = WS_P + 16 * MiB;
constexpr size_t WS_FIN = WS_P;
constexpr size_t WS_MQ = 227 * MiB, WS_MK = 235 * MiB;
constexpr size_t WS_DCC = WS_Z1 + 32 * MiB;
constexpr size_t WS_DCL = WS_H;
constexpr size_t WS_PRM = WS_Z1;
constexpr size_t WS_OUT1 = WS_P;
constexpr size_t WS_X1B = WS_P + 64 * MiB;
constexpr size_t WS_SP = WS_Z1;
constexpr size_t WS_DN = 243 * MiB;
constexpr size_t WS_MS = 243 * MiB + 512 * 1024;
constexpr size_t WS_WUPT = 243 * MiB + 576 * 1024, WS_AUPT = WS_WUPT + 131072, WS_GUPT = WS_WUPT + 262144;
constexpr size_t WS_END = 244 * MiB;
constexpr size_t OUT_YP = 0, OUT_SR = 8388608, OUT_SC = OUT_SR + 1048576, OUT_SN = OUT_SC + 2097152, OUT_SM = OUT_SN + 16384, OUT_TOTAL = OUT_SM + 128;

constexpr int LDS_BYTES = 163840;
constexpr int MISC_OFF = LDS_BYTES - 256;

#define LDS_WAIT() asm volatile("s_waitcnt lgkmcnt(0)" ::: "memory")
#define VM_WAIT() asm volatile("s_waitcnt vmcnt(0)" ::: "memory")

__device__ __forceinline__ float bf2f(unsigned v) { return __builtin_bit_cast(float, v << 16); }
__device__ __forceinline__ unsigned f2bf(float f) { unsigned u = __builtin_bit_cast(unsigned, f); return (u + 0x7fffu + ((u >> 16) & 1u)) >> 16; }
typedef __bf16 bf16v2_t __attribute__((ext_vector_type(2)));
__device__ __forceinline__ unsigned cvt_pk(float lo, float hi) { const f32x2 v = {lo, hi}; return __builtin_bit_cast(unsigned, __builtin_convertvector(v, bf16v2_t)); }
__device__ __forceinline__ unsigned pk2(float lo, float hi) { return cvt_pk(lo, hi); }
__device__ __forceinline__ void st16_wt(void* p, const u32x4 v) { asm volatile("global_store_dwordx4 %0, %1, off sc1\n\ts_nop 1" :: "v"(p), "v"(v) : "memory"); }
__device__ __forceinline__ float sigm(float x) { return 1.f / (1.f + __expf(-x)); }
__device__ __forceinline__ float silu(float x) { return x / (1.f + __expf(-x)); }
__device__ __forceinline__ float wave_sum(float v) {
#pragma unroll
    for (int o = 1; o < 64; o <<= 1) v += __shfl_xor(v, o);
    return v;
}
__device__ __forceinline__ void unpack8(const u32x4 w, float (&f)[8]) {
    f[0] = bf2f(w.x & 0xffffu); f[1] = bf2f(w.x >> 16); f[2] = bf2f(w.y & 0xffffu); f[3] = bf2f(w.y >> 16);
    f[4] = bf2f(w.z & 0xffffu); f[5] = bf2f(w.z >> 16); f[6] = bf2f(w.w & 0xffffu); f[7] = bf2f(w.w >> 16);
}
__device__ __forceinline__ u32x4 pack8(const float (&f)[8]) { u32x4 w; w.x = pk2(f[0], f[1]); w.y = pk2(f[2], f[3]); w.z = pk2(f[4], f[5]); w.w = pk2(f[6], f[7]); return w; }

#define XB_TMO      128
#define XB_XCNT(j)  (256  + 64 * (j))
#define XB_XSUB(j)  (1280 + 64 * (j))
#define XB_XGEN(j)  (2304 + 64 * (j))
#define XB_TOP      3328
#define XB_TOPGEN   3392
#define XCD_BAR_WORDS 3456
#define XB_SPIN_CAP (1u << 22)
__device__ __forceinline__ unsigned xb_ld(unsigned* p)              { return __hip_atomic_load(p, __ATOMIC_RELAXED, __HIP_MEMORY_SCOPE_AGENT); }
__device__ __forceinline__ unsigned xb_add(unsigned* p, unsigned v) { return __hip_atomic_fetch_add(p, v, __ATOMIC_RELAXED, __HIP_MEMORY_SCOPE_AGENT); }
__device__ __forceinline__ unsigned xb_xcc_id() { return (unsigned)__builtin_amdgcn_s_getreg((3 << 11) | 20) & 0xFu; }
#define XB_SPIN(cond, bar) do { unsigned _sp = 0; while (cond) { __builtin_amdgcn_s_sleep(1); \
    if ((++_sp & 255u) == 0u) { if (xb_ld(&(bar)[XB_TMO])) break; if (_sp > XB_SPIN_CAP) { atomicAdd(&(bar)[XB_TMO], 1u); break; } } } } while (0)
struct XcdBarrier { unsigned* bar; unsigned x; volatile LAS unsigned* st; };
__device__ __forceinline__ XcdBarrier xcd_barrier_post(unsigned* bar, volatile LAS unsigned* st) {
    XcdBarrier b; b.bar = bar; b.x = xb_xcc_id(); b.st = st;
    if (threadIdx.x == 0) (void)xb_add(&bar[XB_XCNT(b.x)], 1u);
    return b;
}
__device__ __forceinline__ void xcd_barrier_complete(unsigned* bar, unsigned x, unsigned& nloc, unsigned& nx) {
    const unsigned G = gridDim.x * gridDim.y * gridDim.z;
    unsigned sum, cnt, mine, sp = 0u;
    for (;;) {
        sum = 0u; cnt = 0u; mine = 0u;
#pragma unroll
        for (unsigned j = 0; j < 16; ++j) { const unsigned c = xb_ld(&bar[XB_XCNT(j)]); sum += c; cnt += (c > 0u) ? 1u : 0u; mine = (j == x) ? c : mine; }
        if (sum == G) break;
        __builtin_amdgcn_s_sleep(1);
        if ((++sp & 255u) == 0u) { if (xb_ld(&bar[XB_TMO])) break; if (sp > XB_SPIN_CAP) { atomicAdd(&bar[XB_TMO], 1u); break; } }
    }
    nloc = mine > 0u ? mine : 1u; nx = cnt > 0u ? cnt : 1u;
}
__device__ __forceinline__ void xcd_barrier(const XcdBarrier& b) {
    asm volatile("s_waitcnt vmcnt(0)" ::: "memory");
    __syncthreads();
    if (threadIdx.x == 0) {
        unsigned* bar = b.bar;
        __builtin_amdgcn_s_waitcnt(0);
        unsigned nloc = b.st[0], nx = b.st[1];
        if (nloc == 0u) { xcd_barrier_complete(bar, b.x, nloc, nx); b.st[0] = nloc; b.st[1] = nx; }
        const unsigned old = xb_add(&bar[XB_XSUB(b.x)], 1u);
        const unsigned gen = old / nloc;
        if (old + 1u == (gen + 1u) * nloc) {
            __builtin_amdgcn_fence(__ATOMIC_RELEASE, "agent");
            asm volatile("s_waitcnt vmcnt(0)" ::: "memory");
            const unsigned og = xb_add(&bar[XB_TOP], 1u);
            const unsigned tg = og / nx;
            if (og + 1u == (tg + 1u) * nx) {
#pragma unroll
                for (unsigned j = 0; j < 16; ++j) (void)__hip_atomic_fetch_add(&bar[XB_XGEN(j)], 1u, __ATOMIC_RELAXED, __HIP_MEMORY_SCOPE_AGENT);
            } else XB_SPIN(xb_ld(&bar[XB_XGEN(b.x)]) == gen, bar);
            __builtin_amdgcn_fence(__ATOMIC_ACQUIRE, "agent");
            asm volatile("s_waitcnt vmcnt(0)" ::: "memory");
        } else {
            XB_SPIN(xb_ld(&bar[XB_XGEN(b.x)]) == gen, bar);
            __builtin_amdgcn_fence(__ATOMIC_ACQUIRE, "agent");
            asm volatile("s_waitcnt vmcnt(0)" ::: "memory");
        }
    }
    __syncthreads();
}

__device__ __forceinline__ float dpp_ror1(float v) { return __builtin_bit_cast(float, __builtin_amdgcn_update_dpp(0, __builtin_bit_cast(int, v), 0x121, 0xF, 0xF, false)); }
__device__ __forceinline__ float dpp_rol1(float v) { return __builtin_bit_cast(float, __builtin_amdgcn_update_dpp(0, __builtin_bit_cast(int, v), 0x12F, 0xF, 0xF, false)); }
namespace pg8 {
constexpr int BM = 256, BK = 64, HALF = 128, HTB = HALF * BK * 2, STAGE_BYTES = 8 * HTB, NXCD = 8, WGM = 8;
__host__ __device__ __forceinline__ int lds_byte(int r, int c) { const int st = (r >> 4) * 2 + (c >> 5), rr = r & 15, cc = c & 31, ob = rr * 64 + cc * 2; return st * 1024 + (ob ^ (((ob >> 9) & 1) << 5)); }
__host__ __device__ __forceinline__ void stage_rc(int b, int& R, int& C) { const int st = b / 1024, sb = b % 1024, swz = sb ^ (((sb >> 9) & 1) << 5); R = (st >> 1) * 16 + swz / 64; C = (st & 1) * 32 + (swz % 64) / 2; }
__host__ __device__ __forceinline__ int perm32(int rho) { const int n = rho >> 4, i = rho & 15; return 8 * (i >> 2) + 4 * n + (i & 3); }
struct Unit { const char* a; const char* b; int pm, pn, z; };
struct Gemm { int K, lda, ldb; };
struct StaticOrder {
    int nM, nN, nZ, nwg, G, c, lda, ldb; const bf16_t* Az[2]; const bf16_t* Bz[2];
    __device__ void init(int M, int N, int nZ_, int G_, int c_, const Gemm& g, const bf16_t* A0, const bf16_t* B0, const bf16_t* A1, const bf16_t* B1) {
        nM = M / BM; nZ = nZ_; nN = (N / BM) * nZ_; nwg = nM * nN; G = G_; c = c_; lda = g.lda; ldb = g.ldb; Az[0] = A0; Az[1] = A1; Bz[0] = B0; Bz[1] = B1; }
    __device__ bool next(int i, Unit& u) const {
        const long L = (long)i * G + c; if (L >= nwg) return false;
        int wgid = (int)L; { const int q = nwg / NXCD, r = nwg % NXCD, xcd = wgid % NXCD, off = wgid / NXCD; wgid = (xcd < r ? xcd * (q + 1) : r * (q + 1) + (xcd - r) * q) + off; }
        const int nig = WGM * nN, gid = wgid / nig, fm = gid * WGM, gsz = (nM - fm) < WGM ? (nM - fm) : WGM;
        u.pm = fm + ((wgid % nig) % gsz); const int pnz = (wgid % nig) / gsz; u.pn = pnz / nZ; u.z = pnz - u.pn * nZ;
        u.a = (const char*)(u.z ? Az[1] : Az[0]) + (size_t)u.pm * BM * lda * 2; u.b = (const char*)(u.z ? Bz[1] : Bz[0]) + (size_t)u.pn * BM * ldb * 2; return true;
    }
};

struct EpiBf16 {
    static constexpr bool PERM = true;
    bf16_t* O; int ldc; bf16_t* O2; int split_pn;
    __device__ __forceinline__ void operator()(const f32x4 (&acc)[2][2][4][2], const Unit& u, int wr, int wc, int fr, int fq) const {
        const bool hi = u.pn >= split_pn; bf16_t* Ob = (hi ? O2 : O) + (size_t)u.z * NTOK * ldc;
        const int row0 = u.pm * BM + wr * 64 + fr, col0 = (hi ? u.pn - split_pn : u.pn) * BM + wc * 32 + 8 * fq;
#pragma unroll
        for (int ai = 0; ai < 2; ++ai)
#pragma unroll
            for (int m = 0; m < 4; ++m) { bf16_t* rowp = Ob + (size_t)(row0 + ai * HALF + m * 16) * ldc + col0;
#pragma unroll
                for (int bj = 0; bj < 2; ++bj) { const f32x4 v0 = acc[ai][bj][m][0], v1 = acc[ai][bj][m][1];
                    u32x4 w; w.x = pk2(v0[0], v0[1]); w.y = pk2(v0[2], v0[3]); w.z = pk2(v1[0], v1[1]); w.w = pk2(v1[2], v1[3]);
                    st16_wt(rowp + bj * HALF, w); } }
    }
};
struct EpiGate {
    static constexpr bool PERM = true;
    bf16_t* O; const bf16_t* Z; int gcol0;
    __device__ __forceinline__ void operator()(const f32x4 (&acc)[2][2][4][2], const Unit& u, int wr, int wc, int fr, int fq) const {
        const int row0 = u.pm * BM + wr * 64 + fr, col0 = u.pn * BM + wc * 32 + 8 * fq;
        bf16_t* Ob = O + (size_t)u.z * NTOK * D; const int gc = gcol0 + u.z * D;
#pragma unroll
        for (int ai = 0; ai < 2; ++ai)
#pragma unroll
            for (int m = 0; m < 4; ++m) { const int row = row0 + ai * HALF + m * 16; bf16_t* rowp = Ob + (size_t)row * D + col0; const bf16_t* gp = Z + (size_t)row * Z2C + gc + col0;
#pragma unroll
                for (int bj = 0; bj < 2; ++bj) { const f32x4 v0 = acc[ai][bj][m][0], v1 = acc[ai][bj][m][1];
                    float g[8]; unpack8(*(const u32x4*)(gp + bj * HALF), g);
                    u32x4 w; w.x = cvt_pk(v0[0] * sigm(g[0]), v0[1] * sigm(g[1])); w.y = cvt_pk(v0[2] * sigm(g[2]), v0[3] * sigm(g[3]));
                    w.z = cvt_pk(v1[0] * sigm(g[4]), v1[1] * sigm(g[5])); w.w = cvt_pk(v1[2] * sigm(g[6]), v1[3] * sigm(g[7]));
                    *(u32x4*)(rowp + bj * HALF) = w; } }
    }
};
struct EpiFfnUp {
    static constexpr bool PERM = true;
    bf16_t* U; bf16_t* FIN; const float* cw; const float* cb; LAS float* xch;
    __device__ __forceinline__ void operator()(const f32x4 (&acc)[2][2][4][2], const Unit& u, int wr, int wc, int fr, int fq) const {
        if (u.pm >= NCTX / BM) {
            const int row0 = u.pm * BM + wr * 64 + fr, col0 = u.pn * BM + wc * 32 + 8 * fq;
#pragma unroll
            for (int ai = 0; ai < 2; ++ai)
#pragma unroll
                for (int m = 0; m < 4; ++m) { bf16_t* rowp = U + (size_t)(row0 + ai * HALF + m * 16) * UPC + col0;
#pragma unroll
                    for (int bj = 0; bj < 2; ++bj) { const f32x4 v0 = acc[ai][bj][m][0], v1 = acc[ai][bj][m][1];
                        u32x4 w; w.x = pk2(v0[0], v0[1]); w.y = pk2(v0[2], v0[3]); w.z = pk2(v1[0], v1[1]); w.w = pk2(v1[2], v1[3]);
                        st16_wt(rowp + bj * HALF, w); } }
            return;
        }
        const int cl = wc * 32 + 8 * fq, ch = u.pn * 128 + cl;
#pragma unroll
        for (int ai = 0; ai < 2; ++ai) { const int band = 2 * ai + wr;
            if (fr == 0) { *(LAS f32x4*)(xch + (band * 2 + 0) * 128 + cl) = acc[ai][0][0][0]; *(LAS f32x4*)(xch + (band * 2 + 0) * 128 + cl + 4) = acc[ai][0][0][1]; }
            if (fr == 15) { *(LAS f32x4*)(xch + (band * 2 + 1) * 128 + cl) = acc[ai][0][3][0]; *(LAS f32x4*)(xch + (band * 2 + 1) * 128 + cl + 4) = acc[ai][0][3][1]; } }
        asm volatile("s_waitcnt lgkmcnt(0)" ::: "memory");
        __builtin_amdgcn_s_barrier();
        asm volatile("" ::: "memory"); __builtin_amdgcn_sched_barrier(0);
        float w0[8], w1[8], w2[8], bb[8];
        { const f32x4 a0 = *(const f32x4*)(cw + 3 * DFF + ch), a1 = *(const f32x4*)(cw + 3 * DFF + ch + 4), b0 = *(const f32x4*)(cw + 4 * DFF + ch), b1 = *(const f32x4*)(cw + 4 * DFF + ch + 4);
            const f32x4 c0 = *(const f32x4*)(cw + 5 * DFF + ch), c1 = *(const f32x4*)(cw + 5 * DFF + ch + 4), d0 = *(const f32x4*)(cb + ch), d1 = *(const f32x4*)(cb + ch + 4);
#pragma unroll
            for (int e = 0; e < 4; ++e) { w0[e] = a0[e]; w0[4 + e] = a1[e]; w1[e] = b0[e]; w1[4 + e] = b1[e]; w2[e] = c0[e]; w2[4 + e] = c1[e]; bb[e] = d0[e]; bb[4 + e] = d1[e]; } }
        const int row0 = u.pm * BM + wr * 64 + fr;
#pragma unroll
        for (int ai = 0; ai < 2; ++ai) { const int band = 2 * ai + wr;
            f32x4 ht[2], hb[2];
#pragma unroll
            for (int n = 0; n < 2; ++n) { ht[n] = band > 0 ? *(const LAS f32x4*)(xch + ((band - 1) * 2 + 1) * 128 + cl + 4 * n) : (f32x4){0.f, 0.f, 0.f, 0.f};
                hb[n] = band < 3 ? *(const LAS f32x4*)(xch + ((band + 1) * 2 + 0) * 128 + cl + 4 * n) : (f32x4){0.f, 0.f, 0.f, 0.f}; }
#pragma unroll
            for (int m = 0; m < 4; ++m) { unsigned pk[4];
#pragma unroll
                for (int n = 0; n < 2; ++n) { float o[4];
#pragma unroll
                    for (int e = 0; e < 4; ++e) { const float cur = acc[ai][0][m][n][e];
                        const float rp = dpp_ror1(acc[ai][0][m > 0 ? m - 1 : 0][n][e]), rn = dpp_rol1(acc[ai][0][m < 3 ? m + 1 : 3][n][e]), rc = dpp_ror1(cur), lc = dpp_rol1(cur);
                        const float pt = m > 0 ? rp : ht[n][e], nt_ = m < 3 ? rn : hb[n][e];
                        const float prev = fr > 0 ? rc : pt, next = fr < 15 ? lc : nt_;
                        const float v = bb[4 * n + e] + w0[4 * n + e] * prev + w1[4 * n + e] * cur + w2[4 * n + e] * next;
                        o[e] = silu(v) * acc[ai][1][m][n][e]; }
                    pk[2 * n] = pk2(o[0], o[1]); pk[2 * n + 1] = pk2(o[2], o[3]); }
                u32x4 w; w.x = pk[0]; w.y = pk[1]; w.z = pk[2]; w.w = pk[3];
                st16_wt(FIN + (size_t)(row0 + ai * HALF + m * 16) * DFF + ch, w); } }
    }
};
template <class Epi>
__device__ __forceinline__ void gemm_phase(LAS unsigned char* lds, const Gemm g, const StaticOrder& S, const Epi& E, const int tid) {
    const int wid = __builtin_amdgcn_readfirstlane(tid >> 6), lane = tid & 63, wr = wid >> 2, wc = wid & 3, fr = lane & 15, fq = lane >> 4;
    const int nt = g.K / BK;
    unsigned voffA[2], voffB[2];
#pragma unroll
    for (int i = 0; i < 2; ++i) { int R, C; stage_rc(tid * 16 + i * 8192, R, C); const int Rb = Epi::PERM ? ((R & ~31) + perm32(R & 31)) : R;
        voffA[i] = (unsigned)(R * g.lda + C) * 2u; voffB[i] = (unsigned)(Rb * g.ldb + C) * 2u; }
    const size_t kstep = (size_t)(BK * 2);
    const size_t hstepA = (size_t)HALF * g.lda * 2, hstepB = (size_t)HALF * g.ldb * 2;
    const unsigned ldsw = (unsigned)wid * 1024u;
    const int aoff = lds_byte(wr * 64 + fr, fq * 8), boff = lds_byte(wc * 32 + fr, fq * 8);
#define PG8_SA(b, h) (((b) * 2 + (h)) * HTB)
#define PG8_SB(b, h) ((4 + (b) * 2 + (h)) * HTB)
#define PG8_STAGE(bufoff, gbase, voff) do { _Pragma("unroll") for (int _i = 0; _i < 2; ++_i) \
        __builtin_amdgcn_global_load_lds((const unsigned*)((const char*)(gbase) + (voff)[_i]), (LAS unsigned*)(lds + (bufoff) + ldsw + _i * 8192), 16, 0, 0); } while (0)
#define PG8_LDA(dst, b, h) do { _Pragma("unroll") for (int m = 0; m < 4; ++m) _Pragma("unroll") for (int k = 0; k < 2; ++k) dst[m][k] = *(const LAS bf16x8*)(lds + PG8_SA(b, h) + aoff + m * 2048 + k * 1024); } while (0)
#define PG8_LDB(dst, b, h) do { _Pragma("unroll") for (int n = 0; n < 2; ++n) _Pragma("unroll") for (int k = 0; k < 2; ++k) dst[n][k] = *(const LAS bf16x8*)(lds + PG8_SB(b, h) + boff + n * 2048 + k * 1024); } while (0)
#define PG8_MMA(ai, bj, At, Bt) do { __builtin_amdgcn_s_setprio(1); _Pragma("unroll") for (int m = 0; m < 4; ++m) _Pragma("unroll") for (int n = 0; n < 2; ++n) _Pragma("unroll") for (int k = 0; k < 2; ++k) \
        acc[ai][bj][m][n] = __builtin_amdgcn_mfma_f32_16x16x32_bf16(Bt[n][k], At[m][k], acc[ai][bj][m][n], 0, 0, 0); __builtin_amdgcn_s_setprio(0); } while (0)
#define PG8_WAIT_V(n) asm volatile("s_waitcnt vmcnt(" #n ")" ::: "memory")
#define PG8_WAIT_L(n) asm volatile("s_waitcnt lgkmcnt(" #n ")" ::: "memory")
#define PG8_BAR __builtin_amdgcn_s_barrier()
#define PG8_SCHED __builtin_amdgcn_sched_barrier(0)
    Unit cur, nxt; int ui = 0;
    if (!S.next(0, cur)) return;
    f32x4 acc[2][2][4][2];
#pragma unroll
    for (int a = 0; a < 2; ++a)
#pragma unroll
        for (int b = 0; b < 2; ++b)
#pragma unroll
            for (int m = 0; m < 4; ++m)
#pragma unroll
                for (int n = 0; n < 2; ++n) acc[a][b][m][n] = (f32x4){0.f, 0.f, 0.f, 0.f};
    bf16x8 At[4][2], B0[2][2], B1[2][2];
    const char* cA = cur.a; const char* cB = cur.b;
    PG8_STAGE(PG8_SB(0, 0), cB, voffB); PG8_STAGE(PG8_SB(0, 1), cB + hstepB, voffB); PG8_STAGE(PG8_SA(0, 0), cA, voffA); PG8_STAGE(PG8_SA(0, 1), cA + hstepA, voffA);
    if (wr == 1) PG8_BAR;
    PG8_WAIT_V(2); PG8_BAR;
    PG8_STAGE(PG8_SB(1, 0), cB + kstep, voffB); PG8_STAGE(PG8_SA(1, 0), cA + kstep, voffA); PG8_STAGE(PG8_SB(1, 1), cB + hstepB + kstep, voffB);
    PG8_WAIT_V(6); PG8_BAR;
    for (;;) {
        const bool has_next = S.next(ui + 1, nxt);
        const char* nA = has_next ? nxt.a : cA; const char* nB = has_next ? nxt.b : cB;
        for (int t = 0; t < nt; t += 2) {
            const bool last = (t == nt - 2);
            const char* a1 = cA + (size_t)(t + 1) * kstep;
            const char* a2 = last ? nA : cA + (size_t)(t + 2) * kstep; const char* b2 = last ? nB : cB + (size_t)(t + 2) * kstep;
            const char* a3 = a2 + kstep; const char* b3 = b2 + kstep;
            PG8_LDB(B0, 0, 0); PG8_LDB(B1, 0, 1); PG8_SCHED; PG8_LDA(At, 0, 0); PG8_STAGE(PG8_SA(1, 1), a1 + hstepA, voffA);
            PG8_WAIT_V(8); PG8_WAIT_L(0); PG8_BAR; PG8_MMA(0, 0, At, B0); PG8_MMA(0, 1, At, B1); PG8_BAR; PG8_SCHED;
            PG8_LDA(At, 0, 1); PG8_STAGE(PG8_SB(0, 0), b2, voffB); PG8_STAGE(PG8_SB(0, 1), b2 + hstepB, voffB); PG8_STAGE(PG8_SA(0, 0), a2, voffA);
            PG8_WAIT_V(8); PG8_WAIT_L(0); PG8_BAR; PG8_MMA(1, 0, At, B0); PG8_MMA(1, 1, At, B1); PG8_BAR; PG8_SCHED;
            PG8_LDB(B0, 1, 0); PG8_LDB(B1, 1, 1); PG8_SCHED; PG8_LDA(At, 1, 0); PG8_STAGE(PG8_SA(0, 1), a2 + hstepA, voffA);
            PG8_WAIT_V(8); PG8_WAIT_L(0); PG8_BAR; PG8_MMA(0, 0, At, B0); PG8_MMA(0, 1, At, B1); PG8_BAR; PG8_SCHED;
            PG8_LDA(At, 1, 1); PG8_STAGE(PG8_SB(1, 0), b3, voffB); PG8_STAGE(PG8_SB(1, 1), b3 + hstepB, voffB); PG8_STAGE(PG8_SA(1, 0), a3, voffA);
            PG8_WAIT_V(8); PG8_WAIT_L(0); PG8_BAR; PG8_MMA(1, 0, At, B0); PG8_MMA(1, 1, At, B1); PG8_BAR; PG8_SCHED;
        }
        if (wr == 0) PG8_BAR;
        E(acc, cur, wr, wc, fr, fq);
        if (!has_next) break;
#pragma unroll
        for (int a = 0; a < 2; ++a)
#pragma unroll
            for (int b = 0; b < 2; ++b)
#pragma unroll
                for (int m = 0; m < 4; ++m)
#pragma unroll
                    for (int n = 0; n < 2; ++n) acc[a][b][m][n] = (f32x4){0.f, 0.f, 0.f, 0.f};
        cur = nxt; cA = nA; cB = nB; ++ui;
        if (wr == 1) PG8_BAR;
    }
    PG8_WAIT_V(0);
    PG8_BAR;
#undef PG8_SA
#undef PG8_SB
#undef PG8_STAGE
#undef PG8_LDA
#undef PG8_LDB
#undef PG8_MMA
#undef PG8_WAIT_V
#undef PG8_WAIT_L
#undef PG8_BAR
#undef PG8_SCHED
}
}

struct Args { const float* in[33]; float* out; unsigned char* ws; int ph_lo, ph_hi; };
enum { I_XP = 0, I_XS, I_C, I_SR, I_SC, I_SN, I_SM, I_CCTX, I_ADAW, I_ADAB, I_NORMG, I_WIN, I_MU, I_W0, I_WUP, I_A0, I_AUP, I_GUP, I_KKS, I_KA, I_RK, I_LNG, I_LNB,
       I_MCONV, I_MGB, I_MGNG, I_WBR, I_WBM, I_WOUT, I_FUP, I_FCONV, I_FCB, I_FDN };

struct Frame {
    LAS unsigned char* lds; const Args* a;
    int tid, lane, wave, G, vcu, gw, NGW;
    unsigned char* ws; float* out;
};
__device__ __forceinline__ const float* xrow_ptr(const Args& a, int tok) { return tok < NCTX ? a.in[I_XP] + (size_t)tok * D : a.in[I_XS] + (size_t)(tok - NCTX) * D; }
__device__ __forceinline__ int cond_of(int tok) { return tok < NCTX ? 0 : 1 + ((tok - NCTX) >> 11); }
__device__ __forceinline__ int seq_base(int s) { return s < 16 ? s * 256 : NCTX + (s - 16) * 2048; }
__device__ __forceinline__ int seq_len(int s) { return s < 16 ? 256 : 2048; }

__device__ __forceinline__ int win_col(int n) { return n < 2944 ? n : (n < 2960 ? n + 1024 : (n < 3072 ? 1 << 20 : (n < 4096 ? n - 128 : n - 112))); }
__device__ __forceinline__ int fup_col(int n) { const int t = n >> 8, j = n & 255; return j < 128 ? 128 * t + j : DFF + 128 * t + (j - 128); }
__device__ __forceinline__ void transpose_item(const int REMAP, const float* W, int K, int N, bf16_t* WT, int nblk, LAS float* scr, int item, int lane) {
    const int kb = item / nblk, nb = item % nblk, k0 = 64 * kb, n0 = 32 * nb;
    const int nn = REMAP == 1 ? win_col(n0 + (lane & 31)) : (REMAP == 2 ? fup_col(n0 + (lane & 31)) : n0 + (lane & 31));
#pragma unroll
    for (int i = 0; i < 32; ++i) { const int kk = 2 * i + (lane >> 5); scr[kk * 33 + (lane & 31)] = (nn < N) ? W[(size_t)(k0 + kk) * N + nn] : 0.f; }
    LDS_WAIT(); asm volatile("" ::: "memory");
    const int c = lane & 7;
#pragma unroll
    for (int j = 0; j < 4; ++j) { const int n = (lane >> 3) + 8 * j; const LAS float* s = scr + (8 * c) * 33 + n;
        u32x4 o; o.x = pk2(s[0 * 33], s[1 * 33]); o.y = pk2(s[2 * 33], s[3 * 33]); o.z = pk2(s[4 * 33], s[5 * 33]); o.w = pk2(s[6 * 33], s[7 * 33]);
        *(u32x4*)(WT + (size_t)(n0 + n) * K + k0 + 8 * c) = o; }
    LDS_WAIT(); asm volatile("" ::: "memory");
}
__device__ __forceinline__ void p0_prologue(Frame& F) {
    const Args& a = *F.a;
    if (blockIdx.x < 96) {
        LAS float* sc = (LAS float*)(F.lds + 69632);
        LAS float* part = (LAS float*)(F.lds + 69632 + 12288);
        for (int i = F.tid; i < 3072; i += 512) { const int ci = i >> 10, k = i & 1023; const float cv = ci == 0 ? a.in[I_CCTX][k] : a.in[I_C][(ci - 1) * D + k]; sc[i] = silu(cv); }
        __syncthreads();
        const int col = blockIdx.x * 64 + F.lane; float a0 = 0.f, a1 = 0.f, a2 = 0.f;
        const float* aw = a.in[I_ADAW];
#pragma unroll 64
        for (int k = F.wave * 128; k < F.wave * 128 + 128; ++k) { const float w = aw[(size_t)k * 6144 + col]; a0 += sc[k] * w; a1 += sc[1024 + k] * w; a2 += sc[2048 + k] * w; }
        part[(F.wave * 3 + 0) * 64 + F.lane] = a0; part[(F.wave * 3 + 1) * 64 + F.lane] = a1; part[(F.wave * 3 + 2) * 64 + F.lane] = a2;
        __syncthreads();
        if (F.tid < 192) { const int ci = F.tid >> 6, l = F.tid & 63; float s = a.in[I_ADAB][blockIdx.x * 64 + l];
#pragma unroll
            for (int w = 0; w < 8; ++w) s += part[(w * 3 + ci) * 64 + l];
            ((float*)(F.ws + WS_MOD))[ci * 6144 + blockIdx.x * 64 + l] = s; }
        asm volatile("s_waitcnt vmcnt(0)" ::: "memory");
        __syncthreads();
        if (F.tid == 0) { __builtin_amdgcn_fence(__ATOMIC_RELEASE, "agent"); asm volatile("s_waitcnt vmcnt(0)" ::: "memory");
            (void)__hip_atomic_fetch_add((unsigned*)(F.ws + WS_CTL) + 1024, 1u, __ATOMIC_RELAXED, __HIP_MEMORY_SCOPE_AGENT); }
    }
    LAS float* scr = (LAS float*)(F.lds + F.wave * 8448);
    constexpr int I_1 = 16 * 192, I_2 = 8 * 32, I_3 = 8 * 32, I_4 = 16 * 32, I_5 = 16 * 176, I_6 = 44 * 32;
    constexpr int I_7 = 96;
    constexpr int NITEMS = I_1 + I_2 + I_3 + I_4 + I_5 + I_7;
    const bool adab = blockIdx.x < 96; const int nw = ((int)blockIdx.x - 96) * 8 + F.wave;
    for (int rd = 0; rd < (adab ? 3 : 5); ++rd) {
        const int it = rd < 3 ? rd * 2048 + F.gw : 6144 + (rd - 3) * 1280 + nw; if (it >= NITEMS) break;
        int r = it; const float* W; bf16_t* WT; int K, N, nblk; int remap = 0;
        if (r < I_1) { W = a.in[I_WIN]; K = 1024; N = 6032; WT = (bf16_t*)(F.ws + WS_WIN); nblk = 192; remap = 1; }
        else if ((r -= I_1) < I_2) { W = a.in[I_WBR]; K = 512; N = 1024; WT = (bf16_t*)(F.ws + WS_WBR); nblk = 32; }
        else if ((r -= I_2) < I_3) { W = a.in[I_WBM]; K = 512; N = 1024; WT = (bf16_t*)(F.ws + WS_WBM); nblk = 32; }
        else if ((r -= I_3) < I_4) { W = a.in[I_WOUT]; K = 1024; N = 1024; WT = (bf16_t*)(F.ws + WS_WOUT); nblk = 32; }
        else if ((r -= I_4) < I_5) { W = a.in[I_FUP]; K = 1024; N = 5632; WT = (bf16_t*)(F.ws + WS_WUP); nblk = 176; remap = 2; }
        else if ((r -= I_5) < 32) { const int d = r >> 4; r &= 15; W = a.in[I_WUP] + d * 32768; K = 64; N = 512; WT = (bf16_t*)(F.ws + WS_WUPT) + d * 32768; nblk = 16; }
        else if ((r -= 32) < 32) { const int d = r >> 4; r &= 15; W = a.in[I_AUP] + d * 32768; K = 64; N = 512; WT = (bf16_t*)(F.ws + WS_AUPT) + d * 32768; nblk = 16; }
        else { r -= 32; W = a.in[I_GUP]; K = 128; N = 512; WT = (bf16_t*)(F.ws + WS_GUPT); nblk = 16; }
        transpose_item(remap, W, K, N, WT, nblk, scr, r, F.lane);
    }
}

__device__ __forceinline__ void p1_h1(Frame& F) {
    const Args& a = *F.a; const float* ng = a.in[I_NORMG];
    const bool adab = blockIdx.x < 96; const int nw = ((int)blockIdx.x - 96) * 8 + F.wave;
    for (int rd = 0; rd < (adab ? 3 : 5); ++rd) { const int row = rd < 3 ? rd * 2048 + F.gw : 6144 + (rd - 3) * 1280 + nw; if (row >= NTOK) break;
        const f32x4* xr = (const f32x4*)xrow_ptr(a, row) + F.lane; const float* mod = (const float*)(F.ws + WS_MOD) + cond_of(row) * 6144;
        f32x4 v[4]; float ss = 0.f;
#pragma unroll
        for (int j = 0; j < 4; ++j) { v[j] = xr[64 * j]; ss += (v[j].x * v[j].x + v[j].y * v[j].y) + (v[j].z * v[j].z + v[j].w * v[j].w); }
        const float rstd = rsqrtf(wave_sum(ss) * (1.f / D) + 1e-6f);
        u32x2* o = (u32x2*)((bf16_t*)(F.ws + WS_H) + (size_t)row * D) + F.lane;
#pragma unroll
        for (int j = 0; j < 4; ++j) { const int col = 4 * (64 * j + F.lane);
            const f32x4 g = *(const f32x4*)(ng + col), sh = *(const f32x4*)(mod + col), sc = *(const f32x4*)(mod + 1024 + col);
            const f32x4 h = v[j] * rstd * g * (sc + 1.f) + sh;
            u32x2 w; w.x = pk2(h.x, h.y); w.y = pk2(h.z, h.w); o[64 * j] = w; }
    }
}

constexpr int ZS_STRIDE = 3856;
__device__ __forceinline__ void ld4(const LAS unsigned char* p, float (&f)[4]) { const u32x2 w = *(const LAS u32x2*)p; f[0] = bf2f(w.x & 0xffffu); f[1] = bf2f(w.x >> 16); f[2] = bf2f(w.y & 0xffffu); f[3] = bf2f(w.y >> 16); }
__device__ __forceinline__ void st4(bf16_t* p, const float (&f)[4]) { u32x2 o; o.x = cvt_pk(f[0], f[1]); o.y = cvt_pk(f[2], f[3]); *(u32x2*)p = o; }
__device__ __forceinline__ void flush_rows(LAS unsigned char* stg, bf16_t* g  , const float (&v)[4][4], int fr, int fq, int lane) {
#pragma unroll
    for (int ct = 0; ct < 4; ++ct) { u32x2 o; o.x = cvt_pk(v[ct][0], v[ct][1]); o.y = cvt_pk(v[ct][2], v[ct][3]); *(LAS u32x2*)(stg + fr * 144 + ct * 32 + fq * 8) = o; }
    LDS_WAIT(); asm volatile("" ::: "memory");
#pragma unroll
    for (int i = 0; i < 2; ++i) { const int t = (lane >> 3) + 8 * i; *(u32x4*)(g + (size_t)t * 512 + (lane & 7) * 8) = *(const LAS u32x4*)(stg + t * 144 + (lane & 7) * 16); }
    LDS_WAIT(); asm volatile("" ::: "memory");
}
template <int SM = 7>
__device__ __forceinline__ void p3_prep(Frame& F) {
    const Args& a = *F.a;
    const bf16_t* Z = (const bf16_t*)(F.ws + WS_Z1);
    LAS unsigned char* L = F.lds;
    const int tid = F.tid, lane = F.lane, h = F.wave, fr = lane & 15, fq = lane >> 4;
    { const int unit = blockIdx.x;
        const int tok0 = unit * 32;
        const int s = tok0 < NCTX ? (tok0 >> 8) : 16 + ((tok0 - NCTX) >> 11);
        const int sb = seq_base(s), T = seq_len(s), t0 = tok0 - sb;
        __syncthreads();
        LAS float* prm = (LAS float*)(L + 32 * ZS_STRIDE);
        { prm[tid] = a.in[I_KKS][tid]; prm[512 + tid] = a.in[I_KA][tid]; prm[1024 + tid] = a.in[I_RK][tid]; prm[1536 + tid] = a.in[I_A0][tid]; prm[2048 + tid] = a.in[I_A0][512 + tid];
          prm[2560 + tid] = a.in[I_W0][tid]; prm[3072 + tid] = a.in[I_W0][512 + tid]; }
#pragma unroll 5
        for (int itk = 0; itk < ((SM & 1) ? 15 : 0); ++itk) { const int it = tid + 512 * itk;
            const int j = it / 240, g8 = (it - j * 240) * 8, t = t0 + j;
            const bf16_t* zp = Z + (size_t)(tok0 + j) * Z1C + g8;
            const float ml = t > 0 ? 0.5f : 0.f, mr = t < T - 1 ? 0.5f : 0.f;
            float zc[8], zl[8], zr[8], v[8];
            unpack8(*(const u32x4*)zp, zc); unpack8(*(const u32x4*)(zp - (t > 0 ? Z1C : 0)), zl); unpack8(*(const u32x4*)(zp + (t < T - 1 ? Z1C : 0)), zr);
            const f32x4 m0 = *(const f32x4*)(a.in[I_MU] + g8), m1 = *(const f32x4*)(a.in[I_MU] + g8 + 4);
#pragma unroll
            for (int i = 0; i < 8; ++i) { const float mu = i < 4 ? m0[i] : m1[i - 4]; v[i] = zc[i] + mu * ((ml * zl[i] + mr * zr[i]) - zc[i]); }
            if (g8 >= ZR_WD && g8 < ZR_AD) {
#pragma unroll
                for (int i = 0; i < 8; ++i) v[i] = tanhf(v[i]);
            } else if (g8 >= ZR_GD) {
#pragma unroll
                for (int i = 0; i < 8; ++i) v[i] = sigm(v[i]);
            }
            u32x4 o; o.x = cvt_pk(v[0], v[1]); o.y = cvt_pk(v[2], v[3]); o.z = cvt_pk(v[4], v[5]); o.w = cvt_pk(v[6], v[7]);
            *(LAS u32x4*)(L + j * ZS_STRIDE + g8 * 2) = o;
        }
        __syncthreads();
        if (SM & 2) {
            const bf16_t* WUPT = (const bf16_t*)(F.ws + WS_WUPT); const bf16_t* AUPT = (const bf16_t*)(F.ws + WS_AUPT); const bf16_t* GUPT = (const bf16_t*)(F.ws + WS_GUPT);
            const f32x4 Z4 = {0.f, 0.f, 0.f, 0.f};
            float kx[2][4][4], kk[2][4][4], rx[2][4][4], bon[2] = {0.f, 0.f};
            LAS unsigned char* stg = L + 32 * ZS_STRIDE + 14336 + h * 2304;
#define TILE(WS_, tt_) ((bf16_t*)(F.ws + (WS_)) + (size_t)(tok0 + 16 * (tt_)) * 512 + 64 * h)
#pragma unroll
            for (int tt = 0; tt < 2; ++tt) {
                const LAS unsigned char* zrow = L + (16 * tt + fr) * ZS_STRIDE; const size_t tok = (size_t)(tok0 + 16 * tt + fr);
                float ss = 0.f;
                float vx[4][4];
#pragma unroll
                for (int ct = 0; ct < 4; ++ct) { const int col = 64 * h + 16 * ct + 4 * fq;
                    ld4(zrow + (ZR_R + col) * 2, rx[tt][ct]); ld4(zrow + (ZR_K + col) * 2, kx[tt][ct]); ld4(zrow + (ZR_V + col) * 2, vx[ct]);
                    const f32x4 ks = *(const LAS f32x4*)(prm + col);
#pragma unroll
                    for (int j = 0; j < 4; ++j) { kk[tt][ct][j] = kx[tt][ct][j] * ks[j]; ss += kk[tt][ct][j] * kk[tt][ct][j]; }
                }
                flush_rows(stg, TILE(WS_PR, tt), rx[tt], fr, fq, lane); flush_rows(stg, TILE(WS_PV, tt), vx, fr, fq, lane);
                ss += __shfl_xor(ss, 16); ss += __shfl_xor(ss, 32);
                const float rn = 1.f / fmaxf(sqrtf(ss), 1e-12f);
#pragma unroll
                for (int ct = 0; ct < 4; ++ct) {
#pragma unroll
                    for (int j = 0; j < 4; ++j) kk[tt][ct][j] *= rn; }
                flush_rows(stg, TILE(WS_PKK, tt), kk[tt], fr, fq, lane);
            }
#pragma unroll
            for (int d = 0; d < 2; ++d) {
                asm volatile("" ::: "memory"); __builtin_amdgcn_sched_barrier(0);
                bf16x8 af[2][4];
#pragma unroll
                for (int ks = 0; ks < 2; ++ks)
#pragma unroll
                    for (int ct = 0; ct < 4; ++ct) af[ks][ct] = *(const bf16x8*)(AUPT + ((size_t)(d * 512 + 64 * h + 16 * ct + fr)) * 64 + 32 * ks + 8 * fq);
#pragma unroll
                for (int tt = 0; tt < 2; ++tt) { const LAS unsigned char* zrow = L + (16 * tt + fr) * ZS_STRIDE; const size_t tok = (size_t)(tok0 + 16 * tt + fr);
                    f32x4 acc[4] = {Z4, Z4, Z4, Z4};
#pragma unroll
                    for (int ks = 0; ks < 2; ++ks) { const bf16x8 bv = *(const LAS bf16x8*)(zrow + (ZR_AD + 64 * d + 32 * ks + 8 * fq) * 2);
#pragma unroll
                        for (int ct = 0; ct < 4; ++ct) acc[ct] = __builtin_amdgcn_mfma_f32_16x16x32_bf16(af[ks][ct], bv, acc[ct], 0, 0, 0); }
                    float kd[4][4], bv4[4][4];
#pragma unroll
                    for (int ct = 0; ct < 4; ++ct) { const int col = 64 * h + 16 * ct + 4 * fq;
                        const f32x4 a0 = *(const LAS f32x4*)(prm + 1536 + d * 512 + col), ka = *(const LAS f32x4*)(prm + 512 + col), rk = *(const LAS f32x4*)(prm + 1024 + col);
#pragma unroll
                        for (int j = 0; j < 4; ++j) { const float av = sigm(a0[j] + acc[ct][j]); kd[ct][j] = kx[tt][ct][j] * (1.f + (av - 1.f) * ka[j]); bv4[ct][j] = kk[tt][ct][j] * av; bon[tt] += rx[tt][ct][j] * kd[ct][j] * rk[j]; } }
                    flush_rows(stg, TILE(WS_PKD, tt) + (size_t)d * NTOK * 512, kd, fr, fq, lane); flush_rows(stg, TILE(WS_PB, tt) + (size_t)d * NTOK * 512, bv4, fr, fq, lane); (void)tok;
                }
            }
#pragma unroll
            for (int d = 0; d < 2; ++d) {
                asm volatile("" ::: "memory"); __builtin_amdgcn_sched_barrier(0);
                bf16x8 af[2][4];
#pragma unroll
                for (int ks = 0; ks < 2; ++ks)
#pragma unroll
                    for (int ct = 0; ct < 4; ++ct) af[ks][ct] = *(const bf16x8*)(WUPT + ((size_t)(d * 512 + 64 * h + 16 * ct + fr)) * 64 + 32 * ks + 8 * fq);
#pragma unroll
                for (int tt = 0; tt < 2; ++tt) { const LAS unsigned char* zrow = L + (16 * tt + fr) * ZS_STRIDE; const size_t tok = (size_t)(tok0 + 16 * tt + fr);
                    f32x4 acc[4] = {Z4, Z4, Z4, Z4};
#pragma unroll
                    for (int ks = 0; ks < 2; ++ks) { const bf16x8 bv = *(const LAS bf16x8*)(zrow + (ZR_WD + 64 * d + 32 * ks + 8 * fq) * 2);
#pragma unroll
                        for (int ct = 0; ct < 4; ++ct) acc[ct] = __builtin_amdgcn_mfma_f32_16x16x32_bf16(af[ks][ct], bv, acc[ct], 0, 0, 0); }
                    float dc[4][4];
#pragma unroll
                    for (int ct = 0; ct < 4; ++ct) { const int col = 64 * h + 16 * ct + 4 * fq; const f32x4 w0 = *(const LAS f32x4*)(prm + 2560 + d * 512 + col);
#pragma unroll
                        for (int j = 0; j < 4; ++j) dc[ct][j] = __expf(-0.606531f * sigm(w0[j] + acc[ct][j])); }
                    flush_rows(stg, TILE(WS_PW, tt) + (size_t)d * NTOK * 512, dc, fr, fq, lane); (void)tok;
                }
            }
            {
                asm volatile("" ::: "memory"); __builtin_amdgcn_sched_barrier(0);
                bf16x8 af[4][4];
#pragma unroll
                for (int ks = 0; ks < 4; ++ks)
#pragma unroll
                    for (int ct = 0; ct < 4; ++ct) af[ks][ct] = *(const bf16x8*)(GUPT + ((size_t)(64 * h + 16 * ct + fr)) * 128 + 32 * ks + 8 * fq);
#pragma unroll
                for (int tt = 0; tt < 2; ++tt) { const LAS unsigned char* zrow = L + (16 * tt + fr) * ZS_STRIDE; const size_t tok = (size_t)(tok0 + 16 * tt + fr);
                    f32x4 acc[4] = {Z4, Z4, Z4, Z4};
#pragma unroll
                    for (int ks = 0; ks < 4; ++ks) { const bf16x8 bv = *(const LAS bf16x8*)(zrow + (ZR_GD + 32 * ks + 8 * fq) * 2);
#pragma unroll
                        for (int ct = 0; ct < 4; ++ct) acc[ct] = __builtin_amdgcn_mfma_f32_16x16x32_bf16(af[ks][ct], bv, acc[ct], 0, 0, 0); }
                    float g4[4][4];
#pragma unroll
                    for (int ct = 0; ct < 4; ++ct) { g4[ct][0] = acc[ct][0]; g4[ct][1] = acc[ct][1]; g4[ct][2] = acc[ct][2]; g4[ct][3] = acc[ct][3]; }
                    flush_rows(stg, TILE(WS_PG, tt), g4, fr, fq, lane); (void)tok;
                }
            }
#pragma unroll
            for (int tt = 0; tt < 2; ++tt) { float b = bon[tt]; b += __shfl_xor(b, 16); b += __shfl_xor(b, 32);
                if (fq == 0) ((float*)(F.ws + WS_BON))[(size_t)(tok0 + 16 * tt + fr) * 8 + h] = b; }
        }
        asm volatile("" ::: "memory"); __builtin_amdgcn_sched_barrier(0);
        if (SM & 4) {
            int tid = F.tid; asm volatile("" : "+v"(tid));
            const bool lat = s >= 16;
            const int y = lat ? (t0 >> 6) : 0, W = lat ? 64 : 256, j0 = (tid >> 7) * 8, x0 = (lat ? (t0 & 63) : t0) + j0;
#pragma unroll 1
            for (int half = 0; half < 2; ++half) {
                const int c4 = (tid & 127) * 4 + half * 512;
                const float* cw = a.in[I_MCONV] + c4;
                float acc[8][4];
#pragma unroll
                for (int jj = 0; jj < 8; ++jj)
#pragma unroll
                    for (int e = 0; e < 4; ++e) acc[jj][e] = 0.f;
#pragma unroll 1
                for (int dy = -1; dy <= 1; ++dy) {
                    const bool rowok = dy == 0 || (lat && y + dy >= 0 && y + dy < 32);
                    const int dyo = rowok ? dy * 64 : 0; const float rmask = rowok ? 1.f : 0.f;
                    f32x4 wt[3];
#pragma unroll
                    for (int dx = 0; dx < 3; ++dx) wt[dx] = *(const f32x4*)(cw + ((dy + 1) * 3 + dx) * 1024) * rmask;
#pragma unroll
                    for (int i = 0; i < 10; ++i) { const int xx = x0 - 1 + i; const bool ok = xx >= 0 && xx < W;
                        const u32x2 raw = *(const u32x2*)(Z + ((long)(tok0 + j0 + dyo) + (i - 1)) * Z1C + ZM_Q + c4);
                        const float cm = ok ? 1.f : 0.f;
                        const f32x4 xv = (f32x4){bf2f(raw.x & 0xffffu), bf2f(raw.x >> 16), bf2f(raw.y & 0xffffu), bf2f(raw.y >> 16)} * cm;
#pragma unroll
                        for (int dx = -1; dx <= 1; ++dx) { const int jj = i - 1 - dx;
                            if (jj >= 0 && jj < 8) {
#pragma unroll
                                for (int e = 0; e < 4; ++e) acc[jj][e] += wt[dx + 1][e] * xv[e]; } }
                    }
                }
                const float sc = half == 0 ? 0.08838834764831845f : 1.f;
                bf16_t* dst = (half == 0 ? (bf16_t*)(F.ws + WS_MQ) : (bf16_t*)(F.ws + WS_MK)) + (tid & 127) * 4;
#pragma unroll
                for (int jj = 0; jj < 8; ++jj) {
#pragma unroll
                    for (int e = 0; e < 4; ++e) acc[jj][e] = silu(acc[jj][e]) * sc;
                    u32x2 o; o.x = cvt_pk(acc[jj][0], acc[jj][1]); o.y = cvt_pk(acc[jj][2], acc[jj][3]);
                    *(u32x2*)(dst + (size_t)(tok0 + j0 + jj) * 512) = o; }
                asm volatile("" ::: "memory"); __builtin_amdgcn_sched_barrier(0);
            }
            { const int j = tid >> 4, gi = tid & 15, tok = tok0 + j;
                const float val = bf2f(Z[(size_t)tok * Z1C + ZM_G + gi]) + a.in[I_MGB][gi];
                if (gi < 8) ((float*)(F.ws + WS_LI))[(size_t)gi * NTOK + tok] = val;
                else ((float*)(F.ws + WS_LF))[(size_t)(gi - 8) * NTOK + tok] = fminf(val, 0.f) - log1pf(__expf(-fabsf(val))); }
        }
    }
}

typedef short bf16x4 __attribute__((ext_vector_type(4)));
__device__ __forceinline__ bf16x4 to_b4(const f32x4 c) { u32x2 p; p.x = cvt_pk(c[0], c[1]); p.y = cvt_pk(c[2], c[3]); return __builtin_bit_cast(bf16x4, p); }
__device__ __forceinline__ bf16x8 cat8(const bf16x4 a, const bf16x4 b) { return __builtin_shufflevector(a, b, 0, 1, 2, 3, 4, 5, 6, 7); }
#define MM2(a0, b0, a1, b1, c) __builtin_amdgcn_mfma_f32_16x16x32_bf16(cat8(a0, a1), cat8(b0, b1), c, 0, 0, 0)
#define MM1(a, b, c) __builtin_amdgcn_mfma_f32_16x16x32_bf16(cat8(a, (bf16x4){0, 0, 0, 0}), cat8(b, (bf16x4){0, 0, 0, 0}), c, 0, 0, 0)
constexpr int R1_AA = 0, R1_BB = 2304, R1_KK = 4608, R1_RR = 6912, R1_BPT = 9216, R1_KPT = 12288, R1_VT = 15360, R1_GB = 18432, R1_BYTES = 18688;
__device__ __forceinline__ int r_slot0(int s, int dir, int h) { return s < 16 ? (((s * 2 + dir) * 8 + h) * 4) : 1024 + ((((s - 16) * 2 + dir) * 8 + h) * 32); }
template <int PM = 0>
__device__ __forceinline__ void rwkv_pass1(Frame& F, int unit) {
    int c, s, dir; const int h = unit & 7, g = unit >> 3;
    if (g < 128) { c = g & 3; s = g >> 3; dir = (g >> 2) & 1; } else { const int g2 = g - 128; c = g2 & 31; s = 16 + (g2 >> 6); dir = (g2 >> 5) & 1; }
    const int slot = r_slot0(s, dir, h) + c;
    const int sb = seq_base(s), T = seq_len(s), lane = F.lane, fr = lane & 15, fq = lane >> 4;
    LAS unsigned char* wl = F.lds + F.wave * R1_BYTES;
    const bf16_t* PR = (const bf16_t*)(F.ws + WS_PR) + h * 64; const bf16_t* PV = (const bf16_t*)(F.ws + WS_PV) + h * 64; const bf16_t* PKK = (const bf16_t*)(F.ws + WS_PKK) + h * 64;
    const bf16_t* PW = (const bf16_t*)(F.ws + WS_PW) + (size_t)dir * NTOK * 512 + h * 64; const bf16_t* PKD = (const bf16_t*)(F.ws + WS_PKD) + (size_t)dir * NTOK * 512 + h * 64;
    const bf16_t* PB = (const bf16_t*)(F.ws + WS_PB) + (size_t)dir * NTOK * 512 + h * 64;
    bf16_t* ybase = PM ? (bf16_t*)(F.ws + WS_PW) : (bf16_t*)F.out;
    bf16_t* YS = ybase + (size_t)dir * NTOK * 512 + h * 64; bf16_t* US = ybase + (size_t)(2 + dir) * NTOK * 512 + h * 64;
    f32x4 XT[4][8];
#pragma unroll
    for (int kt = 0; kt < 4; ++kt)
#pragma unroll
        for (int rt = 0; rt < 8; ++rt)
#pragma unroll
            for (int j = 0; j < 4; ++j) XT[kt][rt][j] = (rt >= 4 && (16 * kt + 4 * fq + j) == (16 * (rt - 4) + fr)) ? 1.f : 0.f;
#pragma unroll 1
    for (int blk = 0; blk < 4; ++blk) {
        const int pos0 = c * 64 + blk * 16;
        {
            const int t = lane >> 2, cp = (lane & 3) * 8, p = pos0 + t, tt = dir ? T - 1 - p : p; const size_t off = (size_t)(sb + tt) * 512 + cp;
            u32x4 raw[6][2];
            if (PM == 1) {
#pragma unroll
                for (int q = 0; q < 6; ++q) { raw[q][0] = (u32x4){0x3e003e00u + (unsigned)lane, 0x3e003e00u, 0x3e003e00u, 0x3e003e00u}; raw[q][1] = raw[q][0]; }
            } else {
                raw[0][0] = *(const u32x4*)(PKK + off); raw[0][1] = *(const u32x4*)(PKK + off + 32); raw[1][0] = *(const u32x4*)(PB + off); raw[1][1] = *(const u32x4*)(PB + off + 32);
                raw[2][0] = *(const u32x4*)(PKD + off); raw[2][1] = *(const u32x4*)(PKD + off + 32); raw[3][0] = *(const u32x4*)(PR + off); raw[3][1] = *(const u32x4*)(PR + off + 32);
                raw[4][0] = *(const u32x4*)(PW + off); raw[4][1] = *(const u32x4*)(PW + off + 32); raw[5][0] = *(const u32x4*)(PV + off); raw[5][1] = *(const u32x4*)(PV + off + 32);
            }
            const int lo = t * 144 + cp * 2;
            *(LAS u32x4*)(wl + R1_AA + lo) = raw[0][0]; *(LAS u32x4*)(wl + R1_AA + lo + 64) = raw[0][1]; *(LAS u32x4*)(wl + R1_BB + lo) = raw[1][0]; *(LAS u32x4*)(wl + R1_BB + lo + 64) = raw[1][1];
            *(LAS u32x4*)(wl + R1_KK + lo) = raw[2][0]; *(LAS u32x4*)(wl + R1_KK + lo + 64) = raw[2][1]; *(LAS u32x4*)(wl + R1_RR + lo) = raw[3][0]; *(LAS u32x4*)(wl + R1_RR + lo + 64) = raw[3][1];
            *(LAS u32x4*)(wl + R1_BPT + lo) = raw[4][0]; *(LAS u32x4*)(wl + R1_BPT + lo + 64) = raw[4][1]; *(LAS u32x4*)(wl + R1_KPT + lo) = raw[5][0]; *(LAS u32x4*)(wl + R1_KPT + lo + 64) = raw[5][1];
        }
        LDS_WAIT(); asm volatile("" ::: "memory");
        {
            float gt[16], vv[16], gB = 1.f;
#pragma unroll
            for (int t = 0; t < 16; ++t) { gB *= bf2f(*(const LAS bf16_t*)(wl + R1_BPT + t * 144 + lane * 2)); gt[t] = gB; vv[t] = bf2f(*(const LAS bf16_t*)(wl + R1_KPT + t * 144 + lane * 2)); }
            LDS_WAIT(); asm volatile("" ::: "memory");
#pragma unroll
            for (int tp = 0; tp < 8; ++tp) {
                float bp[2], kp[2];
#pragma unroll
                for (int e = 0; e < 2; ++e) { const int t = 2 * tp + e; const int lo = t * 144 + lane * 2;
                    const float kk = bf2f(*(const LAS bf16_t*)(wl + R1_AA + lo)), b = bf2f(*(const LAS bf16_t*)(wl + R1_BB + lo)), kd = bf2f(*(const LAS bf16_t*)(wl + R1_KK + lo)), r = bf2f(*(const LAS bf16_t*)(wl + R1_RR + lo));
                    const float g = gt[t], gm1 = t ? gt[t > 0 ? t - 1 : 0] : 1.f, inv = __builtin_amdgcn_rcpf(g), bb = b * inv, kq = kd * inv;
                    bp[e] = bb * gB; kp[e] = kq * gB;
                    *(LAS bf16_t*)(wl + R1_AA + lo) = (bf16_t)cvt_pk(gm1 * kk, 0.f); *(LAS bf16_t*)(wl + R1_BB + lo) = (bf16_t)cvt_pk(bb, 0.f);
                    *(LAS bf16_t*)(wl + R1_KK + lo) = (bf16_t)cvt_pk(kq, 0.f); *(LAS bf16_t*)(wl + R1_RR + lo) = (bf16_t)cvt_pk(g * r, 0.f); }
                *(LAS unsigned*)(wl + R1_BPT + lane * 48 + tp * 4) = cvt_pk(bp[0], bp[1]);
                *(LAS unsigned*)(wl + R1_KPT + lane * 48 + tp * 4) = cvt_pk(kp[0], kp[1]);
                *(LAS unsigned*)(wl + R1_VT + lane * 48 + tp * 4) = cvt_pk(vv[2 * tp], vv[2 * tp + 1]);
            }
            *(LAS float*)(wl + R1_GB + lane * 4) = gB;
        }
        LDS_WAIT(); asm volatile("" ::: "memory");
        bf16x4 fAA[4], fRR[4];
        f32x4 Nn = {0.f, 0.f, 0.f, 0.f}, NT = Nn, P2T = Nn, Q1T = Nn, Q2T = Nn;
        {
            bf16x4 fB[4], fK[4];
#pragma unroll
            for (int kt = 0; kt < 4; ++kt) { const int o1 = fr * 144 + (16 * kt + 4 * fq) * 2;
                fAA[kt] = *(const LAS bf16x4*)(wl + R1_AA + o1); fRR[kt] = *(const LAS bf16x4*)(wl + R1_RR + o1); fB[kt] = *(const LAS bf16x4*)(wl + R1_BB + o1); fK[kt] = *(const LAS bf16x4*)(wl + R1_KK + o1); }
#pragma unroll
            for (int kp = 0; kp < 4; kp += 2) {
                Nn = MM2(fAA[kp], fB[kp], fAA[kp + 1], fB[kp + 1], Nn); NT = MM2(fB[kp], fAA[kp], fB[kp + 1], fAA[kp + 1], NT); P2T = MM2(fK[kp], fAA[kp], fK[kp + 1], fAA[kp + 1], P2T);
                Q1T = MM2(fB[kp], fRR[kp], fB[kp + 1], fRR[kp + 1], Q1T); Q2T = MM2(fK[kp], fRR[kp], fK[kp + 1], fRR[kp + 1], Q2T); }
        }
        f32x4 Ic;
#pragma unroll
        for (int j = 0; j < 4; ++j) { const int m = 4 * fq + j, n = fr;
            Nn[j] = (n < m) ? Nn[j] : 0.f; NT[j] = (m < n) ? NT[j] : 0.f; P2T[j] = (m < n) ? P2T[j] : 0.f; Q1T[j] = (m <= n) ? Q1T[j] : 0.f; Q2T[j] = (m <= n) ? Q2T[j] : 0.f; Ic[j] = (m == n) ? 1.f : 0.f; }
        const f32x4 Z4 = {0.f, 0.f, 0.f, 0.f};
        const bf16x4 bNn = to_b4(Nn), bNT = to_b4(NT);
        const f32x4 N2 = MM1(bNT, bNn, Z4), N2T = MM1(bNn, bNT, Z4);
        const bf16x4 bN2 = to_b4(N2), bN2T = to_b4(N2T);
        const f32x4 N4 = MM1(bN2T, bN2, Z4), N4T = MM1(bN2, bN2T, Z4);
        const f32x4 N8 = MM1(to_b4(N4T), to_b4(N4), Z4);
        const f32x4 T2T = MM1(to_b4(Ic + N2), to_b4(Ic - NT), Z4);
        const f32x4 T3T = MM1(to_b4(Ic + N4), to_b4(T2T), Z4);
        const f32x4 TiT = MM1(to_b4(Ic + N8), to_b4(T3T), Z4);
        const bf16x4 bTn = to_b4(Z4 - TiT), bP2T = to_b4(P2T), bQ1T = to_b4(Q1T), bQ2T = to_b4(Q2T);
        bf16x4 fBP[4], fKP[4];
#pragma unroll
        for (int kt = 0; kt < 4; ++kt) { const int o2 = (16 * kt + fr) * 48 + 8 * fq; fBP[kt] = *(const LAS bf16x4*)(wl + R1_BPT + o2); fKP[kt] = *(const LAS bf16x4*)(wl + R1_KPT + o2); }
#pragma unroll
        for (int rt = 0; rt < (PM == 3 ? 0 : 8); ++rt) {
            bf16x4 bX[4];
#pragma unroll
            for (int kt = 0; kt < 4; ++kt) bX[kt] = to_b4(XT[kt][rt]);
            const bf16x4 z4b = {0, 0, 0, 0};
            f32x4 cg = MM2(fAA[0], bX[0], fAA[1], bX[1], Z4); cg = MM2(fAA[2], bX[2], fAA[3], bX[3], cg);
            bf16x4 bV = z4b;
            if (rt < 4) { bV = *(const LAS bf16x4*)(wl + R1_VT + (16 * rt + fr) * 48 + 8 * fq); cg = MM1(bP2T, bV, cg); }
            const bf16x4 bD = to_b4(MM1(bTn, to_b4(cg), Z4));
            f32x4 y = MM2(fRR[0], bX[0], fRR[1], bX[1], Z4); y = MM2(fRR[2], bX[2], fRR[3], bX[3], y);
            y = MM2(bQ1T, bD, (rt < 4 ? bQ2T : z4b), bV, y);
#pragma unroll
            for (int j = 0; j < 4; ++j) *(LAS bf16_t*)(wl + (4 * fq + j) * 256 + (16 * rt + fr) * 2) = (bf16_t)cvt_pk(y[j], 0.f);
#pragma unroll
            for (int kt = 0; kt < 4; ++kt) {
                const f32x4 x = XT[kt][rt] * *(const LAS f32x4*)(wl + R1_GB + (16 * kt + 4 * fq) * 4);
                XT[kt][rt] = MM2(fBP[kt], bD, (rt < 4 ? fKP[kt] : z4b), bV, x); }
            __builtin_amdgcn_sched_barrier(0);
        }
        LDS_WAIT(); asm volatile("" ::: "memory");
        if (PM != 2) {
            const int t = lane >> 2, part = lane & 3, p = pos0 + t, tt = dir ? T - 1 - p : p;
            bf16_t* yo = (part < 2 ? YS : US) + (size_t)(sb + tt) * 512 + 32 * (part & 1);
#pragma unroll
            for (int i = 0; i < 4; ++i) *(u32x4*)(yo + 8 * i) = *(const LAS u32x4*)(wl + t * 256 + part * 64 + 16 * i);
        }
        LDS_WAIT(); asm volatile("" ::: "memory");
    }
    if (PM) {
#pragma unroll
        for (int kt = 0; kt < 4; ++kt)
#pragma unroll
            for (int rt = 0; rt < 8; ++rt) asm volatile("" :: "v"(XT[kt][rt]));
        return; }
    bf16_t* sp = (bf16_t*)(F.ws + WS_SP) + (size_t)slot * 8192;
#pragma unroll
    for (int rt = 0; rt < 4; ++rt) {
        u32x4 o0, o1;
        o0.x = cvt_pk(XT[0][rt][0], XT[0][rt][1]); o0.y = cvt_pk(XT[0][rt][2], XT[0][rt][3]); o0.z = cvt_pk(XT[1][rt][0], XT[1][rt][1]); o0.w = cvt_pk(XT[1][rt][2], XT[1][rt][3]);
        o1.x = cvt_pk(XT[2][rt][0], XT[2][rt][1]); o1.y = cvt_pk(XT[2][rt][2], XT[2][rt][3]); o1.z = cvt_pk(XT[3][rt][0], XT[3][rt][1]); o1.w = cvt_pk(XT[3][rt][2], XT[3][rt][3]);
        *(u32x4*)(sp + 4096 + (16 * rt + fr) * 64 + fq * 16) = o0; *(u32x4*)(sp + 4096 + (16 * rt + fr) * 64 + fq * 16 + 8) = o1;
#pragma unroll
        for (int kt = 0; kt < 4; ++kt)
#pragma unroll
            for (int j = 0; j < 4; ++j) *(LAS bf16_t*)(wl + (16 * kt + 4 * fq + j) * 128 + ((fr >> 2) * 16 + rt * 4 + (fr & 3)) * 2) = (bf16_t)cvt_pk(XT[kt][4 + rt][j], 0.f);
    }
    LDS_WAIT(); asm volatile("" ::: "memory");
#pragma unroll
    for (int i = 0; i < 8; ++i) { const int id = lane + 64 * i; *(u32x4*)(sp + (id >> 3) * 64 + (id & 7) * 8) = *(const LAS u32x4*)(wl + (id >> 3) * 128 + (id & 7) * 16); }
}
struct PropStage { bf16x4 a[4][4]; u32x2 sl[4]; };
template <int MODE = 0>
__device__ __forceinline__ void rwkv_prop(Frame& F, int wu, size_t st_off = 0, bool fin = true) {
    const Args& a = *F.a;
    int s, dir, h, vt;
    if (wu < 128) { const int hs = wu >> 2; vt = wu & 3; s = 16 + (hs >> 4); dir = (hs >> 3) & 1; h = hs & 7; } else { const int u2 = wu - 128, hs = u2 >> 2; vt = u2 & 3; s = hs >> 4; dir = (hs >> 3) & 1; h = hs & 7; }
    const int nch = seq_len(s) / 64, lane = F.lane, fr = lane & 15, fq = lane >> 4;
    bf16_t* sp0 = (bf16_t*)(F.ws + WS_SP) + (size_t)r_slot0(s, dir, h) * 8192;
    bf16x4 bS[4]; f32x4 acc[4];
    if (s >= 16) { const float* s0 = a.in[I_SR] + ((((size_t)(s - 16) * 2 + dir) * 8 + h) * 4096) + (16 * vt + fr) * 64 + 4 * fq;
#pragma unroll
        for (int it = 0; it < 4; ++it) bS[it] = to_b4(*(const f32x4*)(s0 + 16 * it));
    } else {
#pragma unroll
        for (int it = 0; it < 4; ++it) bS[it] = (bf16x4){0, 0, 0, 0};
    }
#pragma unroll
    for (int kt = 0; kt < 4; ++kt) acc[kt] = (f32x4){0.f, 0.f, 0.f, 0.f};
    PropStage st[4];
#define PROP_LOAD(u, cidx) do { const bf16_t* spc = sp0 + (size_t)(cidx) * 8192; \
        _Pragma("unroll") for (int kt = 0; kt < 4; ++kt) { const u32x4 lo_ = *(const u32x4*)(spc + (16 * kt + fr) * 64 + fq * 16), hi_ = *(const u32x4*)(spc + (16 * kt + fr) * 64 + fq * 16 + 8); \
            st[u].a[kt][0] = __builtin_bit_cast(bf16x4, (u32x2){lo_.x, lo_.y}); st[u].a[kt][1] = __builtin_bit_cast(bf16x4, (u32x2){lo_.z, lo_.w}); \
            st[u].a[kt][2] = __builtin_bit_cast(bf16x4, (u32x2){hi_.x, hi_.y}); st[u].a[kt][3] = __builtin_bit_cast(bf16x4, (u32x2){hi_.z, hi_.w}); } \
        { const u32x4 lo_ = *(const u32x4*)(spc + 4096 + (16 * vt + fr) * 64 + fq * 16), hi_ = *(const u32x4*)(spc + 4096 + (16 * vt + fr) * 64 + fq * 16 + 8); \
            st[u].sl[0] = (u32x2){lo_.x, lo_.y}; st[u].sl[1] = (u32x2){lo_.z, lo_.w}; st[u].sl[2] = (u32x2){hi_.x, hi_.y}; st[u].sl[3] = (u32x2){hi_.z, hi_.w}; } } while (0)
#pragma unroll
    for (int u = 0; u < 4; ++u) PROP_LOAD(u, u);
    for (int c0 = 0; c0 < nch; c0 += 4) {
#pragma unroll
        for (int u = 0; u < 4; ++u) { const int c = c0 + u; bf16_t* spc = sp0 + (size_t)c * 8192;
#pragma unroll
            for (int kt = 0; kt < 4; ++kt) { acc[kt][0] = bf2f(st[u].sl[kt].x & 0xffffu); acc[kt][1] = bf2f(st[u].sl[kt].x >> 16); acc[kt][2] = bf2f(st[u].sl[kt].y & 0xffffu); acc[kt][3] = bf2f(st[u].sl[kt].y >> 16); }
#pragma unroll
            for (int it = 0; it < 4; ++it) *(bf16x4*)(spc + st_off + 4096 + (16 * vt + fr) * 64 + 16 * it + 4 * fq) = bS[it];
#pragma unroll
            for (int kt = 0; kt < 4; ++kt)
#pragma unroll
                for (int it = 0; it < 4; it += 2) { if (MODE == 2) { acc[kt][0] += __builtin_bit_cast(float, (int)st[u].a[kt][it][0] + (int)bS[it][0]); } else acc[kt] = MM2(st[u].a[kt][it], bS[it], st[u].a[kt][it + 1], bS[it + 1], acc[kt]); }
#pragma unroll
            for (int kt = 0; kt < 4; ++kt) bS[kt] = to_b4(acc[kt]);
            if (MODE != 1) { const int cn = c + 4 < nch ? c + 4 : nch - 1; PROP_LOAD(u, cn); }
        }
    }
#undef PROP_LOAD
    if (s < 16 && fin) { float* so = F.out + OUT_SR + ((((size_t)s * 2 + dir) * 8 + h) * 4096) + (16 * vt + fr) * 64 + 4 * fq;
#pragma unroll
        for (int kt = 0; kt < 4; ++kt) *(f32x4*)(so + 16 * kt) = acc[kt]; }
}
constexpr int RPL_SLOT = 11520, RPL_NS = 12, RPL_FLG = RPL_SLOT * RPL_NS;
__device__ __forceinline__ void rwkv_prop_lat(Frame& F, int wu) {
    const Args& a = *F.a;
    const int hs = wu >> 2, vt = wu & 3, s = 16 + (hs >> 4), dir = (hs >> 3) & 1, h = hs & 7;
    const int lane = F.lane, fr = lane & 15, fq = lane >> 4;
    bf16_t* sp0 = (bf16_t*)(F.ws + WS_SP) + (size_t)r_slot0(s, dir, h) * 8192;
    LAS unsigned char* L = F.lds; volatile LAS unsigned* flg = (volatile LAS unsigned*)(L + RPL_FLG);
    __syncthreads();
    if (F.tid < 64) flg[F.tid] = 0u;
    __syncthreads();
    if (F.wave == 0) {
        bf16x4 bS[4];
        { const float* s0 = a.in[I_SR] + ((((size_t)(s - 16) * 2 + dir) * 8 + h) * 4096) + (16 * vt + fr) * 64 + 4 * fq;
#pragma unroll
            for (int it = 0; it < 4; ++it) bS[it] = to_b4(*(const f32x4*)(s0 + 16 * it)); }
#pragma unroll 1
        for (int c = 0; c < 32; ++c) {
            while (flg[c] == 0u) __builtin_amdgcn_s_sleep(1);
            asm volatile("" ::: "memory");
            const LAS unsigned char* sl_ = L + (c % RPL_NS) * RPL_SLOT;
            bf16x4 af[4][4]; f32x4 acc[4];
#pragma unroll
            for (int kt = 0; kt < 4; ++kt) { const u32x4 lo_ = *(const LAS u32x4*)(sl_ + (16 * kt + fr) * 144 + fq * 32), hi_ = *(const LAS u32x4*)(sl_ + (16 * kt + fr) * 144 + fq * 32 + 16);
                af[kt][0] = __builtin_bit_cast(bf16x4, (u32x2){lo_.x, lo_.y}); af[kt][1] = __builtin_bit_cast(bf16x4, (u32x2){lo_.z, lo_.w});
                af[kt][2] = __builtin_bit_cast(bf16x4, (u32x2){hi_.x, hi_.y}); af[kt][3] = __builtin_bit_cast(bf16x4, (u32x2){hi_.z, hi_.w}); }
            { const u32x4 lo_ = *(const LAS u32x4*)(sl_ + 9216 + fr * 144 + fq * 32), hi_ = *(const LAS u32x4*)(sl_ + 9216 + fr * 144 + fq * 32 + 16);
                const unsigned w8[8] = {lo_.x, lo_.y, lo_.z, lo_.w, hi_.x, hi_.y, hi_.z, hi_.w};
#pragma unroll
                for (int kt = 0; kt < 4; ++kt) { acc[kt][0] = bf2f(w8[2 * kt] & 0xffffu); acc[kt][1] = bf2f(w8[2 * kt] >> 16); acc[kt][2] = bf2f(w8[2 * kt + 1] & 0xffffu); acc[kt][3] = bf2f(w8[2 * kt + 1] >> 16); } }
            LDS_WAIT(); asm volatile("" ::: "memory");
            flg[32] = (unsigned)(c + 1);
            bf16_t* spc = sp0 + (size_t)c * 8192;
#pragma unroll
            for (int it = 0; it < 4; ++it) *(bf16x4*)(spc + 4096 + (16 * vt + fr) * 64 + 16 * it + 4 * fq) = bS[it];
#pragma unroll
            for (int kt = 0; kt < 4; ++kt)
#pragma unroll
                for (int it = 0; it < 4; it += 2) acc[kt] = MM2(af[kt][it], bS[it], af[kt][it + 1], bS[it + 1], acc[kt]);
#pragma unroll
            for (int kt = 0; kt < 4; ++kt) bS[kt] = to_b4(acc[kt]);
        }
    } else {
#pragma unroll 1
        for (int c = F.wave - 1; c < 32; c += 14) {
            const int c2 = c + 7; const bool two = c2 < 32;
            const unsigned char* g1 = (const unsigned char*)(sp0 + (size_t)c * 8192); const unsigned char* g2 = (const unsigned char*)(sp0 + (size_t)(two ? c2 : c) * 8192);
            u32x4 r1[10], r2[10];
#pragma unroll
            for (int j = 0; j < 8; ++j) r1[j] = *(const u32x4*)(g1 + (lane + 64 * j) * 16);
#pragma unroll
            for (int j = 0; j < 2; ++j) r1[8 + j] = *(const u32x4*)(g1 + 8192 + vt * 2048 + (lane + 64 * j) * 16);
#pragma unroll
            for (int j = 0; j < 8; ++j) r2[j] = *(const u32x4*)(g2 + (lane + 64 * j) * 16);
#pragma unroll
            for (int j = 0; j < 2; ++j) r2[8 + j] = *(const u32x4*)(g2 + 8192 + vt * 2048 + (lane + 64 * j) * 16);
            while ((int)flg[32] < c - (RPL_NS - 1)) __builtin_amdgcn_s_sleep(1);
            { LAS unsigned char* d = L + (c % RPL_NS) * RPL_SLOT;
#pragma unroll
                for (int j = 0; j < 8; ++j) { const int idx = lane + 64 * j; *(LAS u32x4*)(d + (idx >> 3) * 144 + (idx & 7) * 16) = r1[j]; }
#pragma unroll
                for (int j = 0; j < 2; ++j) { const int idx = lane + 64 * j; *(LAS u32x4*)(d + 9216 + (idx >> 3) * 144 + (idx & 7) * 16) = r1[8 + j]; }
                LDS_WAIT(); asm volatile("" ::: "memory"); flg[c] = 1u; }
            if (two) {
                while ((int)flg[32] < c2 - (RPL_NS - 1)) __builtin_amdgcn_s_sleep(1);
                LAS unsigned char* d = L + (c2 % RPL_NS) * RPL_SLOT;
#pragma unroll
                for (int j = 0; j < 8; ++j) { const int idx = lane + 64 * j; *(LAS u32x4*)(d + (idx >> 3) * 144 + (idx & 7) * 16) = r2[j]; }
#pragma unroll
                for (int j = 0; j < 2; ++j) { const int idx = lane + 64 * j; *(LAS u32x4*)(d + 9216 + (idx >> 3) * 144 + (idx & 7) * 16) = r2[8 + j]; }
                LDS_WAIT(); asm volatile("" ::: "memory"); flg[c2] = 1u; }
        }
    }
}
__device__ __forceinline__ void rwkv_fix(Frame& F, int wu2) {
    const Args& a = *F.a; const int wu = wu2 >> 1, th = wu2 & 1;
    int s, cc, h;
    if (wu < 512) { const int cg = wu >> 3; h = wu & 7; s = cg >> 2; cc = cg & 3; } else { const int u2 = wu - 512, cg = u2 >> 3; h = u2 & 7; s = 16 + (cg >> 5); cc = cg & 31; }
    const int sb = seq_base(s), nch = seq_len(s) / 64, tok0 = sb + cc * 64, lane = F.lane, fr = lane & 15, fq = lane >> 4;
    f32x4 acc[4][2];
#pragma unroll
    for (int vt = 0; vt < 4; ++vt)
#pragma unroll
        for (int tt = 0; tt < 2; ++tt) acc[vt][tt] = (f32x4){0.f, 0.f, 0.f, 0.f};
#pragma unroll
    for (int d = 0; d < 2; ++d) {
        const bf16_t* sin = (const bf16_t*)(F.ws + WS_SP) + (size_t)(r_slot0(s, d, h) + (d ? nch - 1 - cc : cc)) * 8192 + 4096;
        const bf16_t* us = (const bf16_t*)F.out + (size_t)(2 + d) * NTOK * 512 + h * 64;
#pragma unroll
        for (int ks = 0; ks < 2; ++ks) { bf16x8 aS[4], bU[2];
#pragma unroll
            for (int i = 0; i < 4; ++i) aS[i] = *(const bf16x8*)(sin + (16 * i + fr) * 64 + 32 * ks + 8 * fq);
#pragma unroll
            for (int i = 0; i < 2; ++i) bU[i] = *(const bf16x8*)(us + (size_t)(tok0 + 32 * th + 16 * i + fr) * 512 + 32 * ks + 8 * fq);
#pragma unroll
            for (int vt = 0; vt < 4; ++vt)
#pragma unroll
                for (int tt = 0; tt < 2; ++tt) acc[vt][tt] = __builtin_amdgcn_mfma_f32_16x16x32_bf16(aS[vt], bU[tt], acc[vt][tt], 0, 0, 0); }
    }
    const bf16_t* YS = (const bf16_t*)F.out + h * 64 + 4 * fq;
#pragma unroll
    for (int tt = 0; tt < 2; ++tt) { const size_t tok = (size_t)(tok0 + 32 * th + 16 * tt + fr);
        float sm = 0.f;
#pragma unroll
        for (int vt = 0; vt < 4; ++vt) { const u32x2 y0 = *(const u32x2*)(YS + tok * 512 + 16 * vt), y1 = *(const u32x2*)(YS + ((size_t)NTOK + tok) * 512 + 16 * vt);
            acc[vt][tt][0] += bf2f(y0.x & 0xffffu) + bf2f(y1.x & 0xffffu); acc[vt][tt][1] += bf2f(y0.x >> 16) + bf2f(y1.x >> 16);
            acc[vt][tt][2] += bf2f(y0.y & 0xffffu) + bf2f(y1.y & 0xffffu); acc[vt][tt][3] += bf2f(y0.y >> 16) + bf2f(y1.y >> 16);
            sm += (acc[vt][tt][0] + acc[vt][tt][1]) + (acc[vt][tt][2] + acc[vt][tt][3]); }
        sm += __shfl_xor(sm, 16); sm += __shfl_xor(sm, 32);
        const float mean = sm * (1.f / 64.f); float vs = 0.f;
#pragma unroll
        for (int vt = 0; vt < 4; ++vt)
#pragma unroll
            for (int j = 0; j < 4; ++j) { acc[vt][tt][j] -= mean; vs += acc[vt][tt][j] * acc[vt][tt][j]; }
        vs += __shfl_xor(vs, 16); vs += __shfl_xor(vs, 32);
        const float rstd = rsqrtf(vs * (1.f / 64.f) + 64e-5f), bon = ((const float*)(F.ws + WS_BON))[tok * 8 + h];
#pragma unroll
        for (int vt = 0; vt < 4; ++vt) { const int c = h * 64 + 16 * vt + 4 * fq;
            const u32x2 vv = *(const u32x2*)((const bf16_t*)(F.ws + WS_PV) + tok * 512 + c), gg = *(const u32x2*)((const bf16_t*)(F.ws + WS_PG) + tok * 512 + c);
            const f32x4 lg = *(const f32x4*)(a.in[I_LNG] + c), lb = *(const f32x4*)(a.in[I_LNB] + c);
            const float v4[4] = {bf2f(vv.x & 0xffffu), bf2f(vv.x >> 16), bf2f(vv.y & 0xffffu), bf2f(vv.y >> 16)}, g4[4] = {bf2f(gg.x & 0xffffu), bf2f(gg.x >> 16), bf2f(gg.y & 0xffffu), bf2f(gg.y >> 16)};
            float r[4];
#pragma unroll
            for (int j = 0; j < 4; ++j) r[j] = (acc[vt][tt][j] * rstd * lg[j] + lb[j] + bon * v4[j]) * g4[j];
            u32x2 o; o.x = cvt_pk(r[0], r[1]); o.y = cvt_pk(r[2], r[3]);
            *(u32x2*)((bf16_t*)(F.ws + WS_YRB) + tok * 512 + c) = o; }
    }
}

__device__ __forceinline__ f32x4 mma16(const LAS unsigned char* A, int sa, const LAS unsigned char* B, int sb, int K, f32x4 acc, int fr, int fq) {
#pragma unroll
    for (int k0 = 0; k0 < K; k0 += 32) {
        const bf16x8 av = *(const LAS bf16x8*)(A + fr * sa + (k0 + fq * 8) * 2);
        const bf16x8 bv = *(const LAS bf16x8*)(B + fr * sb + (k0 + fq * 8) * 2);
        acc = __builtin_amdgcn_mfma_f32_16x16x32_bf16(av, bv, acc, 0, 0, 0);
    }
    return acc;
}
typedef short v4i16_t __attribute__((ext_vector_type(4)));
__device__ __forceinline__ bf16x4 tr_frag(const LAS unsigned char* tile, int rs, int r0, int c0, int lane) {
    const int g = lane >> 4, q = (lane & 15) >> 2, p = lane & 3;
    return __builtin_bit_cast(bf16x4, __builtin_amdgcn_ds_read_tr16_b64_v4i16((LAS v4i16_t*)(tile + (r0 + 4 * g + q) * rs + (c0 + 4 * p) * 2)));
}
__device__ __forceinline__ int m_slot(int s, int dir, int h, int c) { return s < 16 ? (((s * 2 + dir) * 4 + h) * 2 + c) : 256 + ((((s - 16) * 2 + dir) * 4 + h) * 16 + c); }
__device__ __forceinline__ bf16_t* dc_ptr(unsigned char* ws, int slot) { return (bf16_t*)(ws + WS_DCC) + (size_t)slot * 16384; }
__device__ __forceinline__ float wave_max(float v) {
#pragma unroll
    for (int o = 1; o < 64; o <<= 1) v = fmaxf(v, __shfl_xor(v, o));
    return v;
}
constexpr int PA_K = 0, PA_V = 36864, PA_F = 73728, PA_S = 288, PA_SET = 75264;
__device__ __forceinline__ void pa_decode(int slot, int& dir, int& h, int& tok0) {
    int s, c;
    if (slot < 256) { const int hs = slot >> 1; c = slot & 1; s = hs >> 3; dir = (hs >> 2) & 1; h = hs & 3; } else { const int u2 = slot - 256, hs = u2 >> 4; c = u2 & 15; s = 16 + (hs >> 3); dir = (hs >> 2) & 1; h = hs & 3; }
    const int T = seq_len(s), oc = dir ? T / 128 - 1 - c : c; tok0 = seq_base(s) + oc * 128;
}
__device__ __forceinline__ void mlstm_passA(Frame& F, int slotA) {
    const int tid = F.tid, lane = F.lane, w = F.wave, fr = lane & 15, fq = lane >> 4;
    LAS unsigned char* L = F.lds;
    __syncthreads();
#pragma unroll
    for (int p = 0; p < 2; ++p) { int dir, h, tok0; pa_decode(slotA + 256 * p, dir, h, tok0);
        LAS unsigned char* Lp = L + p * PA_SET; LAS float* fv = (LAS float*)(Lp + PA_F);
        const bf16_t* MK = (const bf16_t*)(F.ws + WS_MK) + h * 128; const bf16_t* ZV = (const bf16_t*)(F.ws + WS_Z2) + Z2_V + h * 128;
        const int j = tid >> 2, part = tid & 3; const size_t tok = (size_t)(tok0 + j);
#pragma unroll
        for (int q = 0; q < 4; ++q) { const int c8 = part * 32 + q * 8;
            *(LAS u32x4*)(Lp + PA_K + j * PA_S + c8 * 2) = *(const u32x4*)(MK + tok * 512 + c8); *(LAS u32x4*)(Lp + PA_V + j * PA_S + c8 * 2) = *(const u32x4*)(ZV + tok * Z2C + c8); }
        if (tid < 128) fv[tid] = ((const float*)(F.ws + WS_LI) + (size_t)(dir * 4 + h) * NTOK)[tok0 + tid];
        else if (tid < 256) fv[tid] = ((const float*)(F.ws + WS_LF) + (size_t)(dir * 4 + h) * NTOK)[tok0 + tid - 128]; }
    __syncthreads();
    if (w < 2) {
        int dir, h, tok0; pa_decode(slotA + 256 * w, dir, h, tok0); (void)h; (void)tok0;
        LAS float* fv = (LAS float*)(L + w * PA_SET + PA_F); LAS float *vli = fv, *vlf = fv + 128, *vwj = fv + 256;
        const int op0 = dir ? 127 - 2 * lane : 2 * lane, op1 = dir ? op0 - 1 : op0 + 1;
        const float f0 = vlf[op0], f1 = vlf[op1]; float sc = f0 + f1;
#pragma unroll
        for (int o = 1; o < 64; o <<= 1) { const float t = __shfl_up(sc, o); if (lane >= o) sc += t; }
        const float b1 = sc, b0 = sc - f1, a0 = vli[op0] - b0, a1 = vli[op1] - b1, mx = wave_max(fmaxf(a0, a1)), bL = __shfl(b1, 63);
        vwj[op0] = __expf(a0 - mx); vwj[op1] = __expf(a1 - mx);
        if (lane == 0) { float* ms = (float*)(F.ws + WS_MS) + (size_t)(slotA + 256 * w) * 4; ms[0] = mx; ms[1] = bL; }
    }
    __syncthreads();
#pragma unroll
    for (int p = 0; p < 2; ++p) { const int slot = slotA + 256 * p;
        const LAS unsigned char* Lp = L + p * PA_SET; const LAS float* vwj = (const LAS float*)(Lp + PA_F) + 256;
        bf16x4 bv[8], bw[8];
#pragma unroll
        for (int sl = 0; sl < 8; ++sl) { const u32x2 r = __builtin_bit_cast(u32x2, tr_frag(Lp + PA_V, PA_S, 16 * sl, 16 * w, lane)); const f32x4 wj4 = *(const LAS f32x4*)(vwj + 16 * sl + 4 * fq);
            u32x2 o; o.x = cvt_pk(bf2f(r.x & 0xffffu) * wj4[0], bf2f(r.x >> 16) * wj4[1]); o.y = cvt_pk(bf2f(r.y & 0xffffu) * wj4[2], bf2f(r.y >> 16) * wj4[3]);
            bv[sl] = __builtin_bit_cast(bf16x4, o);
            u32x2 ow; ow.x = cvt_pk(wj4[0], wj4[1]); ow.y = cvt_pk(wj4[2], wj4[3]); bw[sl] = __builtin_bit_cast(bf16x4, ow); }
        bf16_t* dc = dc_ptr(F.ws, slot);
#pragma unroll
        for (int kt = 0; kt < 8; ++kt) {
            f32x4 acc = {0.f, 0.f, 0.f, 0.f};
#pragma unroll
            for (int sl = 0; sl < 8; sl += 2) acc = MM2(tr_frag(Lp + PA_K, PA_S, 16 * sl, 16 * kt, lane), bv[sl], tr_frag(Lp + PA_K, PA_S, 16 * sl + 16, 16 * kt, lane), bv[sl + 1], acc);
            u32x2 o; o.x = cvt_pk(acc[0], acc[1]); o.y = cvt_pk(acc[2], acc[3]);
            *(u32x2*)(dc + (size_t)(16 * w + fr) * 128 + 16 * kt + 4 * fq) = o; }
        { f32x4 acc = {0.f, 0.f, 0.f, 0.f};
#pragma unroll
            for (int sl = 0; sl < 8; sl += 2) acc = MM2(tr_frag(Lp + PA_K, PA_S, 16 * sl, 16 * w, lane), bw[sl], tr_frag(Lp + PA_K, PA_S, 16 * sl + 16, 16 * w, lane), bw[sl + 1], acc);
            if (fr == 0) *(f32x4*)((float*)(F.ws + WS_DN) + (size_t)slot * 128 + 16 * w + 4 * fq) = acc; }
    }
}
constexpr int C3_SC = 0, C3_K = 4096, C3_VT = 4096 + 34816, C3_CIN = 4096 + 2 * 34816, C3_S = 272;
__device__ __forceinline__ void mlstm_passC3(Frame& F, int ch) {
    const Args& a = *F.a;
    int s, h, cc;
    if (ch < 128) { s = ch >> 3; h = (ch >> 1) & 3; cc = ch & 1; } else { const int u2 = ch - 128; s = 16 + (u2 >> 6); h = (u2 >> 4) & 3; cc = u2 & 15; }
    const int sb = seq_base(s), nch = seq_len(s) / 128, tok0 = sb + cc * 128, tid = F.tid, lane = F.lane, st = F.wave, fr = lane & 15, fq = lane >> 4;
    const size_t tok = (size_t)(tok0 + 16 * st + fr);
    const bf16_t* MQ = (const bf16_t*)(F.ws + WS_MQ) + h * 128; const bf16_t* MK = (const bf16_t*)(F.ws + WS_MK) + h * 128;
    const int slotd[2] = {m_slot(s, 0, h, cc), m_slot(s, 1, h, nch - 1 - cc)};
    LAS unsigned char* L = F.lds; LAS float* scl_ = (LAS float*)(L + C3_SC);
    __syncthreads();
    {
        const int j = tid >> 2, part = tid & 3; const size_t tj = (size_t)(tok0 + j);
        const bf16_t* Z2v = (const bf16_t*)(F.ws + WS_Z2) + Z2_V + h * 128;
#pragma unroll
        for (int q = 0; q < 4; ++q) { const int c8 = part * 32 + q * 8;
            *(LAS u32x4*)(L + C3_K + j * C3_S + c8 * 2) = *(const u32x4*)(MK + tj * 512 + c8);
            const u32x4 v0 = *(const u32x4*)(Z2v + tj * Z2C + c8); const unsigned vw[4] = {v0.x, v0.y, v0.z, v0.w};
#pragma unroll
            for (int i = 0; i < 4; ++i) { *(LAS bf16_t*)(L + C3_VT + (c8 + 2 * i) * C3_S + j * 2) = (bf16_t)(vw[i] & 0xffffu); *(LAS bf16_t*)(L + C3_VT + (c8 + 2 * i + 1) * C3_S + j * 2) = (bf16_t)(vw[i] >> 16); } }
        if (F.wave < 2) {
            const int d = F.wave; LAS float* dv = scl_ + d * 512;
            const float m_in = ((const float*)(F.ws + WS_MS))[(size_t)slotd[d] * 4 + 2];
            const float* LI = (const float*)(F.ws + WS_LI) + (size_t)(d * 4 + h) * NTOK + tok0; const float* LF = (const float*)(F.ws + WS_LF) + (size_t)(d * 4 + h) * NTOK + tok0;
            const int op0 = d ? 127 - 2 * lane : 2 * lane, op1 = d ? op0 - 1 : op0 + 1;
            const float f0 = LF[op0], f1 = LF[op1]; float sc = f0 + f1;
#pragma unroll
            for (int o = 1; o < 64; o <<= 1) { const float t = __shfl_up(sc, o); if (lane >= o) sc += t; }
            const float b1 = sc, b0 = sc - f1, a0 = LI[op0] - b0, a1 = LI[op1] - b1;
            float mxp = fmaxf(a0, a1);
#pragma unroll
            for (int o = 1; o < 64; o <<= 1) { const float t = __shfl_up(mxp, o); if (lane >= o) mxp = fmaxf(mxp, t); }
            float mprev = __shfl_up(mxp, 1); if (lane == 0) mprev = -3.0e38f;
            const float M0 = fmaxf(m_in, fmaxf(mprev, a0)), M1 = fmaxf(m_in, mxp);
            dv[op0] = a0; dv[128 + op0] = M0; dv[256 + op0] = __expf(m_in - M0); dv[384 + op0] = __expf(-b0 - M0);
            dv[op1] = a1; dv[128 + op1] = M1; dv[256 + op1] = __expf(m_in - M1); dv[384 + op1] = __expf(-b1 - M1); } }
    bf16x8 qf[4];
#pragma unroll
    for (int ks = 0; ks < 4; ++ks) qf[ks] = *(const bf16x8*)(MQ + tok * 512 + 32 * ks + 8 * fq);
    __syncthreads();
    f32x4 ST[8];
#pragma unroll
    for (int jt = 0; jt < 8; ++jt) { f32x4 acc = {0.f, 0.f, 0.f, 0.f};
#pragma unroll
        for (int ks = 0; ks < 4; ++ks) acc = __builtin_amdgcn_mfma_f32_16x16x32_bf16(*(const LAS bf16x8*)(L + C3_K + (16 * jt + fr) * C3_S + (32 * ks + 8 * fq) * 2), qf[ks], acc, 0, 0, 0);
        ST[jt] = acc; }
    const int sl = 16 * st + fr;
    float hv[8][4];
#pragma unroll
    for (int vt = 0; vt < 8; ++vt)
#pragma unroll
        for (int jj = 0; jj < 4; ++jj) hv[vt][jj] = 0.f;
#pragma unroll 1
    for (int d = 0; d < 2; ++d) {
        const LAS float* dv = scl_ + d * 512;
        __syncthreads();
        { const bf16_t* cin = dc_ptr(F.ws, slotd[d]);
#pragma unroll
            for (int r = 0; r < 4; ++r) { const int idx = tid + 512 * r, row = idx >> 4, c8 = (idx & 15) * 8; *(LAS u32x4*)(L + C3_CIN + row * C3_S + c8 * 2) = *(const u32x4*)(cin + (size_t)row * 128 + c8); } }
        const float Ms = dv[128 + sl], inter = dv[256 + sl], eneg = dv[384 + sl];
        bf16x4 bS[8]; float rs = 0.f;
#pragma unroll
        for (int jt = 0; jt < 8; ++jt) { const f32x4 a4 = *(const LAS f32x4*)(dv + 16 * jt + 4 * fq); f32x4 v;
#pragma unroll
            for (int jj = 0; jj < 4; ++jj) { const int j = 16 * jt + 4 * fq + jj; const bool keep = d ? (j >= sl) : (j <= sl); v[jj] = keep ? ST[jt][jj] * __expf(a4[jj] - Ms) : 0.f; rs += v[jj]; }
            bS[jt] = to_b4(v); }
        rs += __shfl_xor(rs, 16); rs += __shfl_xor(rs, 32);
        float qn = 0.f; { const float* nd = (const float*)(F.ws + WS_DN) + (size_t)slotd[d] * 128;
#pragma unroll
            for (int ks = 0; ks < 4; ++ks) { float qv[8]; unpack8(__builtin_bit_cast(u32x4, qf[ks]), qv); const f32x4 n0 = *(const f32x4*)(nd + 32 * ks + 8 * fq), n1 = *(const f32x4*)(nd + 32 * ks + 8 * fq + 4);
#pragma unroll
                for (int i = 0; i < 4; ++i) qn += qv[i] * n0[i] + qv[4 + i] * n1[i]; } }
        qn += __shfl_xor(qn, 16); qn += __shfl_xor(qn, 32);
        const float scl = 1.f / fmaxf(fabsf(inter * qn + rs), eneg);
        __syncthreads();
#pragma unroll
        for (int vt = 0; vt < 8; ++vt) {
            f32x4 ai = {0.f, 0.f, 0.f, 0.f}, av = {0.f, 0.f, 0.f, 0.f};
#pragma unroll
            for (int ks = 0; ks < 4; ++ks) ai = __builtin_amdgcn_mfma_f32_16x16x32_bf16(*(const LAS bf16x8*)(L + C3_CIN + (16 * vt + fr) * C3_S + (32 * ks + 8 * fq) * 2), qf[ks], ai, 0, 0, 0);
#pragma unroll
            for (int jt = 0; jt < 8; jt += 2) av = MM2(*(const LAS bf16x4*)(L + C3_VT + (16 * vt + fr) * C3_S + (16 * jt + 4 * fq) * 2), bS[jt], *(const LAS bf16x4*)(L + C3_VT + (16 * vt + fr) * C3_S + (16 * jt + 16 + 4 * fq) * 2), bS[jt + 1], av);
#pragma unroll
            for (int jj = 0; jj < 4; ++jj) hv[vt][jj] += (inter * ai[jj] + av[jj]) * scl;
        }
    }
    float s1 = 0.f, s2 = 0.f;
#pragma unroll
    for (int vt = 0; vt < 8; ++vt)
#pragma unroll
        for (int jj = 0; jj < 4; ++jj) { s1 += hv[vt][jj]; s2 += hv[vt][jj] * hv[vt][jj]; }
    s1 += __shfl_xor(s1, 16); s1 += __shfl_xor(s1, 32); s2 += __shfl_xor(s2, 16); s2 += __shfl_xor(s2, 32);
    const float mean = s1 * (1.f / 128.f), rstd = rsqrtf(fmaxf(s2 * (1.f / 128.f) - mean * mean, 0.f) + 1e-5f);
#pragma unroll
    for (int vt = 0; vt < 8; ++vt) { const int c = h * 128 + 16 * vt + 4 * fq;
        const u32x2 ow = *(const u32x2*)((const bf16_t*)(F.ws + WS_Z2) + tok * Z2C + Z2_O + c); const f32x4 gg = *(const f32x4*)(a.in[I_MGNG] + c);
        const float o4[4] = {bf2f(ow.x & 0xffffu), bf2f(ow.x >> 16), bf2f(ow.y & 0xffffu), bf2f(ow.y >> 16)};
        u32x2 o; o.x = cvt_pk((hv[vt][0] - mean) * rstd * gg[0] * sigm(o4[0]), (hv[vt][1] - mean) * rstd * gg[1] * sigm(o4[1]));
        o.y = cvt_pk((hv[vt][2] - mean) * rstd * gg[2] * sigm(o4[2]), (hv[vt][3] - mean) * rstd * gg[3] * sigm(o4[3]));
        *(u32x2*)((bf16_t*)(F.ws + WS_YMB) + tok * 512 + c) = o; }
}
template <int EPT  , int NCH, int PF>
__device__ __forceinline__ void mlstm_prop_t(Frame& F, int s, int dir, int h, int slice) {
    const Args& a = *F.a;
    const int tid = F.tid, e0 = slice * (512 * EPT) + tid * EPT;
    const int slot0 = m_slot(s, dir, h, 0);
    float* MSp = (float*)(F.ws + WS_MS); float* DNp = (float*)(F.ws + WS_DN);
    LAS float* sc = (LAS float*)F.lds;
    __syncthreads();
    if (F.wave == 0) {
        float mx = 0.f, bL = 0.f; if (F.lane < NCH) { mx = MSp[(size_t)(slot0 + F.lane) * 4]; bL = MSp[(size_t)(slot0 + F.lane) * 4 + 1]; }
        float m = s >= 16 ? a.in[I_SM][((size_t)(s - 16) * 2 + dir) * 4 + h] : 0.f;
        for (int c = 0; c < NCH; ++c) { const float mxc = __shfl(mx, c), blc = __shfl(bL, c), Mf = fmaxf(m, mxc);
            if (F.lane == 0) { sc[2 * c] = __expf(m - Mf); sc[2 * c + 1] = __expf(mxc - Mf); if (slice == 0) MSp[(size_t)(slot0 + c) * 4 + 2] = m; }
            m = blc + Mf; }
        if (F.lane == 0 && slice == 0 && s < 16) F.out[OUT_SM + ((size_t)s * 2 + dir) * 4 + h] = m;
    }
    __syncthreads();
    float Cf[EPT];
    if (s >= 16) { const float* c0 = a.in[I_SC] + (((size_t)(s - 16) * 2 + dir) * 4 + h) * 16384 + e0;
#pragma unroll
        for (int i = 0; i < EPT / 4; ++i) { const f32x4 v = *(const f32x4*)(c0 + 4 * i); Cf[4 * i] = v.x; Cf[4 * i + 1] = v.y; Cf[4 * i + 2] = v.z; Cf[4 * i + 3] = v.w; }
    } else {
#pragma unroll
        for (int i = 0; i < EPT; ++i) Cf[i] = 0.f;
    }
    u32x2 ring[PF][EPT / 4];
#pragma unroll
    for (int u = 0; u < PF; ++u) { const bf16_t* dc = dc_ptr(F.ws, slot0 + u) + e0;
#pragma unroll
        for (int i = 0; i < EPT / 4; ++i) ring[u][i] = *(const u32x2*)(dc + 4 * i); }
    for (int c0 = 0; c0 < NCH; c0 += PF) {
#pragma unroll
        for (int u = 0; u < PF; ++u) { const int c = c0 + u; bf16_t* dcw = dc_ptr(F.ws, slot0 + c) + e0; const float e1 = sc[2 * c], e2 = sc[2 * c + 1];
#pragma unroll
            for (int i = 0; i < EPT / 4; ++i) { const u32x2 d = ring[u][i];
                u32x2 o; o.x = cvt_pk(Cf[4 * i], Cf[4 * i + 1]); o.y = cvt_pk(Cf[4 * i + 2], Cf[4 * i + 3]); *(u32x2*)(dcw + 4 * i) = o;
                Cf[4 * i] = e1 * Cf[4 * i] + e2 * bf2f(d.x & 0xffffu); Cf[4 * i + 1] = e1 * Cf[4 * i + 1] + e2 * bf2f(d.x >> 16);
                Cf[4 * i + 2] = e1 * Cf[4 * i + 2] + e2 * bf2f(d.y & 0xffffu); Cf[4 * i + 3] = e1 * Cf[4 * i + 3] + e2 * bf2f(d.y >> 16); }
            { const int cn = c + PF < NCH ? c + PF : NCH - 1; const bf16_t* dc = dc_ptr(F.ws, slot0 + cn) + e0;
#pragma unroll
                for (int i = 0; i < EPT / 4; ++i) ring[u][i] = *(const u32x2*)(dc + 4 * i); }
        }
    }
    if (slice == 0 && tid < 128) {
        float nf = s >= 16 ? a.in[I_SN][(((size_t)(s - 16) * 2 + dir) * 4 + h) * 128 + tid] : 0.f;
        float dn[NCH];
#pragma unroll
        for (int c = 0; c < NCH; ++c) dn[c] = DNp[(size_t)(slot0 + c) * 128 + tid];
#pragma unroll
        for (int c = 0; c < NCH; ++c) { DNp[(size_t)(slot0 + c) * 128 + tid] = nf; nf = sc[2 * c] * nf + sc[2 * c + 1] * dn[c]; }
        if (s < 16) F.out[OUT_SN + (((size_t)s * 2 + dir) * 4 + h) * 128 + tid] = nf;
    }
    if (s < 16) { float* co = F.out + OUT_SC + (((size_t)s * 2 + dir) * 4 + h) * 16384 + e0;
#pragma unroll
        for (int i = 0; i < EPT / 4; ++i) *(f32x4*)(co + 4 * i) = (f32x4){Cf[4 * i], Cf[4 * i + 1], Cf[4 * i + 2], Cf[4 * i + 3]}; }
}
__device__ __forceinline__ void p8_rows(Frame& F) {
    const Args& a = *F.a; const float* ng = a.in[I_NORMG];
    for (int row = F.gw; row < NTOK; row += F.NGW) {
        const f32x4* xr = (const f32x4*)xrow_ptr(a, row) + F.lane; const u32x2* orow = (const u32x2*)((const bf16_t*)(F.ws + WS_OUT1) + (size_t)row * D) + F.lane;
        const float* mod = (const float*)(F.ws + WS_MOD) + cond_of(row) * 6144;
        f32x4 v[4]; float ss = 0.f;
#pragma unroll
        for (int j = 0; j < 4; ++j) { const u32x2 p0 = orow[64 * j], p1 = orow[64 * j + (size_t)NTOK * D / 4];
            v[j] = (f32x4){bf2f(p0.x & 0xffffu) + bf2f(p1.x & 0xffffu), bf2f(p0.x >> 16) + bf2f(p1.x >> 16), bf2f(p0.y & 0xffffu) + bf2f(p1.y & 0xffffu), bf2f(p0.y >> 16) + bf2f(p1.y >> 16)};
            ss += (v[j].x * v[j].x + v[j].y * v[j].y) + (v[j].z * v[j].z + v[j].w * v[j].w); }
        const float rstd = rsqrtf(wave_sum(ss) * (1.f / D) + 1e-6f);
        u32x2* x1o = (u32x2*)((bf16_t*)(F.ws + WS_X1B) + (size_t)row * D) + F.lane; ss = 0.f;
#pragma unroll
        for (int j = 0; j < 4; ++j) { const int col = 4 * (64 * j + F.lane);
            const f32x4 g = *(const f32x4*)(ng + 1024 + col), g1 = *(const f32x4*)(mod + 2048 + col);
            v[j] = xr[64 * j] + g1 * (v[j] * rstd * g); { u32x2 w; w.x = cvt_pk(v[j].x, v[j].y); w.y = cvt_pk(v[j].z, v[j].w); x1o[64 * j] = w; }
            ss += (v[j].x * v[j].x + v[j].y * v[j].y) + (v[j].z * v[j].z + v[j].w * v[j].w); }
        const float rstd2 = rsqrtf(wave_sum(ss) * (1.f / D) + 1e-6f);
        u32x2* o = (u32x2*)((bf16_t*)(F.ws + WS_H) + (size_t)row * D) + F.lane;
#pragma unroll
        for (int j = 0; j < 4; ++j) { const int col = 4 * (64 * j + F.lane);
            const f32x4 g = *(const f32x4*)(ng + 2048 + col), sh = *(const f32x4*)(mod + 3072 + col), sc = *(const f32x4*)(mod + 4096 + col);
            const f32x4 h = v[j] * rstd2 * g * (sc + 1.f) + sh;
            u32x2 w; w.x = pk2(h.x, h.y); w.y = pk2(h.z, h.w); o[64 * j] = w; }
    }
}

template <int NT>
__device__ __forceinline__ void p10_item(Frame& F, int tok0, int c8) {
    const Args& a = *F.a;
    const bf16_t* U = (const bf16_t*)(F.ws + WS_Z); bf16_t* FIN = (bf16_t*)(F.ws + WS_FIN);
    const int uc = 256 * (c8 >> 7) + (c8 & 127);
    const int t0 = (tok0 - NCTX) & 2047, y = t0 >> 6, x0 = t0 & 63;
    const float* cw = a.in[I_FCONV] + c8;
    u32x4 vraw[NT];
#pragma unroll
    for (int jj = 0; jj < NT; ++jj) vraw[jj] = *(const u32x4*)(U + (size_t)(tok0 + jj) * UPC + uc + 128);
    float acc[NT][8];
    { const f32x4 b0 = *(const f32x4*)(a.in[I_FCB] + c8), b1 = *(const f32x4*)(a.in[I_FCB] + c8 + 4);
#pragma unroll
        for (int jj = 0; jj < NT; ++jj) { acc[jj][0] = b0[0]; acc[jj][1] = b0[1]; acc[jj][2] = b0[2]; acc[jj][3] = b0[3]; acc[jj][4] = b1[0]; acc[jj][5] = b1[1]; acc[jj][6] = b1[2]; acc[jj][7] = b1[3]; } }
#pragma unroll 1
    for (int dy = -1; dy <= 1; ++dy) {
        const bool rowok = y + dy >= 0 && y + dy < 32;
        if (!rowok) continue;
        float wt[3][8];
#pragma unroll
        for (int dx = 0; dx < 3; ++dx) { const f32x4 w0 = *(const f32x4*)(cw + ((dy + 1) * 3 + dx) * DFF), w1 = *(const f32x4*)(cw + ((dy + 1) * 3 + dx) * DFF + 4);
#pragma unroll
            for (int e = 0; e < 4; ++e) { wt[dx][e] = w0[e]; wt[dx][4 + e] = w1[e]; } }
#pragma unroll
        for (int i = 0; i < NT + 2; ++i) { const int xx = x0 - 1 + i; const bool ok = xx >= 0 && xx < 64;
            float xv[8]; unpack8(*(const u32x4*)(U + ((long)(tok0 + dy * 64) + (i - 1)) * UPC + uc), xv);
            const float cm = ok ? 1.f : 0.f;
#pragma unroll
            for (int dx = -1; dx <= 1; ++dx) { const int jj = i - 1 - dx;
                if (jj >= 0 && jj < NT) {
#pragma unroll
                    for (int e = 0; e < 8; ++e) acc[jj][e] += (wt[dx + 1][e] * cm) * xv[e]; } }
        }
    }
#pragma unroll
    for (int jj = 0; jj < NT; ++jj) { float x[8]; unpack8(vraw[jj], x);
        u32x4 o; o.x = cvt_pk(silu(acc[jj][0]) * x[0], silu(acc[jj][1]) * x[1]); o.y = cvt_pk(silu(acc[jj][2]) * x[2], silu(acc[jj][3]) * x[3]);
        o.z = cvt_pk(silu(acc[jj][4]) * x[4], silu(acc[jj][5]) * x[5]); o.w = cvt_pk(silu(acc[jj][6]) * x[6], silu(acc[jj][7]) * x[7]);
        *(u32x4*)(FIN + (size_t)(tok0 + jj) * DFF + c8) = o; }
}
__device__ __forceinline__ void p10_ffn_conv(Frame& F) {
    const int t = (int)blockIdx.x * 512 + F.tid;
    { const int sl = t / 352, c8 = (t - sl * 352) * 8; p10_item<8>(F, NCTX + sl * 8, c8); }
    asm volatile("" ::: "memory"); __builtin_amdgcn_sched_barrier(0);
    if (t < 98304) { const int it = 131072 + (t >> 1), sl = it / 352, c8 = (it - sl * 352) * 8; p10_item<4>(F, NCTX + sl * 8 + 4 * (t & 1), c8); }
}

__device__ __forceinline__ void p12_final(Frame& F) {
    const Args& a = *F.a; const float* ng = a.in[I_NORMG];
    for (int row = F.gw; row < NTOK; row += F.NGW) {
        const u32x2* fr_ = (const u32x2*)((const bf16_t*)(F.ws + WS_Z) + (size_t)row * D) + F.lane; f32x4* xo = (f32x4*)(F.out + (size_t)row * D) + F.lane;
        const float* mod = (const float*)(F.ws + WS_MOD) + cond_of(row) * 6144;
        f32x4 v[4]; float ss = 0.f;
#pragma unroll
        for (int j = 0; j < 4; ++j) { const u32x2 p0 = fr_[64 * j], p1 = fr_[64 * j + (size_t)NTOK * D / 4];
            v[j] = (f32x4){bf2f(p0.x & 0xffffu) + bf2f(p1.x & 0xffffu), bf2f(p0.x >> 16) + bf2f(p1.x >> 16), bf2f(p0.y & 0xffffu) + bf2f(p1.y & 0xffffu), bf2f(p0.y >> 16) + bf2f(p1.y >> 16)}; ss += (v[j].x * v[j].x + v[j].y * v[j].y) + (v[j].z * v[j].z + v[j].w * v[j].w); }
        const float rstd = rsqrtf(wave_sum(ss) * (1.f / D) + 1e-6f);
#pragma unroll
        for (int j = 0; j < 4; ++j) { const int col = 4 * (64 * j + F.lane);
            const f32x4 g = *(const f32x4*)(ng + 3072 + col), g2 = *(const f32x4*)(mod + 5120 + col);
            const u32x2 xw = ((const u32x2*)((const bf16_t*)(F.ws + WS_X1B) + (size_t)row * D) + F.lane)[64 * j];
            const f32x4 x1 = {bf2f(xw.x & 0xffffu), bf2f(xw.x >> 16), bf2f(xw.y & 0xffffu), bf2f(xw.y >> 16)};
            xo[64 * j] = x1 + g2 * (v[j] * rstd * g); }
    }
}

__global__ void __launch_bounds__(512, 2) trunk_fwd(Args args) {
    extern __shared__ __attribute__((aligned(16))) unsigned char lds_raw[];
    Frame F;
    F.lds = (LAS unsigned char*)lds_raw; F.a = &args;
    F.tid = threadIdx.x; F.lane = F.tid & 63; F.wave = __builtin_amdgcn_readfirstlane(F.tid >> 6);
    F.G = gridDim.x; { const int bx = blockIdx.x; F.vcu = (F.G % 8 == 0) ? (bx % 8) * (F.G / 8) + bx / 8 : bx; }
    F.gw = F.vcu * 8 + F.wave; F.NGW = F.G * 8;
    F.ws = args.ws; F.out = args.out;
    volatile LAS unsigned* MISC = (volatile LAS unsigned*)(F.lds + MISC_OFF);
    if (F.tid < 64) MISC[F.tid] = 0u;
    __syncthreads();
    XcdBarrier bar = xcd_barrier_post((unsigned*)(F.ws + WS_CTL) + 4096, MISC + 8);
#ifndef PROBE_MASK
#define PROBE_MASK 0
#endif
#define RELANE() do { int t_ = threadIdx.x; asm volatile("" : "+v"(t_)); F.tid = t_; F.lane = t_ & 63; } while (0)
#define PH(k, ...) do { { RELANE(); __VA_ARGS__ } if (((PROBE_MASK) >> (k)) & 1) { xcd_barrier(bar); { RELANE(); __VA_ARGS__ } } if ((k) != NPH - 1) xcd_barrier(bar); } while (0)
    PH(0, p0_prologue(F);
        if (F.tid == 0) { unsigned sp = 0; unsigned* cnt = (unsigned*)(F.ws + WS_CTL) + 1024;
            while (__hip_atomic_load(cnt, __ATOMIC_RELAXED, __HIP_MEMORY_SCOPE_AGENT) < 96u) { __builtin_amdgcn_s_sleep(2); if (++sp > (1u << 22)) break; }
            __builtin_amdgcn_fence(__ATOMIC_ACQUIRE, "agent"); asm volatile("s_waitcnt vmcnt(0)" ::: "memory"); }
        __syncthreads();
        p1_h1(F););
    PH(1, const pg8::Gemm g{D, D, D}; pg8::StaticOrder S; S.init(NTOK, ZC, 1, F.G, (int)blockIdx.x, g, (const bf16_t*)(F.ws + WS_H), (const bf16_t*)(F.ws + WS_WIN), nullptr, nullptr);
        pg8::EpiBf16 E{(bf16_t*)(F.ws + WS_Z1), Z1C, (bf16_t*)(F.ws + WS_Z2), 12}; pg8::gemm_phase(F.lds, g, S, E, F.tid););
#ifndef PROBE_XBAR
#define PROBE_XBAR 0
#endif
    for (int xb_ = 0; xb_ < PROBE_XBAR; ++xb_) xcd_barrier(bar);
    PH(2, p3_prep(F););
#ifndef PROBE_P3
#define PROBE_P3 0
#endif
    if (PROBE_P3) { RELANE(); p3_prep<(PROBE_P3 ? PROBE_P3 : 7)>(F); xcd_barrier(bar); }
    PH(3, mlstm_passA(F, (int)blockIdx.x); __syncthreads(); { const int u = (int)blockIdx.x * 8 + F.wave; rwkv_pass1(F, u); });
#ifndef PROBE_P1
#define PROBE_P1 (-1)
#endif
    if (PROBE_P1 >= 0) { RELANE(); const int u = (int)blockIdx.x * 8 + F.wave; rwkv_pass1<(PROBE_P1 < 0 ? 0 : PROBE_P1)>(F, u); xcd_barrier(bar); }
    PH(4, const int bi = blockIdx.x;
        if (bi < 128) { const int u = bi >> 3; mlstm_prop_t<4, 16, 8>(F, 16 + (u >> 3), (u >> 2) & 1, u & 3, bi & 7); rwkv_prop_lat(F, (((bi & 7) * 4 + (bi >> 5)) << 2) | ((bi >> 3) & 3)); }
        else { const int v = bi - 128; mlstm_prop_t<32, 2, 2>(F, v >> 3, (v >> 2) & 1, v & 3, 0); rwkv_prop(F, 128 + v * 8 + F.wave); });
    PH(5, { mlstm_passC3(F, (int)blockIdx.x); rwkv_fix(F, (int)blockIdx.x * 8 + F.wave); });
    PH(6, const pg8::Gemm g{512, 512, 512}; pg8::StaticOrder S;
        S.init(NTOK, D, 2, F.G, (int)blockIdx.x, g, (const bf16_t*)(F.ws + WS_YRB), (const bf16_t*)(F.ws + WS_WBR), (const bf16_t*)(F.ws + WS_YMB), (const bf16_t*)(F.ws + WS_WBM));
        pg8::EpiGate E{(bf16_t*)(F.ws + WS_PRM), (const bf16_t*)(F.ws + WS_Z2), Z2_GR}; pg8::gemm_phase(F.lds, g, S, E, F.tid););
    PH(7, const pg8::Gemm g{D, D, D}; pg8::StaticOrder S;
        S.init(NTOK, D, 2, F.G, (int)blockIdx.x, g, (const bf16_t*)(F.ws + WS_PRM), (const bf16_t*)(F.ws + WS_WOUT), (const bf16_t*)(F.ws + WS_PRM) + (size_t)NTOK * D, (const bf16_t*)(F.ws + WS_WOUT));
        pg8::EpiBf16 E{(bf16_t*)(F.ws + WS_OUT1), D, (bf16_t*)(F.ws + WS_OUT1), 1 << 20}; pg8::gemm_phase(F.lds, g, S, E, F.tid););
    PH(8, p8_rows(F););
    PH(9, const pg8::Gemm g{D, D, D}; pg8::StaticOrder S; S.init(NTOK, UPC, 1, F.G, (int)blockIdx.x, g, (const bf16_t*)(F.ws + WS_H), (const bf16_t*)(F.ws + WS_WUP), nullptr, nullptr);
        pg8::EpiFfnUp E{(bf16_t*)(F.ws + WS_Z), (bf16_t*)(F.ws + WS_FIN), F.a->in[I_FCONV], F.a->in[I_FCB], (LAS float*)(F.lds + 131072)}; pg8::gemm_phase(F.lds, g, S, E, F.tid);
        if (blockIdx.x >= 192) { LAS float* scr = (LAS float*)(F.lds + F.wave * 8448);
            for (int it = ((int)blockIdx.x - 192) * 8 + F.wave; it < 44 * 32; it += 512) transpose_item(0, F.a->in[I_FDN], 2816, 1024, (bf16_t*)(F.ws + WS_WDN), 32, scr, it, F.lane); });
    PH(10, p10_ffn_conv(F););
    PH(11, const pg8::Gemm g{DFF / 2, DFF, DFF}; pg8::StaticOrder S;
        S.init(NTOK, D, 2, F.G, (int)blockIdx.x, g, (const bf16_t*)(F.ws + WS_FIN), (const bf16_t*)(F.ws + WS_WDN), (const bf16_t*)(F.ws + WS_FIN) + DFF / 2, (const bf16_t*)(F.ws + WS_WDN) + DFF / 2);
        pg8::EpiBf16 E{(bf16_t*)(F.ws + WS_Z), D, (bf16_t*)(F.ws + WS_Z), 1 << 20}; pg8::gemm_phase(F.lds, g, S, E, F.tid););
    PH(12, p12_final(F););
#undef PH
}

extern "C" void kernel_launch(void* const* d_in, const int* in_sizes, int n_in, void* d_out, int out_size, void* d_ws, size_t ws_size, hipStream_t stream) {
    if (n_in != 33 || (size_t)out_size != OUT_TOTAL || ws_size < WS_END) {
        fprintf(stderr, "kernel_launch: unexpected problem (n_in %d, out %d, ws %zu)\n", n_in, out_size, ws_size); return; }
    (void)hipFuncSetAttribute((const void*)trunk_fwd, hipFuncAttributeMaxDynamicSharedMemorySize, LDS_BYTES);
    (void)hipMemsetAsync((char*)d_ws + WS_CTL, 0, CTL_ZERO_BYTES, stream);
    Args a{};
    for (int i = 0; i < 33; ++i) a.in[i] = (const float*)d_in[i];
    a.out = (float*)d_out; a.ws = (unsigned char*)d_ws;
    a.ph_lo = 0; a.ph_hi = NPH;
    hipLaunchKernelGGL(trunk_fwd, dim3(256), dim3(512), LDS_BYTES, stream, a);
}
```

```cpp
#include <hip/hip_runtime.h>
#include <cstdio>
#include <cstdint>

#define GAS __attribute__((address_space(1)))
#define LAS __attribute__((address_space(3)))
typedef unsigned short bf16_t;
typedef short bf16x8 __attribute__((ext_vector_type(8)));
typedef float f32x4 __attribute__((ext_vector_type(4)));
typedef float f32x2 __attribute__((ext_vector_type(2)));
typedef unsigned u32x4 __attribute__((ext_vector_type(4)));
typedef unsigned u32x2 __attribute__((ext_vector_type(2)));

#ifndef MK_ONE_LAUNCH
#define MK_ONE_LAUNCH 1
#endif

constexpr int D = 1024, NTOK = 8192, NCTX = 4096;
constexpr int ZC = 6144;
constexpr int DFF = 2816, UPC = 5632;
constexpr int NPH = 13;
constexpr int ZR_R = 0, ZR_K = 512, ZR_V = 1024, ZR_WD = 1536, ZR_AD = 1664, ZR_GD = 1792;
constexpr int Z1C = 3072, Z2C = 3072;
constexpr int ZM_Q = 1920, ZM_K = 2432, ZM_G = 2944;
constexpr int Z2_V = 0, Z2_O = 512, Z2_GR = 1024, Z2_GM = 2048;

constexpr size_t MiB = 1u << 20;
constexpr size_t WS_CTL = 0, CTL_ZERO_BYTES = 64 * 1024;
constexpr size_t WS_MOD = 1 * MiB;
constexpr size_t WS_LI = 1 * MiB + 256 * 1024;
constexpr size_t WS_LF = 1 * MiB + 512 * 1024;
constexpr size_t WS_BON = 1 * MiB + 768 * 1024;
constexpr size_t WS_WIN = 2 * MiB;
constexpr size_t WS_WBR = 14 * MiB;
constexpr size_t WS_WBM = 15 * MiB;
constexpr size_t WS_WOUT = 16 * MiB;
constexpr size_t WS_WUP = 18 * MiB;
constexpr size_t WS_WDN = 29 * MiB;
constexpr size_t WS_H = 35 * MiB;
constexpr size_t WS_Z = 51 * MiB;
constexpr size_t WS_Z1 = WS_Z, WS_Z2 = WS_Z + 48 * MiB;
constexpr size_t WS_P = 147 * MiB;
constexpr size_t WS_PR = WS_P, WS_PV = WS_P + 8 * MiB, WS_PKK = WS_P + 16 * MiB;
constexpr size_t WS_PW = WS_P + 24 * MiB, WS_PKD = WS_P + 40 * MiB, WS_PB = WS_P + 56 * MiB;
constexpr size_t WS_PG = WS_P + 72 * MiB;
constexpr size_t WS_YRB = WS_P, WS_YMB = WS_P + 16 * MiB;
constexpr size_t WS_FIN = WS_P;
constexpr size_t WS_MQ = 227 * MiB, WS_MK = 235 * MiB;
constexpr size_t WS_DCC = WS_Z1 + 32 * MiB;
constexpr size_t WS_DCL = WS_H;
constexpr size_t WS_PRM = WS_Z1;
constexpr size_t WS_OUT1 = WS_P;
constexpr size_t WS_X1B = WS_P + 64 * MiB;
constexpr size_t WS_SP = WS_Z1;
constexpr size_t WS_DN = 243 * MiB;
constexpr size_t WS_MS = 243 * MiB + 512 * 1024;
constexpr size_t WS_WUPT = 243 * MiB + 576 * 1024, WS_AUPT = WS_WUPT + 131072, WS_GUPT = WS_WUPT + 262144;
constexpr size_t WS_END = 244 * MiB;
constexpr size_t OUT_YP = 0, OUT_SR = 8388608, OUT_SC = OUT_SR + 1048576, OUT_SN = OUT_SC + 2097152, OUT_SM = OUT_SN + 16384, OUT_TOTAL = OUT_SM + 128;

constexpr int LDS_BYTES = 163840;
constexpr int MISC_OFF = LDS_BYTES - 256;

#define LDS_WAIT() asm volatile("s_waitcnt lgkmcnt(0)" ::: "memory")
#define VM_WAIT() asm volatile("s_waitcnt vmcnt(0)" ::: "memory")

__device__ __forceinline__ float bf2f(unsigned v) { return __builtin_bit_cast(float, v << 16); }
__device__ __forceinline__ unsigned f2bf(float f) { unsigned u = __builtin_bit_cast(unsigned, f); return (u + 0x7fffu + ((u >> 16) & 1u)) >> 16; }
typedef __bf16 bf16v2_t __attribute__((ext_vector_type(2)));
__device__ __forceinline__ unsigned cvt_pk(float lo, float hi) { const f32x2 v = {lo, hi}; return __builtin_bit_cast(unsigned, __builtin_convertvector(v, bf16v2_t)); }
__device__ __forceinline__ unsigned pk2(float lo, float hi) { return cvt_pk(lo, hi); }
__device__ __forceinline__ void st16_wt(void* p, const u32x4 v) { asm volatile("global_store_dwordx4 %0, %1, off sc1\n\ts_nop 1" :: "v"(p), "v"(v) : "memory"); }
__device__ __forceinline__ float sigm(float x) { return 1.f / (1.f + __expf(-x)); }
__device__ __forceinline__ float silu(float x) { return x / (1.f + __expf(-x)); }
__device__ __forceinline__ float wave_sum(float v) {
#pragma unroll
    for (int o = 1; o < 64; o <<= 1) v += __shfl_xor(v, o);
    return v;
}
__device__ __forceinline__ void unpack8(const u32x4 w, float (&f)[8]) {
    f[0] = bf2f(w.x & 0xffffu); f[1] = bf2f(w.x >> 16); f[2] = bf2f(w.y & 0xffffu); f[3] = bf2f(w.y >> 16);
    f[4] = bf2f(w.z & 0xffffu); f[5] = bf2f(w.z >> 16); f[6] = bf2f(w.w & 0xffffu); f[7] = bf2f(w.w >> 16);
}
__device__ __forceinline__ u32x4 pack8(const float (&f)[8]) { u32x4 w; w.x = pk2(f[0], f[1]); w.y = pk2(f[2], f[3]); w.z = pk2(f[4], f[5]); w.w = pk2(f[6], f[7]); return w; }

#define XB_TMO      128
#define XB_XCNT(j)  (256  + 64 * (j))
#define XB_XSUB(j)  (1280 + 64 * (j))
#define XB_XGEN(j)  (2304 + 64 * (j))
#define XB_TOP      3328
#define XB_TOPGEN   3392
#define XCD_BAR_WORDS 3456
#define XB_SPIN_CAP (1u << 22)
__device__ __forceinline__ unsigned xb_ld(unsigned* p)              { return __hip_atomic_load(p, __ATOMIC_RELAXED, __HIP_MEMORY_SCOPE_AGENT); }
__device__ __forceinline__ unsigned xb_add(unsigned* p, unsigned v) { return __hip_atomic_fetch_add(p, v, __ATOMIC_RELAXED, __HIP_MEMORY_SCOPE_AGENT); }
__device__ __forceinline__ unsigned xb_xcc_id() { return (unsigned)__builtin_amdgcn_s_getreg((3 << 11) | 20) & 0xFu; }
#define XB_SPIN(cond, bar) do { unsigned _sp = 0; while (cond) { __builtin_amdgcn_s_sleep(1); \
    if ((++_sp & 255u) == 0u) { if (xb_ld(&(bar)[XB_TMO])) break; if (_sp > XB_SPIN_CAP) { atomicAdd(&(bar)[XB_TMO], 1u); break; } } } } while (0)
struct XcdBarrier { unsigned* bar; unsigned x; volatile LAS unsigned* st; };
__device__ __forceinline__ XcdBarrier xcd_barrier_post(unsigned* bar, volatile LAS unsigned* st) {
    XcdBarrier b; b.bar = bar; b.x = xb_xcc_id(); b.st = st;
    if (threadIdx.x == 0) (void)xb_add(&bar[XB_XCNT(b.x)], 1u);
    return b;
}
__device__ __forceinline__ void xcd_barrier_complete(unsigned* bar, unsigned x, unsigned& nloc, unsigned& nx) {
    const unsigned G = gridDim.x * gridDim.y * gridDim.z;
    unsigned sum, cnt, mine, sp = 0u;
    for (;;) {
        sum = 0u; cnt = 0u; mine = 0u;
#pragma unroll
        for (unsigned j = 0; j < 16; ++j) { const unsigned c = xb_ld(&bar[XB_XCNT(j)]); sum += c; cnt += (c > 0u) ? 1u : 0u; mine = (j == x) ? c : mine; }
        if (sum == G) break;
        __builtin_amdgcn_s_sleep(1);
        if ((++sp & 255u) == 0u) { if (xb_ld(&bar[XB_TMO])) break; if (sp > XB_SPIN_CAP) { atomicAdd(&bar[XB_TMO], 1u); break; } }
    }
    nloc = mine > 0u ? mine : 1u; nx = cnt > 0u ? cnt : 1u;
}
__device__ __forceinline__ void xcd_barrier(const XcdBarrier& b) {
    asm volatile("s_waitcnt vmcnt(0)" ::: "memory");
    __syncthreads();
    if (threadIdx.x == 0) {
        unsigned* bar = b.bar;
        __builtin_amdgcn_s_waitcnt(0);
        unsigned nloc = b.st[0], nx = b.st[1];
        if (nloc == 0u) { xcd_barrier_complete(bar, b.x, nloc, nx); b.st[0] = nloc; b.st[1] = nx; }
        const unsigned old = xb_add(&bar[XB_XSUB(b.x)], 1u);
        const unsigned gen = old / nloc;
        if (old + 1u == (gen + 1u) * nloc) {
            __builtin_amdgcn_fence(__ATOMIC_RELEASE, "agent");
            asm volatile("s_waitcnt vmcnt(0)" ::: "memory");
            const unsigned og = xb_add(&bar[XB_TOP], 1u);
            const unsigned tg = og / nx;
            if (og + 1u == (tg + 1u) * nx) {
#pragma unroll
                for (unsigned j = 0; j < 16; ++j) (void)__hip_atomic_fetch_add(&bar[XB_XGEN(j)], 1u, __ATOMIC_RELAXED, __HIP_MEMORY_SCOPE_AGENT);
            } else XB_SPIN(xb_ld(&bar[XB_XGEN(b.x)]) == gen, bar);
            __builtin_amdgcn_fence(__ATOMIC_ACQUIRE, "agent");
            asm volatile("s_waitcnt vmcnt(0)" ::: "memory");
        } else {
            XB_SPIN(xb_ld(&bar[XB_XGEN(b.x)]) == gen, bar);
            __builtin_amdgcn_fence(__ATOMIC_ACQUIRE, "agent");
            asm volatile("s_waitcnt vmcnt(0)" ::: "memory");
        }
    }
    __syncthreads();
}

__device__ __forceinline__ float dpp_ror1(float v) { return __builtin_bit_cast(float, __builtin_amdgcn_update_dpp(0, __builtin_bit_cast(int, v), 0x121, 0xF, 0xF, false)); }
__device__ __forceinline__ float dpp_rol1(float v) { return __builtin_bit_cast(float, __builtin_amdgcn_update_dpp(0, __builtin_bit_cast(int, v), 0x12F, 0xF, 0xF, false)); }
namespace pg8 {
constexpr int BM = 256, BK = 64, HALF = 128, HTB = HALF * BK * 2, STAGE_BYTES = 8 * HTB, NXCD = 8, WGM = 4;
__host__ __device__ __forceinline__ int lds_byte(int r, int c) { const int st = (r >> 4) * 2 + (c >> 5), rr = r & 15, cc = c & 31, ob = rr * 64 + cc * 2; return st * 1024 + (ob ^ (((ob >> 9) & 1) << 5)); }
__host__ __device__ __forceinline__ void stage_rc(int b, int& R, int& C) { const int st = b / 1024, sb = b % 1024, swz = sb ^ (((sb >> 9) & 1) << 5); R = (st >> 1) * 16 + swz / 64; C = (st & 1) * 32 + (swz % 64) / 2; }
__host__ __device__ __forceinline__ int perm32(int rho) { const int n = rho >> 4, i = rho & 15; return 8 * (i >> 2) + 4 * n + (i & 3); }
struct Unit { const char* a; const char* b; int pm, pn, z; };
struct Gemm { int K, lda, ldb; };
struct StaticOrder {
    int nM, nN, nZ, nwg, G, c, lda, ldb; const bf16_t* Az[2]; const bf16_t* Bz[2];
    __device__ void init(int M, int N, int nZ_, int G_, int c_, const Gemm& g, const bf16_t* A0, const bf16_t* B0, const bf16_t* A1, const bf16_t* B1) {
        nM = M / BM; nZ = nZ_; nN = (N / BM) * nZ_; nwg = nM * nN; G = G_; c = c_; lda = g.lda; ldb = g.ldb; Az[0] = A0; Az[1] = A1; Bz[0] = B0; Bz[1] = B1; }
    __device__ bool next(int i, Unit& u) const {
        const long L = (long)i * G + c; if (L >= nwg) return false;
        int wgid = (int)L; { const int q = nwg / NXCD, r = nwg % NXCD, xcd = wgid % NXCD, off = wgid / NXCD; wgid = (xcd < r ? xcd * (q + 1) : r * (q + 1) + (xcd - r) * q) + off; }
        const int nig = WGM * nN, gid = wgid / nig, fm = gid * WGM, gsz = (nM - fm) < WGM ? (nM - fm) : WGM;
        u.pm = fm + ((wgid % nig) % gsz); const int pnz = (wgid % nig) / gsz; u.pn = pnz / nZ; u.z = pnz - u.pn * nZ;
        u.a = (const char*)(u.z ? Az[1] : Az[0]) + (size_t)u.pm * BM * lda * 2; u.b = (const char*)(u.z ? Bz[1] : Bz[0]) + (size_t)u.pn * BM * ldb * 2; return true;
    }
};

struct EpiBf16 {
    static constexpr bool PERM = true;
    bf16_t* O; int ldc; bf16_t* O2; int split_pn;
    __device__ __forceinline__ void operator()(const f32x4 (&acc)[2][2][4][2], const Unit& u, int wr, int wc, int fr, int fq) const {
        const bool hi = u.pn >= split_pn; bf16_t* Ob = (hi ? O2 : O) + (size_t)u.z * NTOK * ldc;
        const int row0 = u.pm * BM + wr * 64 + fr, col0 = (hi ? u.pn - split_pn : u.pn) * BM + wc * 32 + 8 * fq;
#pragma unroll
        for (int ai = 0; ai < 2; ++ai)
#pragma unroll
            for (int m = 0; m < 4; ++m) { bf16_t* rowp = Ob + (size_t)(row0 + ai * HALF + m * 16) * ldc + col0;
#pragma unroll
                for (int bj = 0; bj < 2; ++bj) { const f32x4 v0 = acc[ai][bj][m][0], v1 = acc[ai][bj][m][1];
                    u32x4 w; w.x = pk2(v0[0], v0[1]); w.y = pk2(v0[2], v0[3]); w.z = pk2(v1[0], v1[1]); w.w = pk2(v1[2], v1[3]);
                    st16_wt(rowp + bj * HALF, w); } }
    }
};
struct EpiGate {
    static constexpr bool PERM = true;
    bf16_t* O; const bf16_t* Z; int gcol0;
    __device__ __forceinline__ void operator()(const f32x4 (&acc)[2][2][4][2], const Unit& u, int wr, int wc, int fr, int fq) const {
        const int row0 = u.pm * BM + wr * 64 + fr, col0 = u.pn * BM + wc * 32 + 8 * fq;
        bf16_t* Ob = O + (size_t)u.z * NTOK * D; const int gc = gcol0 + u.z * D;
#pragma unroll
        for (int ai = 0; ai < 2; ++ai)
#pragma unroll
            for (int m = 0; m < 4; ++m) { const int row = row0 + ai * HALF + m * 16; bf16_t* rowp = Ob + (size_t)row * D + col0; const bf16_t* gp = Z + (size_t)row * Z2C + gc + col0;
#pragma unroll
                for (int bj = 0; bj < 2; ++bj) { const f32x4 v0 = acc[ai][bj][m][0], v1 = acc[ai][bj][m][1];
                    float g[8]; unpack8(*(const u32x4*)(gp + bj * HALF), g);
                    u32x4 w; w.x = cvt_pk(v0[0] * sigm(g[0]), v0[1] * sigm(g[1])); w.y = cvt_pk(v0[2] * sigm(g[2]), v0[3] * sigm(g[3]));
                    w.z = cvt_pk(v1[0] * sigm(g[4]), v1[1] * sigm(g[5])); w.w = cvt_pk(v1[2] * sigm(g[6]), v1[3] * sigm(g[7]));
                    *(u32x4*)(rowp + bj * HALF) = w; } }
    }
};
struct EpiFfnUp {
    static constexpr bool PERM = true;
    bf16_t* U; bf16_t* FIN; const float* cw; const float* cb; LAS float* xch;
    __device__ __forceinline__ void operator()(const f32x4 (&acc)[2][2][4][2], const Unit& u, int wr, int wc, int fr, int fq) const {
        if (u.pm >= NCTX / BM) {
            const int row0 = u.pm * BM + wr * 64 + fr, col0 = u.pn * BM + wc * 32 + 8 * fq;
#pragma unroll
            for (int ai = 0; ai < 2; ++ai)
#pragma unroll
                for (int m = 0; m < 4; ++m) { bf16_t* rowp = U + (size_t)(row0 + ai * HALF + m * 16) * UPC + col0;
#pragma unroll
                    for (int bj = 0; bj < 2; ++bj) { const f32x4 v0 = acc[ai][bj][m][0], v1 = acc[ai][bj][m][1];
                        u32x4 w; w.x = pk2(v0[0], v0[1]); w.y = pk2(v0[2], v0[3]); w.z = pk2(v1[0], v1[1]); w.w = pk2(v1[2], v1[3]);
                        st16_wt(rowp + bj * HALF, w); } }
            return;
        }
        const int cl = wc * 32 + 8 * fq, ch = u.pn * 128 + cl;
#pragma unroll
        for (int ai = 0; ai < 2; ++ai) { const int band = 2 * ai + wr;
            if (fr == 0) { *(LAS f32x4*)(xch + (band * 2 + 0) * 128 + cl) = acc[ai][0][0][0]; *(LAS f32x4*)(xch + (band * 2 + 0) * 128 + cl + 4) = acc[ai][0][0][1]; }
            if (fr == 15) { *(LAS f32x4*)(xch + (band * 2 + 1) * 128 + cl) = acc[ai][0][3][0]; *(LAS f32x4*)(xch + (band * 2 + 1) * 128 + cl + 4) = acc[ai][0][3][1]; } }
        asm volatile("s_waitcnt lgkmcnt(0)" ::: "memory");
        __builtin_amdgcn_s_barrier();
        asm volatile("" ::: "memory"); __builtin_amdgcn_sched_barrier(0);
        float w0[8], w1[8], w2[8], bb[8];
        { const f32x4 a0 = *(const f32x4*)(cw + 3 * DFF + ch), a1 = *(const f32x4*)(cw + 3 * DFF + ch + 4), b0 = *(const f32x4*)(cw + 4 * DFF + ch), b1 = *(const f32x4*)(cw + 4 * DFF + ch + 4);
            const f32x4 c0 = *(const f32x4*)(cw + 5 * DFF + ch), c1 = *(const f32x4*)(cw + 5 * DFF + ch + 4), d0 = *(const f32x4*)(cb + ch), d1 = *(const f32x4*)(cb + ch + 4);
#pragma unroll
            for (int e = 0; e < 4; ++e) { w0[e] = a0[e]; w0[4 + e] = a1[e]; w1[e] = b0[e]; w1[4 + e] = b1[e]; w2[e] = c0[e]; w2[4 + e] = c1[e]; bb[e] = d0[e]; bb[4 + e] = d1[e]; } }
        const int row0 = u.pm * BM + wr * 64 + fr;
#pragma unroll
        for (int ai = 0; ai < 2; ++ai) { const int band = 2 * ai + wr;
            f32x4 ht[2], hb[2];
#pragma unroll
            for (int n = 0; n < 2; ++n) { ht[n] = band > 0 ? *(const LAS f32x4*)(xch + ((band - 1) * 2 + 1) * 128 + cl + 4 * n) : (f32x4){0.f, 0.f, 0.f, 0.f};
                hb[n] = band < 3 ? *(const LAS f32x4*)(xch + ((band + 1) * 2 + 0) * 128 + cl + 4 * n) : (f32x4){0.f, 0.f, 0.f, 0.f}; }
#pragma unroll
            for (int m = 0; m < 4; ++m) { unsigned pk[4];
#pragma unroll
                for (int n = 0; n < 2; ++n) { float o[4];
#pragma unroll
                    for (int e = 0; e < 4; ++e) { const float cur = acc[ai][0][m][n][e];
                        const float rp = dpp_ror1(acc[ai][0][m > 0 ? m - 1 : 0][n][e]), rn = dpp_rol1(acc[ai][0][m < 3 ? m + 1 : 3][n][e]), rc = dpp_ror1(cur), lc = dpp_rol1(cur);
                        const float pt = m > 0 ? rp : ht[n][e], nt_ = m < 3 ? rn : hb[n][e];
                        const float prev = fr > 0 ? rc : pt, next = fr < 15 ? lc : nt_;
                        const float v = bb[4 * n + e] + w0[4 * n + e] * prev + w1[4 * n + e] * cur + w2[4 * n + e] * next;
                        o[e] = silu(v) * acc[ai][1][m][n][e]; }
                    pk[2 * n] = pk2(o[0], o[1]); pk[2 * n + 1] = pk2(o[2], o[3]); }
                u32x4 w; w.x = pk[0]; w.y = pk[1]; w.z = pk[2]; w.w = pk[3];
                st16_wt(FIN + (size_t)(row0 + ai * HALF + m * 16) * DFF + ch, w); } }
    }
};
template <class Epi>
__device__ __forceinline__ void gemm_phase(LAS unsigned char* lds, const Gemm g, const StaticOrder& S, const Epi& E, const int tid) {
    const int wid = __builtin_amdgcn_readfirstlane(tid >> 6), lane = tid & 63, wr = wid >> 2, wc = wid & 3, fr = lane & 15, fq = lane >> 4;
    const int nt = g.K / BK;
    unsigned voffA[2], voffB[2];
#pragma unroll
    for (int i = 0; i < 2; ++i) { int R, C; stage_rc(tid * 16 + i * 8192, R, C); const int Rb = Epi::PERM ? ((R & ~31) + perm32(R & 31)) : R;
        voffA[i] = (unsigned)(R * g.lda + C) * 2u; voffB[i] = (unsigned)(Rb * g.ldb + C) * 2u; }
    const size_t kstep = (size_t)(BK * 2);
    const size_t hstepA = (size_t)HALF * g.lda * 2, hstepB = (size_t)HALF * g.ldb * 2;
    const unsigned ldsw = (unsigned)wid * 1024u;
    const int aoff = lds_byte(wr * 64 + fr, fq * 8), boff = lds_byte(wc * 32 + fr, fq * 8);
#define PG8_SA(b, h) (((b) * 2 + (h)) * HTB)
#define PG8_SB(b, h) ((4 + (b) * 2 + (h)) * HTB)
#define PG8_STAGE(bufoff, gbase, voff) do { _Pragma("unroll") for (int _i = 0; _i < 2; ++_i) \
        __builtin_amdgcn_global_load_lds((const unsigned*)((const char*)(gbase) + (voff)[_i]), (LAS unsigned*)(lds + (bufoff) + ldsw + _i * 8192), 16, 0, 0); } while (0)
#define PG8_LDA(dst, b, h) do { _Pragma("unroll") for (int m = 0; m < 4; ++m) _Pragma("unroll") for (int k = 0; k < 2; ++k) dst[m][k] = *(const LAS bf16x8*)(lds + PG8_SA(b, h) + aoff + m * 2048 + k * 1024); } while (0)
#define PG8_LDB(dst, b, h) do { _Pragma("unroll") for (int n = 0; n < 2; ++n) _Pragma("unroll") for (int k = 0; k < 2; ++k) dst[n][k] = *(const LAS bf16x8*)(lds + PG8_SB(b, h) + boff + n * 2048 + k * 1024); } while (0)
#define PG8_MMA(ai, bj, At, Bt) do { __builtin_amdgcn_s_setprio(1); _Pragma("unroll") for (int m = 0; m < 4; ++m) _Pragma("unroll") for (int n = 0; n < 2; ++n) _Pragma("unroll") for (int k = 0; k < 2; ++k) \
        acc[ai][bj][m][n] = __builtin_amdgcn_mfma_f32_16x16x32_bf16(Bt[n][k], At[m][k], acc[ai][bj][m][n], 0, 0, 0); __builtin_amdgcn_s_setprio(0); } while (0)
#define PG8_WAIT_V(n) asm volatile("s_waitcnt vmcnt(" #n ")" ::: "memory")
#define PG8_WAIT_L(n) asm volatile("s_waitcnt lgkmcnt(" #n ")" ::: "memory")
#define PG8_BAR __builtin_amdgcn_s_barrier()
#define PG8_SCHED __builtin_amdgcn_sched_barrier(0)
    Unit cur, nxt; int ui = 0;
    if (!S.next(0, cur)) return;
    f32x4 acc[2][2][4][2];
#pragma unroll
    for (int a = 0; a < 2; ++a)
#pragma unroll
        for (int b = 0; b < 2; ++b)
#pragma unroll
            for (int m = 0; m < 4; ++m)
#pragma unroll
                for (int n = 0; n < 2; ++n) acc[a][b][m][n] = (f32x4){0.f, 0.f, 0.f, 0.f};
    bf16x8 At[4][2], B0[2][2], B1[2][2];
    const char* cA = cur.a; const char* cB = cur.b;
    PG8_STAGE(PG8_SB(0, 0), cB, voffB); PG8_STAGE(PG8_SB(0, 1), cB + hstepB, voffB); PG8_STAGE(PG8_SA(0, 0), cA, voffA); PG8_STAGE(PG8_SA(0, 1), cA + hstepA, voffA);
    if (wr == 1) PG8_BAR;
    PG8_WAIT_V(2); PG8_BAR;
    PG8_STAGE(PG8_SB(1, 0), cB + kstep, voffB); PG8_STAGE(PG8_SA(1, 0), cA + kstep, voffA); PG8_STAGE(PG8_SB(1, 1), cB + hstepB + kstep, voffB);
    PG8_WAIT_V(6); PG8_BAR;
    for (;;) {
        const bool has_next = S.next(ui + 1, nxt);
        const char* nA = has_next ? nxt.a : cA; const char* nB = has_next ? nxt.b : cB;
        for (int t = 0; t < nt; t += 2) {
            const bool last = (t == nt - 2);
            const char* a1 = cA + (size_t)(t + 1) * kstep;
            const char* a2 = last ? nA : cA + (size_t)(t + 2) * kstep; const char* b2 = last ? nB : cB + (size_t)(t + 2) * kstep;
            const char* a3 = a2 + kstep; const char* b3 = b2 + kstep;
            PG8_LDB(B0, 0, 0); PG8_LDB(B1, 0, 1); PG8_SCHED; PG8_LDA(At, 0, 0); PG8_STAGE(PG8_SA(1, 1), a1 + hstepA, voffA);
            PG8_WAIT_V(8); PG8_WAIT_L(0); PG8_BAR; PG8_MMA(0, 0, At, B0); PG8_MMA(0, 1, At, B1); PG8_BAR; PG8_SCHED;
            PG8_LDA(At, 0, 1); PG8_STAGE(PG8_SB(0, 0), b2, voffB); PG8_STAGE(PG8_SB(0, 1), b2 + hstepB, voffB); PG8_STAGE(PG8_SA(0, 0), a2, voffA);
            PG8_WAIT_V(8); PG8_WAIT_L(0); PG8_BAR; PG8_MMA(1, 0, At, B0); PG8_MMA(1, 1, At, B1); PG8_BAR; PG8_SCHED;
            PG8_LDB(B0, 1, 0); PG8_LDB(B1, 1, 1); PG8_SCHED; PG8_LDA(At, 1, 0); PG8_STAGE(PG8_SA(0, 1), a2 + hstepA, voffA);
            PG8_WAIT_V(8); PG8_WAIT_L(0); PG8_BAR; PG8_MMA(0, 0, At, B0); PG8_MMA(0, 1, At, B1); PG8_BAR; PG8_SCHED;
            PG8_LDA(At, 1, 1); PG8_STAGE(PG8_SB(1, 0), b3, voffB); PG8_STAGE(PG8_SB(1, 1), b3 + hstepB, voffB); PG8_STAGE(PG8_SA(1, 0), a3, voffA);
            PG8_WAIT_V(8); PG8_WAIT_L(0); PG8_BAR; PG8_MMA(1, 0, At, B0); PG8_MMA(1, 1, At, B1); PG8_BAR; PG8_SCHED;
        }
        if (wr == 0) PG8_BAR;
        E(acc, cur, wr, wc, fr, fq);
        if (!has_next) break;
#pragma unroll
        for (int a = 0; a < 2; ++a)
#pragma unroll
            for (int b = 0; b < 2; ++b)
#pragma unroll
                for (int m = 0; m < 4; ++m)
#pragma unroll
                    for (int n = 0; n < 2; ++n) acc[a][b][m][n] = (f32x4){0.f, 0.f, 0.f, 0.f};
        cur = nxt; cA = nA; cB = nB; ++ui;
        if (wr == 1) PG8_BAR;
    }
    PG8_WAIT_V(0);
    PG8_BAR;
#undef PG8_SA
#undef PG8_SB
#undef PG8_STAGE
#undef PG8_LDA
#undef PG8_LDB
#undef PG8_MMA
#undef PG8_WAIT_V
#undef PG8_WAIT_L
#undef PG8_BAR
#undef PG8_SCHED
}
}

struct Args { const float* in[33]; float* out; unsigned char* ws; int ph_lo, ph_hi; };
enum { I_XP = 0, I_XS, I_C, I_SR, I_SC, I_SN, I_SM, I_CCTX, I_ADAW, I_ADAB, I_NORMG, I_WIN, I_MU, I_W0, I_WUP, I_A0, I_AUP, I_GUP, I_KKS, I_KA, I_RK, I_LNG, I_LNB,
       I_MCONV, I_MGB, I_MGNG, I_WBR, I_WBM, I_WOUT, I_FUP, I_FCONV, I_FCB, I_FDN };

struct Frame {
    LAS unsigned char* lds; const Args* a;
    int tid, lane, wave, G, vcu, gw, NGW;
    unsigned char* ws; float* out;
};
__device__ __forceinline__ const float* xrow_ptr(const Args& a, int tok) { return tok < NCTX ? a.in[I_XP] + (size_t)tok * D : a.in[I_XS] + (size_t)(tok - NCTX) * D; }
__device__ __forceinline__ int cond_of(int tok) { return tok < NCTX ? 0 : 1 + ((tok - NCTX) >> 11); }
__device__ __forceinline__ int seq_base(int s) { return s < 16 ? s * 256 : NCTX + (s - 16) * 2048; }
__device__ __forceinline__ int seq_len(int s) { return s < 16 ? 256 : 2048; }

__device__ __forceinline__ int win_col(int n) { return n < 2944 ? n : (n < 2960 ? n + 1024 : (n < 3072 ? 1 << 20 : (n < 4096 ? n - 128 : n - 112))); }
__device__ __forceinline__ int fup_col(int n) { const int t = n >> 8, j = n & 255; return j < 128 ? 128 * t + j : DFF + 128 * t + (j - 128); }
__device__ __forceinline__ void transpose_item(const int REMAP, const float* W, int K, int N, bf16_t* WT, int nblk, LAS float* scr, int item, int lane) {
    const int kb = item / nblk, nb = item % nblk, k0 = 64 * kb, n0 = 32 * nb;
    const int nn = REMAP == 1 ? win_col(n0 + (lane & 31)) : (REMAP == 2 ? fup_col(n0 + (lane & 31)) : n0 + (lane & 31));
#pragma unroll
    for (int i = 0; i < 32; ++i) { const int kk = 2 * i + (lane >> 5); scr[kk * 33 + (lane & 31)] = (nn < N) ? W[(size_t)(k0 + kk) * N + nn] : 0.f; }
    LDS_WAIT(); asm volatile("" ::: "memory");
    const int c = lane & 7;
#pragma unroll
    for (int j = 0; j < 4; ++j) { const int n = (lane >> 3) + 8 * j; const LAS float* s = scr + (8 * c) * 33 + n;
        u32x4 o; o.x = pk2(s[0 * 33], s[1 * 33]); o.y = pk2(s[2 * 33], s[3 * 33]); o.z = pk2(s[4 * 33], s[5 * 33]); o.w = pk2(s[6 * 33], s[7 * 33]);
        *(u32x4*)(WT + (size_t)(n0 + n) * K + k0 + 8 * c) = o; }
    LDS_WAIT(); asm volatile("" ::: "memory");
}
__device__ __forceinline__ void p0_prologue(Frame& F) {
    const Args& a = *F.a;
    if (blockIdx.x < 96) {
        LAS float* sc = (LAS float*)(F.lds + 69632);
        LAS float* part = (LAS float*)(F.lds + 69632 + 12288);
        for (int i = F.tid; i < 3072; i += 512) { const int ci = i >> 10, k = i & 1023; const float cv = ci == 0 ? a.in[I_CCTX][k] : a.in[I_C][(ci - 1) * D + k]; sc[i] = silu(cv); }
        __syncthreads();
        const int col = blockIdx.x * 64 + F.lane; float a0 = 0.f, a1 = 0.f, a2 = 0.f;
        const float* aw = a.in[I_ADAW];
#pragma unroll 64
        for (int k = F.wave * 128; k < F.wave * 128 + 128; ++k) { const float w = aw[(size_t)k * 6144 + col]; a0 += sc[k] * w; a1 += sc[1024 + k] * w; a2 += sc[2048 + k] * w; }
        part[(F.wave * 3 + 0) * 64 + F.lane] = a0; part[(F.wave * 3 + 1) * 64 + F.lane] = a1; part[(F.wave * 3 + 2) * 64 + F.lane] = a2;
        __syncthreads();
        if (F.tid < 192) { const int ci = F.tid >> 6, l = F.tid & 63; float s = a.in[I_ADAB][blockIdx.x * 64 + l];
#pragma unroll
            for (int w = 0; w < 8; ++w) s += part[(w * 3 + ci) * 64 + l];
            ((float*)(F.ws + WS_MOD))[ci * 6144 + blockIdx.x * 64 + l] = s; }
        asm volatile("s_waitcnt vmcnt(0)" ::: "memory");
        __syncthreads();
        if (F.tid == 0) { __builtin_amdgcn_fence(__ATOMIC_RELEASE, "agent"); asm volatile("s_waitcnt vmcnt(0)" ::: "memory");
            (void)__hip_atomic_fetch_add((unsigned*)(F.ws + WS_CTL) + 1024, 1u, __ATOMIC_RELAXED, __HIP_MEMORY_SCOPE_AGENT); }
    }
    LAS float* scr = (LAS float*)(F.lds + F.wave * 8448);
    constexpr int I_1 = 16 * 192, I_2 = 8 * 32, I_3 = 8 * 32, I_4 = 16 * 32, I_5 = 16 * 176, I_6 = 44 * 32;
    constexpr int I_7 = 96;
    constexpr int NITEMS = I_1 + I_2 + I_3 + I_4 + I_5 + I_7;
    const bool adab = blockIdx.x < 96; const int nw = ((int)blockIdx.x - 96) * 8 + F.wave;
    for (int rd = 0; rd < (adab ? 3 : 5); ++rd) {
        const int it = rd < 3 ? rd * 2048 + F.gw : 6144 + (rd - 3) * 1280 + nw; if (it >= NITEMS) break;
        int r = it; const float* W; bf16_t* WT; int K, N, nblk; int remap = 0;
        if (r < I_1) { W = a.in[I_WIN]; K = 1024; N = 6032; WT = (bf16_t*)(F.ws + WS_WIN); nblk = 192; remap = 1; }
        else if ((r -= I_1) < I_2) { W = a.in[I_WBR]; K = 512; N = 1024; WT = (bf16_t*)(F.ws + WS_WBR); nblk = 32; }
        else if ((r -= I_2) < I_3) { W = a.in[I_WBM]; K = 512; N = 1024; WT = (bf16_t*)(F.ws + WS_WBM); nblk = 32; }
        else if ((r -= I_3) < I_4) { W = a.in[I_WOUT]; K = 1024; N = 1024; WT = (bf16_t*)(F.ws + WS_WOUT); nblk = 32; }
        else if ((r -= I_4) < I_5) { W = a.in[I_FUP]; K = 1024; N = 5632; WT = (bf16_t*)(F.ws + WS_WUP); nblk = 176; remap = 2; }
        else if ((r -= I_5) < 32) { const int d = r >> 4; r &= 15; W = a.in[I_WUP] + d * 32768; K = 64; N = 512; WT = (bf16_t*)(F.ws + WS_WUPT) + d * 32768; nblk = 16; }
        else if ((r -= 32) < 32) { const int d = r >> 4; r &= 15; W = a.in[I_AUP] + d * 32768; K = 64; N = 512; WT = (bf16_t*)(F.ws + WS_AUPT) + d * 32768; nblk = 16; }
        else { r -= 32; W = a.in[I_GUP]; K = 128; N = 512; WT = (bf16_t*)(F.ws + WS_GUPT); nblk = 16; }
        transpose_item(remap, W, K, N, WT, nblk, scr, r, F.lane);
    }
}

__device__ __forceinline__ void p1_h1(Frame& F) {
    const Args& a = *F.a; const float* ng = a.in[I_NORMG];
    const bool adab = blockIdx.x < 96; const int nw = ((int)blockIdx.x - 96) * 8 + F.wave;
    for (int rd = 0; rd < (adab ? 3 : 5); ++rd) { const int row = rd < 3 ? rd * 2048 + F.gw : 6144 + (rd - 3) * 1280 + nw; if (row >= NTOK) break;
        const f32x4* xr = (const f32x4*)xrow_ptr(a, row) + F.lane; const float* mod = (const float*)(F.ws + WS_MOD) + cond_of(row) * 6144;
        f32x4 v[4]; float ss = 0.f;
#pragma unroll
        for (int j = 0; j < 4; ++j) { v[j] = xr[64 * j]; ss += (v[j].x * v[j].x + v[j].y * v[j].y) + (v[j].z * v[j].z + v[j].w * v[j].w); }
        const float rstd = rsqrtf(wave_sum(ss) * (1.f / D) + 1e-6f);
        u32x2* o = (u32x2*)((bf16_t*)(F.ws + WS_H) + (size_t)row * D) + F.lane;
#pragma unroll
        for (int j = 0; j < 4; ++j) { const int col = 4 * (64 * j + F.lane);
            const f32x4 g = *(const f32x4*)(ng + col), sh = *(const f32x4*)(mod + col), sc = *(const f32x4*)(mod + 1024 + col);
            const f32x4 h = v[j] * rstd * g * (sc + 1.f) + sh;
            u32x2 w; w.x = pk2(h.x, h.y); w.y = pk2(h.z, h.w); o[64 * j] = w; }
    }
}

constexpr int ZS_STRIDE = 3856;
__device__ __forceinline__ void ld4(const LAS unsigned char* p, float (&f)[4]) { const u32x2 w = *(const LAS u32x2*)p; f[0] = bf2f(w.x & 0xffffu); f[1] = bf2f(w.x >> 16); f[2] = bf2f(w.y & 0xffffu); f[3] = bf2f(w.y >> 16); }
__device__ __forceinline__ void st4(bf16_t* p, const float (&f)[4]) { u32x2 o; o.x = cvt_pk(f[0], f[1]); o.y = cvt_pk(f[2], f[3]); *(u32x2*)p = o; }
__device__ __forceinline__ void flush_rows(LAS unsigned char* stg, bf16_t* g  , const float (&v)[4][4], int fr, int fq, int lane) {
#pragma unroll
    for (int ct = 0; ct < 4; ++ct) { u32x2 o; o.x = cvt_pk(v[ct][0], v[ct][1]); o.y = cvt_pk(v[ct][2], v[ct][3]); *(LAS u32x2*)(stg + fr * 144 + ct * 32 + fq * 8) = o; }
    LDS_WAIT(); asm volatile("" ::: "memory");
#pragma unroll
    for (int i = 0; i < 2; ++i) { const int t = (lane >> 3) + 8 * i; *(u32x4*)(g + (size_t)t * 512 + (lane & 7) * 8) = *(const LAS u32x4*)(stg + t * 144 + (lane & 7) * 16); }
    LDS_WAIT(); asm volatile("" ::: "memory");
}
template <int SM = 7>
__device__ __forceinline__ void p3_prep(Frame& F) {
    const Args& a = *F.a;
    const bf16_t* Z = (const bf16_t*)(F.ws + WS_Z1);
    LAS unsigned char* L = F.lds;
    const int tid = F.tid, lane = F.lane, h = F.wave, fr = lane & 15, fq = lane >> 4;
    { const int unit = blockIdx.x;
        const int tok0 = unit * 32;
        const int s = tok0 < NCTX ? (tok0 >> 8) : 16 + ((tok0 - NCTX) >> 11);
        const int sb = seq_base(s), T = seq_len(s), t0 = tok0 - sb;
        __syncthreads();
        LAS float* prm = (LAS float*)(L + 32 * ZS_STRIDE);
        { prm[tid] = a.in[I_KKS][tid]; prm[512 + tid] = a.in[I_KA][tid]; prm[1024 + tid] = a.in[I_RK][tid]; prm[1536 + tid] = a.in[I_A0][tid]; prm[2048 + tid] = a.in[I_A0][512 + tid];
          prm[2560 + tid] = a.in[I_W0][tid]; prm[3072 + tid] = a.in[I_W0][512 + tid]; }
#pragma unroll 5
        for (int itk = 0; itk < ((SM & 1) ? 15 : 0); ++itk) { const int it = tid + 512 * itk;
            const int j = it / 240, g8 = (it - j * 240) * 8, t = t0 + j;
            const bf16_t* zp = Z + (size_t)(tok0 + j) * Z1C + g8;
            const float ml = t > 0 ? 0.5f : 0.f, mr = t < T - 1 ? 0.5f : 0.f;
            float zc[8], zl[8], zr[8], v[8];
            unpack8(*(const u32x4*)zp, zc); unpack8(*(const u32x4*)(zp - (t > 0 ? Z1C : 0)), zl); unpack8(*(const u32x4*)(zp + (t < T - 1 ? Z1C : 0)), zr);
            const f32x4 m0 = *(const f32x4*)(a.in[I_MU] + g8), m1 = *(const f32x4*)(a.in[I_MU] + g8 + 4);
#pragma unroll
            for (int i = 0; i < 8; ++i) { const float mu = i < 4 ? m0[i] : m1[i - 4]; v[i] = zc[i] + mu * ((ml * zl[i] + mr * zr[i]) - zc[i]); }
            if (g8 >= ZR_WD && g8 < ZR_AD) {
#pragma unroll
                for (int i = 0; i < 8; ++i) v[i] = tanhf(v[i]);
            } else if (g8 >= ZR_GD) {
#pragma unroll
                for (int i = 0; i < 8; ++i) v[i] = sigm(v[i]);
            }
            u32x4 o; o.x = cvt_pk(v[0], v[1]); o.y = cvt_pk(v[2], v[3]); o.z = cvt_pk(v[4], v[5]); o.w = cvt_pk(v[6], v[7]);
            *(LAS u32x4*)(L + j * ZS_STRIDE + g8 * 2) = o;
        }
        __syncthreads();
        if (SM & 2) {
            const bf16_t* WUPT = (const bf16_t*)(F.ws + WS_WUPT); const bf16_t* AUPT = (const bf16_t*)(F.ws + WS_AUPT); const bf16_t* GUPT = (const bf16_t*)(F.ws + WS_GUPT);
            const f32x4 Z4 = {0.f, 0.f, 0.f, 0.f};
            float kx[2][4][4], kk[2][4][4], rx[2][4][4], bon[2] = {0.f, 0.f};
            LAS unsigned char* stg = L + 32 * ZS_STRIDE + 14336 + h * 2304;
#define TILE(WS_, tt_) ((bf16_t*)(F.ws + (WS_)) + (size_t)(tok0 + 16 * (tt_)) * 512 + 64 * h)
#pragma unroll
            for (int tt = 0; tt < 2; ++tt) {
                const LAS unsigned char* zrow = L + (16 * tt + fr) * ZS_STRIDE; const size_t tok = (size_t)(tok0 + 16 * tt + fr);
                float ss = 0.f;
                float vx[4][4];
#pragma unroll
                for (int ct = 0; ct < 4; ++ct) { const int col = 64 * h + 16 * ct + 4 * fq;
                    ld4(zrow + (ZR_R + col) * 2, rx[tt][ct]); ld4(zrow + (ZR_K + col) * 2, kx[tt][ct]); ld4(zrow + (ZR_V + col) * 2, vx[ct]);
                    const f32x4 ks = *(const LAS f32x4*)(prm + col);
#pragma unroll
                    for (int j = 0; j < 4; ++j) { kk[tt][ct][j] = kx[tt][ct][j] * ks[j]; ss += kk[tt][ct][j] * kk[tt][ct][j]; }
                }
                flush_rows(stg, TILE(WS_PR, tt), rx[tt], fr, fq, lane); flush_rows(stg, TILE(WS_PV, tt), vx, fr, fq, lane);
                ss += __shfl_xor(ss, 16); ss += __shfl_xor(ss, 32);
                const float rn = 1.f / fmaxf(sqrtf(ss), 1e-12f);
#pragma unroll
                for (int ct = 0; ct < 4; ++ct) {
#pragma unroll
                    for (int j = 0; j < 4; ++j) kk[tt][ct][j] *= rn; }
                flush_rows(stg, TILE(WS_PKK, tt), kk[tt], fr, fq, lane);
            }
#pragma unroll
            for (int d = 0; d < 2; ++d) {
                asm volatile("" ::: "memory"); __builtin_amdgcn_sched_barrier(0);
                bf16x8 af[2][4];
#pragma unroll
                for (int ks = 0; ks < 2; ++ks)
#pragma unroll
                    for (int ct = 0; ct < 4; ++ct) af[ks][ct] = *(const bf16x8*)(AUPT + ((size_t)(d * 512 + 64 * h + 16 * ct + fr)) * 64 + 32 * ks + 8 * fq);
#pragma unroll
                for (int tt = 0; tt < 2; ++tt) { const LAS unsigned char* zrow = L + (16 * tt + fr) * ZS_STRIDE; const size_t tok = (size_t)(tok0 + 16 * tt + fr);
                    f32x4 acc[4] = {Z4, Z4, Z4, Z4};
#pragma unroll
                    for (int ks = 0; ks < 2; ++ks) { const bf16x8 bv = *(const LAS bf16x8*)(zrow + (ZR_AD + 64 * d + 32 * ks + 8 * fq) * 2);
#pragma unroll
                        for (int ct = 0; ct < 4; ++ct) acc[ct] = __builtin_amdgcn_mfma_f32_16x16x32_bf16(af[ks][ct], bv, acc[ct], 0, 0, 0); }
                    float kd[4][4], bv4[4][4];
#pragma unroll
                    for (int ct = 0; ct < 4; ++ct) { const int col = 64 * h + 16 * ct + 4 * fq;
                        const f32x4 a0 = *(const LAS f32x4*)(prm + 1536 + d * 512 + col), ka = *(const LAS f32x4*)(prm + 512 + col), rk = *(const LAS f32x4*)(prm + 1024 + col);
#pragma unroll
                        for (int j = 0; j < 4; ++j) { const float av = sigm(a0[j] + acc[ct][j]); kd[ct][j] = kx[tt][ct][j] * (1.f + (av - 1.f) * ka[j]); bv4[ct][j] = kk[tt][ct][j] * av; bon[tt] += rx[tt][ct][j] * kd[ct][j] * rk[j]; } }
                    flush_rows(stg, TILE(WS_PKD, tt) + (size_t)d * NTOK * 512, kd, fr, fq, lane); flush_rows(stg, TILE(WS_PB, tt) + (size_t)d * NTOK * 512, bv4, fr, fq, lane); (void)tok;
                }
            }
#pragma unroll
            for (int d = 0; d < 2; ++d) {
                asm volatile("" ::: "memory"); __builtin_amdgcn_sched_barrier(0);
                bf16x8 af[2][4];
#pragma unroll
                for (int ks = 0; ks < 2; ++ks)
#pragma unroll
                    for (int ct = 0; ct < 4; ++ct) af[ks][ct] = *(const bf16x8*)(WUPT + ((size_t)(d * 512 + 64 * h + 16 * ct + fr)) * 64 + 32 * ks + 8 * fq);
#pragma unroll
                for (int tt = 0; tt < 2; ++tt) { const LAS unsigned char* zrow = L + (16 * tt + fr) * ZS_STRIDE; const size_t tok = (size_t)(tok0 + 16 * tt + fr);
                    f32x4 acc[4] = {Z4, Z4, Z4, Z4};
#pragma unroll
                    for (int ks = 0; ks < 2; ++ks) { const bf16x8 bv = *(const LAS bf16x8*)(zrow + (ZR_WD + 64 * d + 32 * ks + 8 * fq) * 2);
#pragma unroll
                        for (int ct = 0; ct < 4; ++ct) acc[ct] = __builtin_amdgcn_mfma_f32_16x16x32_bf16(af[ks][ct], bv, acc[ct], 0, 0, 0); }
                    float dc[4][4];
#pragma unroll
                    for (int ct = 0; ct < 4; ++ct) { const int col = 64 * h + 16 * ct + 4 * fq; const f32x4 w0 = *(const LAS f32x4*)(prm + 2560 + d * 512 + col);
#pragma unroll
                        for (int j = 0; j < 4; ++j) dc[ct][j] = __expf(-0.606531f * sigm(w0[j] + acc[ct][j])); }
                    flush_rows(stg, TILE(WS_PW, tt) + (size_t)d * NTOK * 512, dc, fr, fq, lane); (void)tok;
                }
            }
            {
                asm volatile("" ::: "memory"); __builtin_amdgcn_sched_barrier(0);
                bf16x8 af[4][4];
#pragma unroll
                for (int ks = 0; ks < 4; ++ks)
#pragma unroll
                    for (int ct = 0; ct < 4; ++ct) af[ks][ct] = *(const bf16x8*)(GUPT + ((size_t)(64 * h + 16 * ct + fr)) * 128 + 32 * ks + 8 * fq);
#pragma unroll
                for (int tt = 0; tt < 2; ++tt) { const LAS unsigned char* zrow = L + (16 * tt + fr) * ZS_STRIDE; const size_t tok = (size_t)(tok0 + 16 * tt + fr);
                    f32x4 acc[4] = {Z4, Z4, Z4, Z4};
#pragma unroll
                    for (int ks = 0; ks < 4; ++ks) { const bf16x8 bv = *(const LAS bf16x8*)(zrow + (ZR_GD + 32 * ks + 8 * fq) * 2);
#pragma unroll
                        for (int ct = 0; ct < 4; ++ct) acc[ct] = __builtin_amdgcn_mfma_f32_16x16x32_bf16(af[ks][ct], bv, acc[ct], 0, 0, 0); }
                    float g4[4][4];
#pragma unroll
                    for (int ct = 0; ct < 4; ++ct) { g4[ct][0] = acc[ct][0]; g4[ct][1] = acc[ct][1]; g4[ct][2] = acc[ct][2]; g4[ct][3] = acc[ct][3]; }
                    flush_rows(stg, TILE(WS_PG, tt), g4, fr, fq, lane); (void)tok;
                }
            }
#pragma unroll
            for (int tt = 0; tt < 2; ++tt) { float b = bon[tt]; b += __shfl_xor(b, 16); b += __shfl_xor(b, 32);
                if (fq == 0) ((float*)(F.ws + WS_BON))[(size_t)(tok0 + 16 * tt + fr) * 8 + h] = b; }
        }
        asm volatile("" ::: "memory"); __builtin_amdgcn_sched_barrier(0);
        if (SM & 4) {
            int tid = F.tid; asm volatile("" : "+v"(tid));
            const bool lat = s >= 16;
            const int y = lat ? (t0 >> 6) : 0, W = lat ? 64 : 256, j0 = (tid >> 7) * 8, x0 = (lat ? (t0 & 63) : t0) + j0;
#pragma unroll 1
            for (int half = 0; half < 2; ++half) {
                const int c4 = (tid & 127) * 4 + half * 512;
                const float* cw = a.in[I_MCONV] + c4;
                float acc[8][4];
#pragma unroll
                for (int jj = 0; jj < 8; ++jj)
#pragma unroll
                    for (int e = 0; e < 4; ++e) acc[jj][e] = 0.f;
#pragma unroll 1
                for (int dy = -1; dy <= 1; ++dy) {
                    const bool rowok = dy == 0 || (lat && y + dy >= 0 && y + dy < 32);
                    const int dyo = rowok ? dy * 64 : 0; const float rmask = rowok ? 1.f : 0.f;
                    f32x4 wt[3];
#pragma unroll
                    for (int dx = 0; dx < 3; ++dx) wt[dx] = *(const f32x4*)(cw + ((dy + 1) * 3 + dx) * 1024) * rmask;
#pragma unroll
                    for (int i = 0; i < 10; ++i) { const int xx = x0 - 1 + i; const bool ok = xx >= 0 && xx < W;
                        const u32x2 raw = *(const u32x2*)(Z + ((long)(tok0 + j0 + dyo) + (i - 1)) * Z1C + ZM_Q + c4);
                        const float cm = ok ? 1.f : 0.f;
                        const f32x4 xv = (f32x4){bf2f(raw.x & 0xffffu), bf2f(raw.x >> 16), bf2f(raw.y & 0xffffu), bf2f(raw.y >> 16)} * cm;
#pragma unroll
                        for (int dx = -1; dx <= 1; ++dx) { const int jj = i - 1 - dx;
                            if (jj >= 0 && jj < 8) {
#pragma unroll
                                for (int e = 0; e < 4; ++e) acc[jj][e] += wt[dx + 1][e] * xv[e]; } }
                    }
                }
                const float sc = half == 0 ? 0.08838834764831845f : 1.f;
                bf16_t* dst = (half == 0 ? (bf16_t*)(F.ws + WS_MQ) : (bf16_t*)(F.ws + WS_MK)) + (tid & 127) * 4;
#pragma unroll
                for (int jj = 0; jj < 8; ++jj) {
#pragma unroll
                    for (int e = 0; e < 4; ++e) acc[jj][e] = silu(acc[jj][e]) * sc;
                    u32x2 o; o.x = cvt_pk(acc[jj][0], acc[jj][1]); o.y = cvt_pk(acc[jj][2], acc[jj][3]);
                    *(u32x2*)(dst + (size_t)(tok0 + j0 + jj) * 512) = o; }
                asm volatile("" ::: "memory"); __builtin_amdgcn_sched_barrier(0);
            }
            { const int j = tid >> 4, gi = tid & 15, tok = tok0 + j;
                const float val = bf2f(Z[(size_t)tok * Z1C + ZM_G + gi]) + a.in[I_MGB][gi];
                if (gi < 8) ((float*)(F.ws + WS_LI))[(size_t)gi * NTOK + tok] = val;
                else ((float*)(F.ws + WS_LF))[(size_t)(gi - 8) * NTOK + tok] = fminf(val, 0.f) - log1pf(__expf(-fabsf(val))); }
        }
    }
}

typedef short bf16x4 __attribute__((ext_vector_type(4)));
__device__ __forceinline__ bf16x4 to_b4(const f32x4 c) { u32x2 p; p.x = cvt_pk(c[0], c[1]); p.y = cvt_pk(c[2], c[3]); return __builtin_bit_cast(bf16x4, p); }
__device__ __forceinline__ bf16x8 cat8(const bf16x4 a, const bf16x4 b) { return __builtin_shufflevector(a, b, 0, 1, 2, 3, 4, 5, 6, 7); }
#define MM2(a0, b0, a1, b1, c) __builtin_amdgcn_mfma_f32_16x16x32_bf16(cat8(a0, a1), cat8(b0, b1), c, 0, 0, 0)
#define MM1(a, b, c) __builtin_amdgcn_mfma_f32_16x16x32_bf16(cat8(a, (bf16x4){0, 0, 0, 0}), cat8(b, (bf16x4){0, 0, 0, 0}), c, 0, 0, 0)
constexpr int R1_AA = 0, R1_BB = 2304, R1_KK = 4608, R1_RR = 6912, R1_BPT = 9216, R1_KPT = 12288, R1_VT = 15360, R1_GB = 18432, R1_BYTES = 18688;
__device__ __forceinline__ int r_slot0(int s, int dir, int h) { return s < 16 ? (((s * 2 + dir) * 8 + h) * 4) : 1024 + ((((s - 16) * 2 + dir) * 8 + h) * 32); }
template <int PM = 0>
__device__ __forceinline__ void rwkv_pass1(Frame& F, int unit) {
    int c, s, dir; const int h = unit & 7, g = unit >> 3;
    if (g < 128) { c = g & 3; s = g >> 3; dir = (g >> 2) & 1; } else { const int g2 = g - 128; c = g2 & 31; s = 16 + (g2 >> 6); dir = (g2 >> 5) & 1; }
    const int slot = r_slot0(s, dir, h) + c;
    const int sb = seq_base(s), T = seq_len(s), lane = F.lane, fr = lane & 15, fq = lane >> 4;
    LAS unsigned char* wl = F.lds + F.wave * R1_BYTES;
    const bf16_t* PR = (const bf16_t*)(F.ws + WS_PR) + h * 64; const bf16_t* PV = (const bf16_t*)(F.ws + WS_PV) + h * 64; const bf16_t* PKK = (const bf16_t*)(F.ws + WS_PKK) + h * 64;
    const bf16_t* PW = (const bf16_t*)(F.ws + WS_PW) + (size_t)dir * NTOK * 512 + h * 64; const bf16_t* PKD = (const bf16_t*)(F.ws + WS_PKD) + (size_t)dir * NTOK * 512 + h * 64;
    const bf16_t* PB = (const bf16_t*)(F.ws + WS_PB) + (size_t)dir * NTOK * 512 + h * 64;
    bf16_t* ybase = PM ? (bf16_t*)(F.ws + WS_PW) : (bf16_t*)F.out;
    bf16_t* YS = ybase + (size_t)dir * NTOK * 512 + h * 64; bf16_t* US = ybase + (size_t)(2 + dir) * NTOK * 512 + h * 64;
    f32x4 XT[4][8];
#pragma unroll
    for (int kt = 0; kt < 4; ++kt)
#pragma unroll
        for (int rt = 0; rt < 8; ++rt)
#pragma unroll
            for (int j = 0; j < 4; ++j) XT[kt][rt][j] = (rt >= 4 && (16 * kt + 4 * fq + j) == (16 * (rt - 4) + fr)) ? 1.f : 0.f;
#pragma unroll 1
    for (int blk = 0; blk < 4; ++blk) {
        const int pos0 = c * 64 + blk * 16;
        {
            const int t = lane >> 2, cp = (lane & 3) * 8, p = pos0 + t, tt = dir ? T - 1 - p : p; const size_t off = (size_t)(sb + tt) * 512 + cp;
            u32x4 raw[6][2];
            if (PM == 1) {
#pragma unroll
                for (int q = 0; q < 6; ++q) { raw[q][0] = (u32x4){0x3e003e00u + (unsigned)lane, 0x3e003e00u, 0x3e003e00u, 0x3e003e00u}; raw[q][1] = raw[q][0]; }
            } else {
                raw[0][0] = *(const u32x4*)(PKK + off); raw[0][1] = *(const u32x4*)(PKK + off + 32); raw[1][0] = *(const u32x4*)(PB + off); raw[1][1] = *(const u32x4*)(PB + off + 32);
                raw[2][0] = *(const u32x4*)(PKD + off); raw[2][1] = *(const u32x4*)(PKD + off + 32); raw[3][0] = *(const u32x4*)(PR + off); raw[3][1] = *(const u32x4*)(PR + off + 32);
                raw[4][0] = *(const u32x4*)(PW + off); raw[4][1] = *(const u32x4*)(PW + off + 32); raw[5][0] = *(const u32x4*)(PV + off); raw[5][1] = *(const u32x4*)(PV + off + 32);
            }
            const int lo = t * 144 + cp * 2;
            *(LAS u32x4*)(wl + R1_AA + lo) = raw[0][0]; *(LAS u32x4*)(wl + R1_AA + lo + 64) = raw[0][1]; *(LAS u32x4*)(wl + R1_BB + lo) = raw[1][0]; *(LAS u32x4*)(wl + R1_BB + lo + 64) = raw[1][1];
            *(LAS u32x4*)(wl + R1_KK + lo) = raw[2][0]; *(LAS u32x4*)(wl + R1_KK + lo + 64) = raw[2][1]; *(LAS u32x4*)(wl + R1_RR + lo) = raw[3][0]; *(LAS u32x4*)(wl + R1_RR + lo + 64) = raw[3][1];
            *(LAS u32x4*)(wl + R1_BPT + lo) = raw[4][0]; *(LAS u32x4*)(wl + R1_BPT + lo + 64) = raw[4][1]; *(LAS u32x4*)(wl + R1_KPT + lo) = raw[5][0]; *(LAS u32x4*)(wl + R1_KPT + lo + 64) = raw[5][1];
        }
        LDS_WAIT(); asm volatile("" ::: "memory");
        {
            float gt[16], vv[16], gB = 1.f;
#pragma unroll
            for (int t = 0; t < 16; ++t) { gB *= bf2f(*(const LAS bf16_t*)(wl + R1_BPT + t * 144 + lane * 2)); gt[t] = gB; vv[t] = bf2f(*(const LAS bf16_t*)(wl + R1_KPT + t * 144 + lane * 2)); }
            LDS_WAIT(); asm volatile("" ::: "memory");
#pragma unroll
            for (int tp = 0; tp < 8; ++tp) {
                float bp[2], kp[2];
#pragma unroll
                for (int e = 0; e < 2; ++e) { const int t = 2 * tp + e; const int lo = t * 144 + lane * 2;
                    const float kk = bf2f(*(const LAS bf16_t*)(wl + R1_AA + lo)), b = bf2f(*(const LAS bf16_t*)(wl + R1_BB + lo)), kd = bf2f(*(const LAS bf16_t*)(wl + R1_KK + lo)), r = bf2f(*(const LAS bf16_t*)(wl + R1_RR + lo));
                    const float g = gt[t], gm1 = t ? gt[t > 0 ? t - 1 : 0] : 1.f, inv = __builtin_amdgcn_rcpf(g), bb = b * inv, kq = kd * inv;
                    bp[e] = bb * gB; kp[e] = kq * gB;
                    *(LAS bf16_t*)(wl + R1_AA + lo) = (bf16_t)cvt_pk(gm1 * kk, 0.f); *(LAS bf16_t*)(wl + R1_BB + lo) = (bf16_t)cvt_pk(bb, 0.f);
                    *(LAS bf16_t*)(wl + R1_KK + lo) = (bf16_t)cvt_pk(kq, 0.f); *(LAS bf16_t*)(wl + R1_RR + lo) = (bf16_t)cvt_pk(g * r, 0.f); }
                *(LAS unsigned*)(wl + R1_BPT + lane * 48 + tp * 4) = cvt_pk(bp[0], bp[1]);
                *(LAS unsigned*)(wl + R1_KPT + lane * 48 + tp * 4) = cvt_pk(kp[0], kp[1]);
                *(LAS unsigned*)(wl + R1_VT + lane * 48 + tp * 4) = cvt_pk(vv[2 * tp], vv[2 * tp + 1]);
            }
            *(LAS float*)(wl + R1_GB + lane * 4) = gB;
        }
        LDS_WAIT(); asm volatile("" ::: "memory");
        bf16x4 fAA[4], fRR[4];
        f32x4 Nn = {0.f, 0.f, 0.f, 0.f}, NT = Nn, P2T = Nn, Q1T = Nn, Q2T = Nn;
        {
            bf16x4 fB[4], fK[4];
#pragma unroll
            for (int kt = 0; kt < 4; ++kt) { const int o1 = fr * 144 + (16 * kt + 4 * fq) * 2;
                fAA[kt] = *(const LAS bf16x4*)(wl + R1_AA + o1); fRR[kt] = *(const LAS bf16x4*)(wl + R1_RR + o1); fB[kt] = *(const LAS bf16x4*)(wl + R1_BB + o1); fK[kt] = *(const LAS bf16x4*)(wl + R1_KK + o1); }
#pragma unroll
            for (int kp = 0; kp < 4; kp += 2) {
                Nn = MM2(fAA[kp], fB[kp], fAA[kp + 1], fB[kp + 1], Nn); NT = MM2(fB[kp], fAA[kp], fB[kp + 1], fAA[kp + 1], NT); P2T = MM2(fK[kp], fAA[kp], fK[kp + 1], fAA[kp + 1], P2T);
                Q1T = MM2(fB[kp], fRR[kp], fB[kp + 1], fRR[kp + 1], Q1T); Q2T = MM2(fK[kp], fRR[kp], fK[kp + 1], fRR[kp + 1], Q2T); }
        }
        f32x4 Ic;
#pragma unroll
        for (int j = 0; j < 4; ++j) { const int m = 4 * fq + j, n = fr;
            Nn[j] = (n < m) ? Nn[j] : 0.f; NT[j] = (m < n) ? NT[j] : 0.f; P2T[j] = (m < n) ? P2T[j] : 0.f; Q1T[j] = (m <= n) ? Q1T[j] : 0.f; Q2T[j] = (m <= n) ? Q2T[j] : 0.f; Ic[j] = (m == n) ? 1.f : 0.f; }
        const f32x4 Z4 = {0.f, 0.f, 0.f, 0.f};
        const bf16x4 bNn = to_b4(Nn), bNT = to_b4(NT);
        const f32x4 N2 = MM1(bNT, bNn, Z4), N2T = MM1(bNn, bNT, Z4);
        const bf16x4 bN2 = to_b4(N2), bN2T = to_b4(N2T);
        const f32x4 N4 = MM1(bN2T, bN2, Z4), N4T = MM1(bN2, bN2T, Z4);
        const f32x4 N8 = MM1(to_b4(N4T), to_b4(N4), Z4);
        const f32x4 T2T = MM1(to_b4(Ic + N2), to_b4(Ic - NT), Z4);
        const f32x4 T3T = MM1(to_b4(Ic + N4), to_b4(T2T), Z4);
        const f32x4 TiT = MM1(to_b4(Ic + N8), to_b4(T3T), Z4);
        const bf16x4 bTn = to_b4(Z4 - TiT), bP2T = to_b4(P2T), bQ1T = to_b4(Q1T), bQ2T = to_b4(Q2T);
#pragma unroll
        for (int rt = 0; rt < (PM == 3 ? 0 : 8); ++rt) {
            bf16x4 bX[4];
#pragma unroll
            for (int kt = 0; kt < 4; ++kt) bX[kt] = to_b4(XT[kt][rt]);
            const bf16x4 z4b = {0, 0, 0, 0};
            f32x4 cg = MM2(fAA[0], bX[0], fAA[1], bX[1], Z4); cg = MM2(fAA[2], bX[2], fAA[3], bX[3], cg);
            bf16x4 bV = z4b;
            if (rt < 4) { bV = *(const LAS bf16x4*)(wl + R1_VT + (16 * rt + fr) * 48 + 8 * fq); cg = MM1(bP2T, bV, cg); }
            const bf16x4 bD = to_b4(MM1(bTn, to_b4(cg), Z4));
            f32x4 y = MM2(fRR[0], bX[0], fRR[1], bX[1], Z4); y = MM2(fRR[2], bX[2], fRR[3], bX[3], y);
            y = MM2(bQ1T, bD, (rt < 4 ? bQ2T : z4b), bV, y);
#pragma unroll
            for (int j = 0; j < 4; ++j) *(LAS bf16_t*)(wl + (4 * fq + j) * 256 + (16 * rt + fr) * 2) = (bf16_t)cvt_pk(y[j], 0.f);
#pragma unroll
            for (int kt = 0; kt < 4; ++kt) { const int o2 = (16 * kt + fr) * 48 + 8 * fq;
                const f32x4 x = XT[kt][rt] * *(const LAS f32x4*)(wl + R1_GB + (16 * kt + 4 * fq) * 4);
                XT[kt][rt] = MM2(*(const LAS bf16x4*)(wl + R1_BPT + o2), bD, (rt < 4 ? *(const LAS bf16x4*)(wl + R1_KPT + o2) : z4b), bV, x); }
            __builtin_amdgcn_sched_barrier(0);
        }
        LDS_WAIT(); asm volatile("" ::: "memory");
        if (PM != 2) {
            const int t = lane >> 2, part = lane & 3, p = pos0 + t, tt = dir ? T - 1 - p : p;
            bf16_t* yo = (part < 2 ? YS : US) + (size_t)(sb + tt) * 512 + 32 * (part & 1);
#pragma unroll
            for (int i = 0; i < 4; ++i) *(u32x4*)(yo + 8 * i) = *(const LAS u32x4*)(wl + t * 256 + part * 64 + 16 * i);
        }
        LDS_WAIT(); asm volatile("" ::: "memory");
    }
    if (PM) {
#pragma unroll
        for (int kt = 0; kt < 4; ++kt)
#pragma unroll
            for (int rt = 0; rt < 8; ++rt) asm volatile("" :: "v"(XT[kt][rt]));
        return; }
    bf16_t* sp = (bf16_t*)(F.ws + WS_SP) + (size_t)slot * 8192;
#pragma unroll
    for (int rt = 0; rt < 4; ++rt) {
        u32x4 o0, o1;
        o0.x = cvt_pk(XT[0][rt][0], XT[0][rt][1]); o0.y = cvt_pk(XT[0][rt][2], XT[0][rt][3]); o0.z = cvt_pk(XT[1][rt][0], XT[1][rt][1]); o0.w = cvt_pk(XT[1][rt][2], XT[1][rt][3]);
        o1.x = cvt_pk(XT[2][rt][0], XT[2][rt][1]); o1.y = cvt_pk(XT[2][rt][2], XT[2][rt][3]); o1.z = cvt_pk(XT[3][rt][0], XT[3][rt][1]); o1.w = cvt_pk(XT[3][rt][2], XT[3][rt][3]);
        *(u32x4*)(sp + 4096 + (16 * rt + fr) * 64 + fq * 16) = o0; *(u32x4*)(sp + 4096 + (16 * rt + fr) * 64 + fq * 16 + 8) = o1;
#pragma unroll
        for (int kt = 0; kt < 4; ++kt)
#pragma unroll
            for (int j = 0; j < 4; ++j) *(LAS bf16_t*)(wl + (16 * kt + 4 * fq + j) * 128 + ((fr >> 2) * 16 + rt * 4 + (fr & 3)) * 2) = (bf16_t)cvt_pk(XT[kt][4 + rt][j], 0.f);
    }
    LDS_WAIT(); asm volatile("" ::: "memory");
#pragma unroll
    for (int i = 0; i < 8; ++i) { const int id = lane + 64 * i; *(u32x4*)(sp + (id >> 3) * 64 + (id & 7) * 8) = *(const LAS u32x4*)(wl + (id >> 3) * 128 + (id & 7) * 16); }
}
struct PropStage { bf16x4 a[4][4]; u32x2 sl[4]; };
template <int MODE = 0>
__device__ __forceinline__ void rwkv_prop(Frame& F, int wu, size_t st_off = 0, bool fin = true) {
    const Args& a = *F.a;
    int s, dir, h, vt;
    if (wu < 128) { const int hs = wu >> 2; vt = wu & 3; s = 16 + (hs >> 4); dir = (hs >> 3) & 1; h = hs & 7; } else { const int u2 = wu - 128, hs = u2 >> 2; vt = u2 & 3; s = hs >> 4; dir = (hs >> 3) & 1; h = hs & 7; }
    const int nch = seq_len(s) / 64, lane = F.lane, fr = lane & 15, fq = lane >> 4;
    bf16_t* sp0 = (bf16_t*)(F.ws + WS_SP) + (size_t)r_slot0(s, dir, h) * 8192;
    bf16x4 bS[4]; f32x4 acc[4];
    if (s >= 16) { const float* s0 = a.in[I_SR] + ((((size_t)(s - 16) * 2 + dir) * 8 + h) * 4096) + (16 * vt + fr) * 64 + 4 * fq;
#pragma unroll
        for (int it = 0; it < 4; ++it) bS[it] = to_b4(*(const f32x4*)(s0 + 16 * it));
    } else {
#pragma unroll
        for (int it = 0; it < 4; ++it) bS[it] = (bf16x4){0, 0, 0, 0};
    }
#pragma unroll
    for (int kt = 0; kt < 4; ++kt) acc[kt] = (f32x4){0.f, 0.f, 0.f, 0.f};
    PropStage st[4];
#define PROP_LOAD(u, cidx) do { const bf16_t* spc = sp0 + (size_t)(cidx) * 8192; \
        _Pragma("unroll") for (int kt = 0; kt < 4; ++kt) { const u32x4 lo_ = *(const u32x4*)(spc + (16 * kt + fr) * 64 + fq * 16), hi_ = *(const u32x4*)(spc + (16 * kt + fr) * 64 + fq * 16 + 8); \
            st[u].a[kt][0] = __builtin_bit_cast(bf16x4, (u32x2){lo_.x, lo_.y}); st[u].a[kt][1] = __builtin_bit_cast(bf16x4, (u32x2){lo_.z, lo_.w}); \
            st[u].a[kt][2] = __builtin_bit_cast(bf16x4, (u32x2){hi_.x, hi_.y}); st[u].a[kt][3] = __builtin_bit_cast(bf16x4, (u32x2){hi_.z, hi_.w}); } \
        { const u32x4 lo_ = *(const u32x4*)(spc + 4096 + (16 * vt + fr) * 64 + fq * 16), hi_ = *(const u32x4*)(spc + 4096 + (16 * vt + fr) * 64 + fq * 16 + 8); \
            st[u].sl[0] = (u32x2){lo_.x, lo_.y}; st[u].sl[1] = (u32x2){lo_.z, lo_.w}; st[u].sl[2] = (u32x2){hi_.x, hi_.y}; st[u].sl[3] = (u32x2){hi_.z, hi_.w}; } } while (0)
#pragma unroll
    for (int u = 0; u < 4; ++u) PROP_LOAD(u, u);
    for (int c0 = 0; c0 < nch; c0 += 4) {
#pragma unroll
        for (int u = 0; u < 4; ++u) { const int c = c0 + u; bf16_t* spc = sp0 + (size_t)c * 8192;
#pragma unroll
            for (int kt = 0; kt < 4; ++kt) { acc[kt][0] = bf2f(st[u].sl[kt].x & 0xffffu); acc[kt][1] = bf2f(st[u].sl[kt].x >> 16); acc[kt][2] = bf2f(st[u].sl[kt].y & 0xffffu); acc[kt][3] = bf2f(st[u].sl[kt].y >> 16); }
#pragma unroll
            for (int it = 0; it < 4; ++it) *(bf16x4*)(spc + st_off + 4096 + (16 * vt + fr) * 64 + 16 * it + 4 * fq) = bS[it];
#pragma unroll
            for (int kt = 0; kt < 4; ++kt)
#pragma unroll
                for (int it = 0; it < 4; it += 2) { if (MODE == 2) { acc[kt][0] += __builtin_bit_cast(float, (int)st[u].a[kt][it][0] + (int)bS[it][0]); } else acc[kt] = MM2(st[u].a[kt][it], bS[it], st[u].a[kt][it + 1], bS[it + 1], acc[kt]); }
#pragma unroll
            for (int kt = 0; kt < 4; ++kt) bS[kt] = to_b4(acc[kt]);
            if (MODE != 1) { const int cn = c + 4 < nch ? c + 4 : nch - 1; PROP_LOAD(u, cn); }
        }
    }
#undef PROP_LOAD
    if (s < 16 && fin) { float* so = F.out + OUT_SR + ((((size_t)s * 2 + dir) * 8 + h) * 4096) + (16 * vt + fr) * 64 + 4 * fq;
#pragma unroll
        for (int kt = 0; kt < 4; ++kt) *(f32x4*)(so + 16 * kt) = acc[kt]; }
}
constexpr int RPL_SLOT = 11520, RPL_NS = 12, RPL_FLG = RPL_SLOT * RPL_NS;
__device__ __forceinline__ void rwkv_prop_lat(Frame& F, int wu) {
    const Args& a = *F.a;
    const int hs = wu >> 2, vt = wu & 3, s = 16 + (hs >> 4), dir = (hs >> 3) & 1, h = hs & 7;
    const int lane = F.lane, fr = lane & 15, fq = lane >> 4;
    bf16_t* sp0 = (bf16_t*)(F.ws + WS_SP) + (size_t)r_slot0(s, dir, h) * 8192;
    LAS unsigned char* L = F.lds; volatile LAS unsigned* flg = (volatile LAS unsigned*)(L + RPL_FLG);
    __syncthreads();
    if (F.tid < 64) flg[F.tid] = 0u;
    __syncthreads();
    if (F.wave == 0) {
        bf16x4 bS[4];
        { const float* s0 = a.in[I_SR] + ((((size_t)(s - 16) * 2 + dir) * 8 + h) * 4096) + (16 * vt + fr) * 64 + 4 * fq;
#pragma unroll
            for (int it = 0; it < 4; ++it) bS[it] = to_b4(*(const f32x4*)(s0 + 16 * it)); }
#pragma unroll 1
        for (int c = 0; c < 32; ++c) {
            while (flg[c] == 0u) __builtin_amdgcn_s_sleep(1);
            asm volatile("" ::: "memory");
            const LAS unsigned char* sl_ = L + (c % RPL_NS) * RPL_SLOT;
            bf16x4 af[4][4]; f32x4 acc[4];
#pragma unroll
            for (int kt = 0; kt < 4; ++kt) { const u32x4 lo_ = *(const LAS u32x4*)(sl_ + (16 * kt + fr) * 144 + fq * 32), hi_ = *(const LAS u32x4*)(sl_ + (16 * kt + fr) * 144 + fq * 32 + 16);
                af[kt][0] = __builtin_bit_cast(bf16x4, (u32x2){lo_.x, lo_.y}); af[kt][1] = __builtin_bit_cast(bf16x4, (u32x2){lo_.z, lo_.w});
                af[kt][2] = __builtin_bit_cast(bf16x4, (u32x2){hi_.x, hi_.y}); af[kt][3] = __builtin_bit_cast(bf16x4, (u32x2){hi_.z, hi_.w}); }
            { const u32x4 lo_ = *(const LAS u32x4*)(sl_ + 9216 + fr * 144 + fq * 32), hi_ = *(const LAS u32x4*)(sl_ + 9216 + fr * 144 + fq * 32 + 16);
                const unsigned w8[8] = {lo_.x, lo_.y, lo_.z, lo_.w, hi_.x, hi_.y, hi_.z, hi_.w};
#pragma unroll
                for (int kt = 0; kt < 4; ++kt) { acc[kt][0] = bf2f(w8[2 * kt] & 0xffffu); acc[kt][1] = bf2f(w8[2 * kt] >> 16); acc[kt][2] = bf2f(w8[2 * kt + 1] & 0xffffu); acc[kt][3] = bf2f(w8[2 * kt + 1] >> 16); } }
            LDS_WAIT(); asm volatile("" ::: "memory");
            flg[32] = (unsigned)(c + 1);
            bf16_t* spc = sp0 + (size_t)c * 8192;
#pragma unroll
            for (int it = 0; it < 4; ++it) *(bf16x4*)(spc + 4096 + (16 * vt + fr) * 64 + 16 * it + 4 * fq) = bS[it];
#pragma unroll
            for (int kt = 0; kt < 4; ++kt)
#pragma unroll
                for (int it = 0; it < 4; it += 2) acc[kt] = MM2(af[kt][it], bS[it], af[kt][it + 1], bS[it + 1], acc[kt]);
#pragma unroll
            for (int kt = 0; kt < 4; ++kt) bS[kt] = to_b4(acc[kt]);
        }
    } else {
#pragma unroll 1
        for (int c = F.wave - 1; c < 32; c += 14) {
            const int c2 = c + 7; const bool two = c2 < 32;
            const unsigned char* g1 = (const unsigned char*)(sp0 + (size_t)c * 8192); const unsigned char* g2 = (const unsigned char*)(sp0 + (size_t)(two ? c2 : c) * 8192);
            u32x4 r1[10], r2[10];
#pragma unroll
            for (int j = 0; j < 8; ++j) r1[j] = *(const u32x4*)(g1 + (lane + 64 * j) * 16);
#pragma unroll
            for (int j = 0; j < 2; ++j) r1[8 + j] = *(const u32x4*)(g1 + 8192 + vt * 2048 + (lane + 64 * j) * 16);
#pragma unroll
            for (int j = 0; j < 8; ++j) r2[j] = *(const u32x4*)(g2 + (lane + 64 * j) * 16);
#pragma unroll
            for (int j = 0; j < 2; ++j) r2[8 + j] = *(const u32x4*)(g2 + 8192 + vt * 2048 + (lane + 64 * j) * 16);
            while ((int)flg[32] < c - (RPL_NS - 1)) __builtin_amdgcn_s_sleep(1);
            { LAS unsigned char* d = L + (c % RPL_NS) * RPL_SLOT;
#pragma unroll
                for (int j = 0; j < 8; ++j) { const int idx = lane + 64 * j; *(LAS u32x4*)(d + (idx >> 3) * 144 + (idx & 7) * 16) = r1[j]; }
#pragma unroll
                for (int j = 0; j < 2; ++j) { const int idx = lane + 64 * j; *(LAS u32x4*)(d + 9216 + (idx >> 3) * 144 + (idx & 7) * 16) = r1[8 + j]; }
                LDS_WAIT(); asm volatile("" ::: "memory"); flg[c] = 1u; }
            if (two) {
                while ((int)flg[32] < c2 - (RPL_NS - 1)) __builtin_amdgcn_s_sleep(1);
                LAS unsigned char* d = L + (c2 % RPL_NS) * RPL_SLOT;
#pragma unroll
                for (int j = 0; j < 8; ++j) { const int idx = lane + 64 * j; *(LAS u32x4*)(d + (idx >> 3) * 144 + (idx & 7) * 16) = r2[j]; }
#pragma unroll
                for (int j = 0; j < 2; ++j) { const int idx = lane + 64 * j; *(LAS u32x4*)(d + 9216 + (idx >> 3) * 144 + (idx & 7) * 16) = r2[8 + j]; }
                LDS_WAIT(); asm volatile("" ::: "memory"); flg[c2] = 1u; }
        }
    }
}
__device__ __forceinline__ void rwkv_fix(Frame& F, int wu2) {
    const Args& a = *F.a; const int wu = wu2 >> 1, th = wu2 & 1;
    int s, cc, h;
    if (wu < 512) { const int cg = wu >> 3; h = wu & 7; s = cg >> 2; cc = cg & 3; } else { const int u2 = wu - 512, cg = u2 >> 3; h = u2 & 7; s = 16 + (cg >> 5); cc = cg & 31; }
    const int sb = seq_base(s), nch = seq_len(s) / 64, tok0 = sb + cc * 64, lane = F.lane, fr = lane & 15, fq = lane >> 4;
    f32x4 acc[4][2];
#pragma unroll
    for (int vt = 0; vt < 4; ++vt)
#pragma unroll
        for (int tt = 0; tt < 2; ++tt) acc[vt][tt] = (f32x4){0.f, 0.f, 0.f, 0.f};
#pragma unroll
    for (int d = 0; d < 2; ++d) {
        const bf16_t* sin = (const bf16_t*)(F.ws + WS_SP) + (size_t)(r_slot0(s, d, h) + (d ? nch - 1 - cc : cc)) * 8192 + 4096;
        const bf16_t* us = (const bf16_t*)F.out + (size_t)(2 + d) * NTOK * 512 + h * 64;
#pragma unroll
        for (int ks = 0; ks < 2; ++ks) { bf16x8 aS[4], bU[2];
#pragma unroll
            for (int i = 0; i < 4; ++i) aS[i] = *(const bf16x8*)(sin + (16 * i + fr) * 64 + 32 * ks + 8 * fq);
#pragma unroll
            for (int i = 0; i < 2; ++i) bU[i] = *(const bf16x8*)(us + (size_t)(tok0 + 32 * th + 16 * i + fr) * 512 + 32 * ks + 8 * fq);
#pragma unroll
            for (int vt = 0; vt < 4; ++vt)
#pragma unroll
                for (int tt = 0; tt < 2; ++tt) acc[vt][tt] = __builtin_amdgcn_mfma_f32_16x16x32_bf16(aS[vt], bU[tt], acc[vt][tt], 0, 0, 0); }
    }
    const bf16_t* YS = (const bf16_t*)F.out + h * 64 + 4 * fq;
#pragma unroll
    for (int tt = 0; tt < 2; ++tt) { const size_t tok = (size_t)(tok0 + 32 * th + 16 * tt + fr);
        float sm = 0.f;
#pragma unroll
        for (int vt = 0; vt < 4; ++vt) { const u32x2 y0 = *(const u32x2*)(YS + tok * 512 + 16 * vt), y1 = *(const u32x2*)(YS + ((size_t)NTOK + tok) * 512 + 16 * vt);
            acc[vt][tt][0] += bf2f(y0.x & 0xffffu) + bf2f(y1.x & 0xffffu); acc[vt][tt][1] += bf2f(y0.x >> 16) + bf2f(y1.x >> 16);
            acc[vt][tt][2] += bf2f(y0.y & 0xffffu) + bf2f(y1.y & 0xffffu); acc[vt][tt][3] += bf2f(y0.y >> 16) + bf2f(y1.y >> 16);
            sm += (acc[vt][tt][0] + acc[vt][tt][1]) + (acc[vt][tt][2] + acc[vt][tt][3]); }
        sm += __shfl_xor(sm, 16); sm += __shfl_xor(sm, 32);
        const float mean = sm * (1.f / 64.f); float vs = 0.f;
#pragma unroll
        for (int vt = 0; vt < 4; ++vt)
#pragma unroll
            for (int j = 0; j < 4; ++j) { acc[vt][tt][j] -= mean; vs += acc[vt][tt][j] * acc[vt][tt][j]; }
        vs += __shfl_xor(vs, 16); vs += __shfl_xor(vs, 32);
        const float rstd = rsqrtf(vs * (1.f / 64.f) + 64e-5f), bon = ((const float*)(F.ws + WS_BON))[tok * 8 + h];
#pragma unroll
        for (int vt = 0; vt < 4; ++vt) { const int c = h * 64 + 16 * vt + 4 * fq;
            const u32x2 vv = *(const u32x2*)((const bf16_t*)(F.ws + WS_PV) + tok * 512 + c), gg = *(const u32x2*)((const bf16_t*)(F.ws + WS_PG) + tok * 512 + c);
            const f32x4 lg = *(const f32x4*)(a.in[I_LNG] + c), lb = *(const f32x4*)(a.in[I_LNB] + c);
            const float v4[4] = {bf2f(vv.x & 0xffffu), bf2f(vv.x >> 16), bf2f(vv.y & 0xffffu), bf2f(vv.y >> 16)}, g4[4] = {bf2f(gg.x & 0xffffu), bf2f(gg.x >> 16), bf2f(gg.y & 0xffffu), bf2f(gg.y >> 16)};
            float r[4];
#pragma unroll
            for (int j = 0; j < 4; ++j) r[j] = (acc[vt][tt][j] * rstd * lg[j] + lb[j] + bon * v4[j]) * g4[j];
            u32x2 o; o.x = cvt_pk(r[0], r[1]); o.y = cvt_pk(r[2], r[3]);
            *(u32x2*)((bf16_t*)(F.ws + WS_YRB) + tok * 512 + c) = o; }
    }
}

__device__ __forceinline__ f32x4 mma16(const LAS unsigned char* A, int sa, const LAS unsigned char* B, int sb, int K, f32x4 acc, int fr, int fq) {
#pragma unroll
    for (int k0 = 0; k0 < K; k0 += 32) {
        const bf16x8 av = *(const LAS bf16x8*)(A + fr * sa + (k0 + fq * 8) * 2);
        const bf16x8 bv = *(const LAS bf16x8*)(B + fr * sb + (k0 + fq * 8) * 2);
        acc = __builtin_amdgcn_mfma_f32_16x16x32_bf16(av, bv, acc, 0, 0, 0);
    }
    return acc;
}
typedef short v4i16_t __attribute__((ext_vector_type(4)));
__device__ __forceinline__ bf16x4 tr_frag(const LAS unsigned char* tile, int rs, int r0, int c0, int lane) {
    const int g = lane >> 4, q = (lane & 15) >> 2, p = lane & 3;
    return __builtin_bit_cast(bf16x4, __builtin_amdgcn_ds_read_tr16_b64_v4i16((LAS v4i16_t*)(tile + (r0 + 4 * g + q) * rs + (c0 + 4 * p) * 2)));
}
__device__ __forceinline__ int m_slot(int s, int dir, int h, int c) { return s < 16 ? (((s * 2 + dir) * 4 + h) * 2 + c) : 256 + ((((s - 16) * 2 + dir) * 4 + h) * 16 + c); }
__device__ __forceinline__ bf16_t* dc_ptr(unsigned char* ws, int slot) { return (bf16_t*)(ws + WS_DCC) + (size_t)slot * 16384; }
__device__ __forceinline__ float wave_max(float v) {
#pragma unroll
    for (int o = 1; o < 64; o <<= 1) v = fmaxf(v, __shfl_xor(v, o));
    return v;
}
constexpr int PA_K = 0, PA_V = 36864, PA_F = 73728, PA_S = 288, PA_SET = 75264;
__device__ __forceinline__ void pa_decode(int slot, int& dir, int& h, int& tok0) {
    int s, c;
    if (slot < 256) { const int hs = slot >> 1; c = slot & 1; s = hs >> 3; dir = (hs >> 2) & 1; h = hs & 3; } else { const int u2 = slot - 256, hs = u2 >> 4; c = u2 & 15; s = 16 + (hs >> 3); dir = (hs >> 2) & 1; h = hs & 3; }
    const int T = seq_len(s), oc = dir ? T / 128 - 1 - c : c; tok0 = seq_base(s) + oc * 128;
}
__device__ __forceinline__ void mlstm_passA(Frame& F, int slotA) {
    const int tid = F.tid, lane = F.lane, w = F.wave, fr = lane & 15, fq = lane >> 4;
    LAS unsigned char* L = F.lds;
    __syncthreads();
#pragma unroll
    for (int p = 0; p < 2; ++p) { int dir, h, tok0; pa_decode(slotA + 256 * p, dir, h, tok0);
        LAS unsigned char* Lp = L + p * PA_SET; LAS float* fv = (LAS float*)(Lp + PA_F);
        const bf16_t* MK = (const bf16_t*)(F.ws + WS_MK) + h * 128; const bf16_t* ZV = (const bf16_t*)(F.ws + WS_Z2) + Z2_V + h * 128;
        const int j = tid >> 2, part = tid & 3; const size_t tok = (size_t)(tok0 + j);
#pragma unroll
        for (int q = 0; q < 4; ++q) { const int c8 = part * 32 + q * 8;
            *(LAS u32x4*)(Lp + PA_K + j * PA_S + c8 * 2) = *(const u32x4*)(MK + tok * 512 + c8); *(LAS u32x4*)(Lp + PA_V + j * PA_S + c8 * 2) = *(const u32x4*)(ZV + tok * Z2C + c8); }
        if (tid < 128) fv[tid] = ((const float*)(F.ws + WS_LI) + (size_t)(dir * 4 + h) * NTOK)[tok0 + tid];
        else if (tid < 256) fv[tid] = ((const float*)(F.ws + WS_LF) + (size_t)(dir * 4 + h) * NTOK)[tok0 + tid - 128]; }
    __syncthreads();
    if (w < 2) {
        int dir, h, tok0; pa_decode(slotA + 256 * w, dir, h, tok0); (void)h; (void)tok0;
        LAS float* fv = (LAS float*)(L + w * PA_SET + PA_F); LAS float *vli = fv, *vlf = fv + 128, *vwj = fv + 256;
        const int op0 = dir ? 127 - 2 * lane : 2 * lane, op1 = dir ? op0 - 1 : op0 + 1;
        const float f0 = vlf[op0], f1 = vlf[op1]; float sc = f0 + f1;
#pragma unroll
        for (int o = 1; o < 64; o <<= 1) { const float t = __shfl_up(sc, o); if (lane >= o) sc += t; }
        const float b1 = sc, b0 = sc - f1, a0 = vli[op0] - b0, a1 = vli[op1] - b1, mx = wave_max(fmaxf(a0, a1)), bL = __shfl(b1, 63);
        vwj[op0] = __expf(a0 - mx); vwj[op1] = __expf(a1 - mx);
        if (lane == 0) { float* ms = (float*)(F.ws + WS_MS) + (size_t)(slotA + 256 * w) * 4; ms[0] = mx; ms[1] = bL; }
    }
    __syncthreads();
#pragma unroll
    for (int p = 0; p < 2; ++p) { const int slot = slotA + 256 * p;
        const LAS unsigned char* Lp = L + p * PA_SET; const LAS float* vwj = (const LAS float*)(Lp + PA_F) + 256;
        bf16x4 bv[8], bw[8];
#pragma unroll
        for (int sl = 0; sl < 8; ++sl) { const u32x2 r = __builtin_bit_cast(u32x2, tr_frag(Lp + PA_V, PA_S, 16 * sl, 16 * w, lane)); const f32x4 wj4 = *(const LAS f32x4*)(vwj + 16 * sl + 4 * fq);
            u32x2 o; o.x = cvt_pk(bf2f(r.x & 0xffffu) * wj4[0], bf2f(r.x >> 16) * wj4[1]); o.y = cvt_pk(bf2f(r.y & 0xffffu) * wj4[2], bf2f(r.y >> 16) * wj4[3]);
            bv[sl] = __builtin_bit_cast(bf16x4, o);
            u32x2 ow; ow.x = cvt_pk(wj4[0], wj4[1]); ow.y = cvt_pk(wj4[2], wj4[3]); bw[sl] = __builtin_bit_cast(bf16x4, ow); }
        bf16_t* dc = dc_ptr(F.ws, slot);
#pragma unroll
        for (int kt = 0; kt < 8; ++kt) {
            f32x4 acc = {0.f, 0.f, 0.f, 0.f};
#pragma unroll
            for (int sl = 0; sl < 8; sl += 2) acc = MM2(tr_frag(Lp + PA_K, PA_S, 16 * sl, 16 * kt, lane), bv[sl], tr_frag(Lp + PA_K, PA_S, 16 * sl + 16, 16 * kt, lane), bv[sl + 1], acc);
            u32x2 o; o.x = cvt_pk(acc[0], acc[1]); o.y = cvt_pk(acc[2], acc[3]);
            *(u32x2*)(dc + (size_t)(16 * w + fr) * 128 + 16 * kt + 4 * fq) = o; }
        { f32x4 acc = {0.f, 0.f, 0.f, 0.f};
#pragma unroll
            for (int sl = 0; sl < 8; sl += 2) acc = MM2(tr_frag(Lp + PA_K, PA_S, 16 * sl, 16 * w, lane), bw[sl], tr_frag(Lp + PA_K, PA_S, 16 * sl + 16, 16 * w, lane), bw[sl + 1], acc);
            if (fr == 0) *(f32x4*)((float*)(F.ws + WS_DN) + (size_t)slot * 128 + 16 * w + 4 * fq) = acc; }
    }
}
constexpr int C3_SC = 0, C3_K = 4096, C3_VT = 4096 + 34816, C3_CIN = 4096 + 2 * 34816, C3_S = 272;
__device__ __forceinline__ void mlstm_passC3(Frame& F, int ch) {
    const Args& a = *F.a;
    int s, h, cc;
    if (ch < 128) { s = ch >> 3; h = (ch >> 1) & 3; cc = ch & 1; } else { const int u2 = ch - 128; s = 16 + (u2 >> 6); h = (u2 >> 4) & 3; cc = u2 & 15; }
    const int sb = seq_base(s), nch = seq_len(s) / 128, tok0 = sb + cc * 128, tid = F.tid, lane = F.lane, st = F.wave, fr = lane & 15, fq = lane >> 4;
    const size_t tok = (size_t)(tok0 + 16 * st + fr);
    const bf16_t* MQ = (const bf16_t*)(F.ws + WS_MQ) + h * 128; const bf16_t* MK = (const bf16_t*)(F.ws + WS_MK) + h * 128;
    const int slotd[2] = {m_slot(s, 0, h, cc), m_slot(s, 1, h, nch - 1 - cc)};
    LAS unsigned char* L = F.lds; LAS float* scl_ = (LAS float*)(L + C3_SC);
    __syncthreads();
    {
        const int j = tid >> 2, part = tid & 3; const size_t tj = (size_t)(tok0 + j);
        const bf16_t* Z2v = (const bf16_t*)(F.ws + WS_Z2) + Z2_V + h * 128;
#pragma unroll
        for (int q = 0; q < 4; ++q) { const int c8 = part * 32 + q * 8;
            *(LAS u32x4*)(L + C3_K + j * C3_S + c8 * 2) = *(const u32x4*)(MK + tj * 512 + c8);
            const u32x4 v0 = *(const u32x4*)(Z2v + tj * Z2C + c8); const unsigned vw[4] = {v0.x, v0.y, v0.z, v0.w};
#pragma unroll
            for (int i = 0; i < 4; ++i) { *(LAS bf16_t*)(L + C3_VT + (c8 + 2 * i) * C3_S + j * 2) = (bf16_t)(vw[i] & 0xffffu); *(LAS bf16_t*)(L + C3_VT + (c8 + 2 * i + 1) * C3_S + j * 2) = (bf16_t)(vw[i] >> 16); } }
        if (F.wave < 2) {
            const int d = F.wave; LAS float* dv = scl_ + d * 512;
            const float m_in = ((const float*)(F.ws + WS_MS))[(size_t)slotd[d] * 4 + 2];
            const float* LI = (const float*)(F.ws + WS_LI) + (size_t)(d * 4 + h) * NTOK + tok0; const float* LF = (const float*)(F.ws + WS_LF) + (size_t)(d * 4 + h) * NTOK + tok0;
            const int op0 = d ? 127 - 2 * lane : 2 * lane, op1 = d ? op0 - 1 : op0 + 1;
            const float f0 = LF[op0], f1 = LF[op1]; float sc = f0 + f1;
#pragma unroll
            for (int o = 1; o < 64; o <<= 1) { const float t = __shfl_up(sc, o); if (lane >= o) sc += t; }
            const float b1 = sc, b0 = sc - f1, a0 = LI[op0] - b0, a1 = LI[op1] - b1;
            float mxp = fmaxf(a0, a1);
#pragma unroll
            for (int o = 1; o < 64; o <<= 1) { const float t = __shfl_up(mxp, o); if (lane >= o) mxp = fmaxf(mxp, t); }
            float mprev = __shfl_up(mxp, 1); if (lane == 0) mprev = -3.0e38f;
            const float M0 = fmaxf(m_in, fmaxf(mprev, a0)), M1 = fmaxf(m_in, mxp);
            dv[op0] = a0; dv[128 + op0] = M0; dv[256 + op0] = __expf(m_in - M0); dv[384 + op0] = __expf(-b0 - M0);
            dv[op1] = a1; dv[128 + op1] = M1; dv[256 + op1] = __expf(m_in - M1); dv[384 + op1] = __expf(-b1 - M1); } }
    bf16x8 qf[4];
#pragma unroll
    for (int ks = 0; ks < 4; ++ks) qf[ks] = *(const bf16x8*)(MQ + tok * 512 + 32 * ks + 8 * fq);
    __syncthreads();
    f32x4 ST[8];
#pragma unroll
    for (int jt = 0; jt < 8; ++jt) { f32x4 acc = {0.f, 0.f, 0.f, 0.f};
#pragma unroll
        for (int ks = 0; ks < 4; ++ks) acc = __builtin_amdgcn_mfma_f32_16x16x32_bf16(*(const LAS bf16x8*)(L + C3_K + (16 * jt + fr) * C3_S + (32 * ks + 8 * fq) * 2), qf[ks], acc, 0, 0, 0);
        ST[jt] = acc; }
    const int sl = 16 * st + fr;
    float hv[8][4];
#pragma unroll
    for (int vt = 0; vt < 8; ++vt)
#pragma unroll
        for (int jj = 0; jj < 4; ++jj) hv[vt][jj] = 0.f;
#pragma unroll 1
    for (int d = 0; d < 2; ++d) {
        const LAS float* dv = scl_ + d * 512;
        __syncthreads();
        { const bf16_t* cin = dc_ptr(F.ws, slotd[d]);
#pragma unroll
            for (int r = 0; r < 4; ++r) { const int idx = tid + 512 * r, row = idx >> 4, c8 = (idx & 15) * 8; *(LAS u32x4*)(L + C3_CIN + row * C3_S + c8 * 2) = *(const u32x4*)(cin + (size_t)row * 128 + c8); } }
        const float Ms = dv[128 + sl], inter = dv[256 + sl], eneg = dv[384 + sl];
        bf16x4 bS[8]; float rs = 0.f;
#pragma unroll
        for (int jt = 0; jt < 8; ++jt) { const f32x4 a4 = *(const LAS f32x4*)(dv + 16 * jt + 4 * fq); f32x4 v;
#pragma unroll
            for (int jj = 0; jj < 4; ++jj) { const int j = 16 * jt + 4 * fq + jj; const bool keep = d ? (j >= sl) : (j <= sl); v[jj] = keep ? ST[jt][jj] * __expf(a4[jj] - Ms) : 0.f; rs += v[jj]; }
            bS[jt] = to_b4(v); }
        rs += __shfl_xor(rs, 16); rs += __shfl_xor(rs, 32);
        float qn = 0.f; { const float* nd = (const float*)(F.ws + WS_DN) + (size_t)slotd[d] * 128;
#pragma unroll
            for (int ks = 0; ks < 4; ++ks) { float qv[8]; unpack8(__builtin_bit_cast(u32x4, qf[ks]), qv); const f32x4 n0 = *(const f32x4*)(nd + 32 * ks + 8 * fq), n1 = *(const f32x4*)(nd + 32 * ks + 8 * fq + 4);
#pragma unroll
                for (int i = 0; i < 4; ++i) qn += qv[i] * n0[i] + qv[4 + i] * n1[i]; } }
        qn += __shfl_xor(qn, 16); qn += __shfl_xor(qn, 32);
        const float scl = 1.f / fmaxf(fabsf(inter * qn + rs), eneg);
        __syncthreads();
#pragma unroll
        for (int vt = 0; vt < 8; ++vt) {
            f32x4 ai = {0.f, 0.f, 0.f, 0.f}, av = {0.f, 0.f, 0.f, 0.f};
#pragma unroll
            for (int ks = 0; ks < 4; ++ks) ai = __builtin_amdgcn_mfma_f32_16x16x32_bf16(*(const LAS bf16x8*)(L + C3_CIN + (16 * vt + fr) * C3_S + (32 * ks + 8 * fq) * 2), qf[ks], ai, 0, 0, 0);
#pragma unroll
            for (int jt = 0; jt < 8; jt += 2) av = MM2(*(const LAS bf16x4*)(L + C3_VT + (16 * vt + fr) * C3_S + (16 * jt + 4 * fq) * 2), bS[jt], *(const LAS bf16x4*)(L + C3_VT + (16 * vt + fr) * C3_S + (16 * jt + 16 + 4 * fq) * 2), bS[jt + 1], av);
#pragma unroll
            for (int jj = 0; jj < 4; ++jj) hv[vt][jj] += (inter * ai[jj] + av[jj]) * scl;
        }
    }
    float s1 = 0.f, s2 = 0.f;
#pragma unroll
    for (int vt = 0; vt < 8; ++vt)
#pragma unroll
        for (int jj = 0; jj < 4; ++jj) { s1 += hv[vt][jj]; s2 += hv[vt][jj] * hv[vt][jj]; }
    s1 += __shfl_xor(s1, 16); s1 += __shfl_xor(s1, 32); s2 += __shfl_xor(s2, 16); s2 += __shfl_xor(s2, 32);
    const float mean = s1 * (1.f / 128.f), rstd = rsqrtf(fmaxf(s2 * (1.f / 128.f) - mean * mean, 0.f) + 1e-5f);
#pragma unroll
    for (int vt = 0; vt < 8; ++vt) { const int c = h * 128 + 16 * vt + 4 * fq;
        const u32x2 ow = *(const u32x2*)((const bf16_t*)(F.ws + WS_Z2) + tok * Z2C + Z2_O + c); const f32x4 gg = *(const f32x4*)(a.in[I_MGNG] + c);
        const float o4[4] = {bf2f(ow.x & 0xffffu), bf2f(ow.x >> 16), bf2f(ow.y & 0xffffu), bf2f(ow.y >> 16)};
        u32x2 o; o.x = cvt_pk((hv[vt][0] - mean) * rstd * gg[0] * sigm(o4[0]), (hv[vt][1] - mean) * rstd * gg[1] * sigm(o4[1]));
        o.y = cvt_pk((hv[vt][2] - mean) * rstd * gg[2] * sigm(o4[2]), (hv[vt][3] - mean) * rstd * gg[3] * sigm(o4[3]));
        *(u32x2*)((bf16_t*)(F.ws + WS_YMB) + tok * 512 + c) = o; }
}
template <int EPT  , int NCH, int PF>
__device__ __forceinline__ void mlstm_prop_t(Frame& F, int s, int dir, int h, int slice) {
    const Args& a = *F.a;
    const int tid = F.tid, e0 = slice * (512 * EPT) + tid * EPT;
    const int slot0 = m_slot(s, dir, h, 0);
    float* MSp = (float*)(F.ws + WS_MS); float* DNp = (float*)(F.ws + WS_DN);
    LAS float* sc = (LAS float*)F.lds;
    __syncthreads();
    if (F.wave == 0) {
        float mx = 0.f, bL = 0.f; if (F.lane < NCH) { mx = MSp[(size_t)(slot0 + F.lane) * 4]; bL = MSp[(size_t)(slot0 + F.lane) * 4 + 1]; }
        float m = s >= 16 ? a.in[I_SM][((size_t)(s - 16) * 2 + dir) * 4 + h] : 0.f;
        for (int c = 0; c < NCH; ++c) { const float mxc = __shfl(mx, c), blc = __shfl(bL, c), Mf = fmaxf(m, mxc);
            if (F.lane == 0) { sc[2 * c] = __expf(m - Mf); sc[2 * c + 1] = __expf(mxc - Mf); if (slice == 0) MSp[(size_t)(slot0 + c) * 4 + 2] = m; }
            m = blc + Mf; }
        if (F.lane == 0 && slice == 0 && s < 16) F.out[OUT_SM + ((size_t)s * 2 + dir) * 4 + h] = m;
    }
    __syncthreads();
    float Cf[EPT];
    if (s >= 16) { const float* c0 = a.in[I_SC] + (((size_t)(s - 16) * 2 + dir) * 4 + h) * 16384 + e0;
#pragma unroll
        for (int i = 0; i < EPT / 4; ++i) { const f32x4 v = *(const f32x4*)(c0 + 4 * i); Cf[4 * i] = v.x; Cf[4 * i + 1] = v.y; Cf[4 * i + 2] = v.z; Cf[4 * i + 3] = v.w; }
    } else {
#pragma unroll
        for (int i = 0; i < EPT; ++i) Cf[i] = 0.f;
    }
    u32x2 ring[PF][EPT / 4];
#pragma unroll
    for (int u = 0; u < PF; ++u) { const bf16_t* dc = dc_ptr(F.ws, slot0 + u) + e0;
#pragma unroll
        for (int i = 0; i < EPT / 4; ++i) ring[u][i] = *(const u32x2*)(dc + 4 * i); }
    for (int c0 = 0; c0 < NCH; c0 += PF) {
#pragma unroll
        for (int u = 0; u < PF; ++u) { const int c = c0 + u; bf16_t* dcw = dc_ptr(F.ws, slot0 + c) + e0; const float e1 = sc[2 * c], e2 = sc[2 * c + 1];
#pragma unroll
            for (int i = 0; i < EPT / 4; ++i) { const u32x2 d = ring[u][i];
                u32x2 o; o.x = cvt_pk(Cf[4 * i], Cf[4 * i + 1]); o.y = cvt_pk(Cf[4 * i + 2], Cf[4 * i + 3]); *(u32x2*)(dcw + 4 * i) = o;
                Cf[4 * i] = e1 * Cf[4 * i] + e2 * bf2f(d.x & 0xffffu); Cf[4 * i + 1] = e1 * Cf[4 * i + 1] + e2 * bf2f(d.x >> 16);
                Cf[4 * i + 2] = e1 * Cf[4 * i + 2] + e2 * bf2f(d.y & 0xffffu); Cf[4 * i + 3] = e1 * Cf[4 * i + 3] + e2 * bf2f(d.y >> 16); }
            { const int cn = c + PF < NCH ? c + PF : NCH - 1; const bf16_t* dc = dc_ptr(F.ws, slot0 + cn) + e0;
#pragma unroll
                for (int i = 0; i < EPT / 4; ++i) ring[u][i] = *(const u32x2*)(dc + 4 * i); }
        }
    }
    if (slice == 0 && tid < 128) {
        float nf = s >= 16 ? a.in[I_SN][(((size_t)(s - 16) * 2 + dir) * 4 + h) * 128 + tid] : 0.f;
        float dn[NCH];
#pragma unroll
        for (int c = 0; c < NCH; ++c) dn[c] = DNp[(size_t)(slot0 + c) * 128 + tid];
#pragma unroll
        for (int c = 0; c < NCH; ++c) { DNp[(size_t)(slot0 + c) * 128 + tid] = nf; nf = sc[2 * c] * nf + sc[2 * c + 1] * dn[c]; }
        if (s < 16) F.out[OUT_SN + (((size_t)s * 2 + dir) * 4 + h) * 128 + tid] = nf;
    }
    if (s < 16) { float* co = F.out + OUT_SC + (((size_t)s * 2 + dir) * 4 + h) * 16384 + e0;
#pragma unroll
        for (int i = 0; i < EPT / 4; ++i) *(f32x4*)(co + 4 * i) = (f32x4){Cf[4 * i], Cf[4 * i + 1], Cf[4 * i + 2], Cf[4 * i + 3]}; }
}
__device__ __forceinline__ void p8_rows(Frame& F) {
    const Args& a = *F.a; const float* ng = a.in[I_NORMG];
    for (int row = F.gw; row < NTOK; row += F.NGW) {
        const f32x4* xr = (const f32x4*)xrow_ptr(a, row) + F.lane; const u32x2* orow = (const u32x2*)((const bf16_t*)(F.ws + WS_OUT1) + (size_t)row * D) + F.lane;
        const float* mod = (const float*)(F.ws + WS_MOD) + cond_of(row) * 6144;
        f32x4 v[4]; float ss = 0.f;
#pragma unroll
        for (int j = 0; j < 4; ++j) { const u32x2 p0 = orow[64 * j], p1 = orow[64 * j + (size_t)NTOK * D / 4];
            v[j] = (f32x4){bf2f(p0.x & 0xffffu) + bf2f(p1.x & 0xffffu), bf2f(p0.x >> 16) + bf2f(p1.x >> 16), bf2f(p0.y & 0xffffu) + bf2f(p1.y & 0xffffu), bf2f(p0.y >> 16) + bf2f(p1.y >> 16)};
            ss += (v[j].x * v[j].x + v[j].y * v[j].y) + (v[j].z * v[j].z + v[j].w * v[j].w); }
        const float rstd = rsqrtf(wave_sum(ss) * (1.f / D) + 1e-6f);
        u32x2* x1o = (u32x2*)((bf16_t*)(F.ws + WS_X1B) + (size_t)row * D) + F.lane; ss = 0.f;
#pragma unroll
        for (int j = 0; j < 4; ++j) { const int col = 4 * (64 * j + F.lane);
            const f32x4 g = *(const f32x4*)(ng + 1024 + col), g1 = *(const f32x4*)(mod + 2048 + col);
            v[j] = xr[64 * j] + g1 * (v[j] * rstd * g); { u32x2 w; w.x = cvt_pk(v[j].x, v[j].y); w.y = cvt_pk(v[j].z, v[j].w); x1o[64 * j] = w; }
            ss += (v[j].x * v[j].x + v[j].y * v[j].y) + (v[j].z * v[j].z + v[j].w * v[j].w); }
        const float rstd2 = rsqrtf(wave_sum(ss) * (1.f / D) + 1e-6f);
        u32x2* o = (u32x2*)((bf16_t*)(F.ws + WS_H) + (size_t)row * D) + F.lane;
#pragma unroll
        for (int j = 0; j < 4; ++j) { const int col = 4 * (64 * j + F.lane);
            const f32x4 g = *(const f32x4*)(ng + 2048 + col), sh = *(const f32x4*)(mod + 3072 + col), sc = *(const f32x4*)(mod + 4096 + col);
            const f32x4 h = v[j] * rstd2 * g * (sc + 1.f) + sh;
            u32x2 w; w.x = pk2(h.x, h.y); w.y = pk2(h.z, h.w); o[64 * j] = w; }
    }
}

template <int NT>
__device__ __forceinline__ void p10_item(Frame& F, int tok0, int c8) {
    const Args& a = *F.a;
    const bf16_t* U = (const bf16_t*)(F.ws + WS_Z); bf16_t* FIN = (bf16_t*)(F.ws + WS_FIN);
    const int uc = 256 * (c8 >> 7) + (c8 & 127);
    const int t0 = (tok0 - NCTX) & 2047, y = t0 >> 6, x0 = t0 & 63;
    const float* cw = a.in[I_FCONV] + c8;
    u32x4 vraw[NT];
#pragma unroll
    for (int jj = 0; jj < NT; ++jj) vraw[jj] = *(const u32x4*)(U + (size_t)(tok0 + jj) * UPC + uc + 128);
    float acc[NT][8];
    { const f32x4 b0 = *(const f32x4*)(a.in[I_FCB] + c8), b1 = *(const f32x4*)(a.in[I_FCB] + c8 + 4);
#pragma unroll
        for (int jj = 0; jj < NT; ++jj) { acc[jj][0] = b0[0]; acc[jj][1] = b0[1]; acc[jj][2] = b0[2]; acc[jj][3] = b0[3]; acc[jj][4] = b1[0]; acc[jj][5] = b1[1]; acc[jj][6] = b1[2]; acc[jj][7] = b1[3]; } }
#pragma unroll 1
    for (int dy = -1; dy <= 1; ++dy) {
        const bool rowok = y + dy >= 0 && y + dy < 32;
        if (!rowok) continue;
        float wt[3][8];
#pragma unroll
        for (int dx = 0; dx < 3; ++dx) { const f32x4 w0 = *(const f32x4*)(cw + ((dy + 1) * 3 + dx) * DFF), w1 = *(const f32x4*)(cw + ((dy + 1) * 3 + dx) * DFF + 4);
#pragma unroll
            for (int e = 0; e < 4; ++e) { wt[dx][e] = w0[e]; wt[dx][4 + e] = w1[e]; } }
#pragma unroll
        for (int i = 0; i < NT + 2; ++i) { const int xx = x0 - 1 + i; const bool ok = xx >= 0 && xx < 64;
            float xv[8]; unpack8(*(const u32x4*)(U + ((long)(tok0 + dy * 64) + (i - 1)) * UPC + uc), xv);
            const float cm = ok ? 1.f : 0.f;
#pragma unroll
            for (int dx = -1; dx <= 1; ++dx) { const int jj = i - 1 - dx;
                if (jj >= 0 && jj < NT) {
#pragma unroll
                    for (int e = 0; e < 8; ++e) acc[jj][e] += (wt[dx + 1][e] * cm) * xv[e]; } }
        }
    }
#pragma unroll
    for (int jj = 0; jj < NT; ++jj) { float x[8]; unpack8(vraw[jj], x);
        u32x4 o; o.x = cvt_pk(silu(acc[jj][0]) * x[0], silu(acc[jj][1]) * x[1]); o.y = cvt_pk(silu(acc[jj][2]) * x[2], silu(acc[jj][3]) * x[3]);
        o.z = cvt_pk(silu(acc[jj][4]) * x[4], silu(acc[jj][5]) * x[5]); o.w = cvt_pk(silu(acc[jj][6]) * x[6], silu(acc[jj][7]) * x[7]);
        *(u32x4*)(FIN + (size_t)(tok0 + jj) * DFF + c8) = o; }
}
__device__ __forceinline__ void p10_ffn_conv(Frame& F) {
    const int t = (int)blockIdx.x * 512 + F.tid;
    { const int sl = t / 352, c8 = (t - sl * 352) * 8; p10_item<8>(F, NCTX + sl * 8, c8); }
    asm volatile("" ::: "memory"); __builtin_amdgcn_sched_barrier(0);
    if (t < 98304) { const int it = 131072 + (t >> 1), sl = it / 352, c8 = (it - sl * 352) * 8; p10_item<4>(F, NCTX + sl * 8 + 4 * (t & 1), c8); }
}

__device__ __forceinline__ void p12_final(Frame& F) {
    const Args& a = *F.a; const float* ng = a.in[I_NORMG];
    for (int row = F.gw; row < NTOK; row += F.NGW) {
        const u32x2* fr_ = (const u32x2*)((const bf16_t*)(F.ws + WS_Z) + (size_t)row * D) + F.lane; f32x4* xo = (f32x4*)(F.out + (size_t)row * D) + F.lane;
        const float* mod = (const float*)(F.ws + WS_MOD) + cond_of(row) * 6144;
        f32x4 v[4]; float ss = 0.f;
#pragma unroll
        for (int j = 0; j < 4; ++j) { const u32x2 p0 = fr_[64 * j], p1 = fr_[64 * j + (size_t)NTOK * D / 4];
            v[j] = (f32x4){bf2f(p0.x & 0xffffu) + bf2f(p1.x & 0xffffu), bf2f(p0.x >> 16) + bf2f(p1.x >> 16), bf2f(p0.y & 0xffffu) + bf2f(p1.y & 0xffffu), bf2f(p0.y >> 16) + bf2f(p1.y >> 16)}; ss += (v[j].x * v[j].x + v[j].y * v[j].y) + (v[j].z * v[j].z + v[j].w * v[j].w); }
        const float rstd = rsqrtf(wave_sum(ss) * (1.f / D) + 1e-6f);
#pragma unroll
        for (int j = 0; j < 4; ++j) { const int col = 4 * (64 * j + F.lane);
            const f32x4 g = *(const f32x4*)(ng + 3072 + col), g2 = *(const f32x4*)(mod + 5120 + col);
            const u32x2 xw = ((const u32x2*)((const bf16_t*)(F.ws + WS_X1B) + (size_t)row * D) + F.lane)[64 * j];
            const f32x4 x1 = {bf2f(xw.x & 0xffffu), bf2f(xw.x >> 16), bf2f(xw.y & 0xffffu), bf2f(xw.y >> 16)};
            xo[64 * j] = x1 + g2 * (v[j] * rstd * g); }
    }
}

__global__ void __launch_bounds__(512, 2) trunk_fwd(Args args) {
    extern __shared__ __attribute__((aligned(16))) unsigned char lds_raw[];
    Frame F;
    F.lds = (LAS unsigned char*)lds_raw; F.a = &args;
    F.tid = threadIdx.x; F.lane = F.tid & 63; F.wave = __builtin_amdgcn_readfirstlane(F.tid >> 6);
    F.G = gridDim.x; { const int bx = blockIdx.x; F.vcu = (F.G % 8 == 0) ? (bx % 8) * (F.G / 8) + bx / 8 : bx; }
    F.gw = F.vcu * 8 + F.wave; F.NGW = F.G * 8;
    F.ws = args.ws; F.out = args.out;
    volatile LAS unsigned* MISC = (volatile LAS unsigned*)(F.lds + MISC_OFF);
    if (F.tid < 64) MISC[F.tid] = 0u;
    __syncthreads();
    XcdBarrier bar = xcd_barrier_post((unsigned*)(F.ws + WS_CTL) + 4096, MISC + 8);
#ifndef PROBE_MASK
#define PROBE_MASK 0
#endif
#define RELANE() do { int t_ = threadIdx.x; asm volatile("" : "+v"(t_)); F.tid = t_; F.lane = t_ & 63; } while (0)
#define PH(k, ...) do { { RELANE(); __VA_ARGS__ } if (((PROBE_MASK) >> (k)) & 1) { xcd_barrier(bar); { RELANE(); __VA_ARGS__ } } if ((k) != NPH - 1) xcd_barrier(bar); } while (0)
    PH(0, p0_prologue(F);
        if (F.tid == 0) { unsigned sp = 0; unsigned* cnt = (unsigned*)(F.ws + WS_CTL) + 1024;
            while (__hip_atomic_load(cnt, __ATOMIC_RELAXED, __HIP_MEMORY_SCOPE_AGENT) < 96u) { __builtin_amdgcn_s_sleep(2); if (++sp > (1u << 22)) break; }
            __builtin_amdgcn_fence(__ATOMIC_ACQUIRE, "agent"); asm volatile("s_waitcnt vmcnt(0)" ::: "memory"); }
        __syncthreads();
        p1_h1(F););
    PH(1, const pg8::Gemm g{D, D, D}; pg8::StaticOrder S; S.init(NTOK, ZC, 1, F.G, (int)blockIdx.x, g, (const bf16_t*)(F.ws + WS_H), (const bf16_t*)(F.ws + WS_WIN), nullptr, nullptr);
        pg8::EpiBf16 E{(bf16_t*)(F.ws + WS_Z1), Z1C, (bf16_t*)(F.ws + WS_Z2), 12}; pg8::gemm_phase(F.lds, g, S, E, F.tid););
#ifndef PROBE_XBAR
#define PROBE_XBAR 0
#endif
    for (int xb_ = 0; xb_ < PROBE_XBAR; ++xb_) xcd_barrier(bar);
    PH(2, p3_prep(F););
#ifndef PROBE_P3
#define PROBE_P3 0
#endif
    if (PROBE_P3) { RELANE(); p3_prep<(PROBE_P3 ? PROBE_P3 : 7)>(F); xcd_barrier(bar); }
    PH(3, mlstm_passA(F, (int)blockIdx.x); __syncthreads(); { const int u = (int)blockIdx.x * 8 + F.wave; rwkv_pass1(F, u); });
#ifndef PROBE_P1
#define PROBE_P1 (-1)
#endif
    if (PROBE_P1 >= 0) { RELANE(); const int u = (int)blockIdx.x * 8 + F.wave; rwkv_pass1<(PROBE_P1 < 0 ? 0 : PROBE_P1)>(F, u); xcd_barrier(bar); }
    PH(4, const int bi = blockIdx.x;
        if (bi < 128) { const int u = bi >> 3; mlstm_prop_t<4, 16, 8>(F, 16 + (u >> 3), (u >> 2) & 1, u & 3, bi & 7); rwkv_prop_lat(F, (((bi & 7) * 4 + (bi >> 5)) << 2) | ((bi >> 3) & 3)); }
        else { const int v = bi - 128; mlstm_prop_t<32, 2, 2>(F, v >> 3, (v >> 2) & 1, v & 3, 0); rwkv_prop(F, 128 + v * 8 + F.wave); });
    PH(5, { mlstm_passC3(F, (int)blockIdx.x); rwkv_fix(F, (int)blockIdx.x * 8 + F.wave); });
    PH(6, const pg8::Gemm g{512, 512, 512}; pg8::StaticOrder S;
        S.init(NTOK, D, 2, F.G, (int)blockIdx.x, g, (const bf16_t*)(F.ws + WS_YRB), (const bf16_t*)(F.ws + WS_WBR), (const bf16_t*)(F.ws + WS_YMB), (const bf16_t*)(F.ws + WS_WBM));
        pg8::EpiGate E{(bf16_t*)(F.ws + WS_PRM), (const bf16_t*)(F.ws + WS_Z2), Z2_GR}; pg8::gemm_phase(F.lds, g, S, E, F.tid););
    PH(7, const pg8::Gemm g{D, D, D}; pg8::StaticOrder S;
        S.init(NTOK, D, 2, F.G, (int)blockIdx.x, g, (const bf16_t*)(F.ws + WS_PRM), (const bf16_t*)(F.ws + WS_WOUT), (const bf16_t*)(F.ws + WS_PRM) + (size_t)NTOK * D, (const bf16_t*)(F.ws + WS_WOUT));
        pg8::EpiBf16 E{(bf16_t*)(F.ws + WS_OUT1), D, (bf16_t*)(F.ws + WS_OUT1), 1 << 20}; pg8::gemm_phase(F.lds, g, S, E, F.tid););
    PH(8, p8_rows(F););
    PH(9, const pg8::Gemm g{D, D, D}; pg8::StaticOrder S; S.init(NTOK, UPC, 1, F.G, (int)blockIdx.x, g, (const bf16_t*)(F.ws + WS_H), (const bf16_t*)(F.ws + WS_WUP), nullptr, nullptr);
        pg8::EpiFfnUp E{(bf16_t*)(F.ws + WS_Z), (bf16_t*)(F.ws + WS_FIN), F.a->in[I_FCONV], F.a->in[I_FCB], (LAS float*)(F.lds + 131072)}; pg8::gemm_phase(F.lds, g, S, E, F.tid);
        if (blockIdx.x >= 192) { LAS float* scr = (LAS float*)(F.lds + F.wave * 8448);
            for (int it = ((int)blockIdx.x - 192) * 8 + F.wave; it < 44 * 32; it += 512) transpose_item(0, F.a->in[I_FDN], 2816, 1024, (bf16_t*)(F.ws + WS_WDN), 32, scr, it, F.lane); });
    PH(10, p10_ffn_conv(F););
    PH(11, const pg8::Gemm g{DFF / 2, DFF, DFF}; pg8::StaticOrder S;
        S.init(NTOK, D, 2, F.G, (int)blockIdx.x, g, (const bf16_t*)(F.ws + WS_FIN), (const bf16_t*)(F.ws + WS_WDN), (const bf16_t*)(F.ws + WS_FIN) + DFF / 2, (const bf16_t*)(F.ws + WS_WDN) + DFF / 2);
        pg8::EpiBf16 E{(bf16_t*)(F.ws + WS_Z), D, (bf16_t*)(F.ws + WS_Z), 1 << 20}; pg8::gemm_phase(F.lds, g, S, E, F.tid););
    PH(12, p12_final(F););
#undef PH
}

extern "C" void kernel_launch(void* const* d_in, const int* in_sizes, int n_in, void* d_out, int out_size, void* d_ws, size_t ws_size, hipStream_t stream) {
    if (n_in != 33 || (size_t)out_size != OUT_TOTAL || ws_size < WS_END) {
        fprintf(stderr, "kernel_launch: unexpected problem (n_in %d, out %d, ws %zu)\n", n_in, out_size, ws_size); return; }
    (void)hipFuncSetAttribute((const void*)trunk_fwd, hipFuncAttributeMaxDynamicSharedMemorySize, LDS_BYTES);
    (void)hipMemsetAsync((char*)d_ws + WS_CTL, 0, CTL_ZERO_BYTES, stream);
    Args a{};
    for (int i = 0; i < 33; ++i) a.in[i] = (const float*)d_in[i];
    a.out = (float*)d_out; a.ws = (unsigned char*)d_ws;
    a.ph_lo = 0; a.ph_hi = NPH;
    hipLaunchKernelGGL(trunk_fwd, dim3(256), dim3(512), LDS_BYTES, stream, a);
}
```

```cpp
#include <hip/hip_runtime.h>
#include <cstdio>
#include <cstdint>

#define GAS __attribute__((address_space(1)))
#define LAS __attribute__((address_space(3)))
typedef unsigned short bf16_t;
typedef short bf16x8 __attribute__((ext_vector_type(8)));
typedef float f32x4 __attribute__((ext_vector_type(4)));
typedef float f32x2 __attribute__((ext_vector_type(2)));
typedef unsigned u32x4 __attribute__((ext_vector_type(4)));
typedef unsigned u32x2 __attribute__((ext_vector_type(2)));

#ifndef MK_ONE_LAUNCH
#define MK_ONE_LAUNCH 1
#endif

constexpr int D = 1024, NTOK = 8192, NCTX = 4096;
constexpr int ZC = 6144;
constexpr int DFF = 2816, UPC = 5632;
constexpr int NPH = 13;
constexpr int ZR_R = 0, ZR_K = 512, ZR_V = 1024, ZR_WD = 1536, ZR_AD = 1664, ZR_GD = 1792;
constexpr int Z1C = 3072, Z2C = 3072;
constexpr int ZM_Q = 1920, ZM_K = 2432, ZM_G = 2944;
constexpr int Z2_V = 0, Z2_O = 512, Z2_GR = 1024, Z2_GM = 2048;

constexpr size_t MiB = 1u << 20;
constexpr size_t WS_CTL = 0, CTL_ZERO_BYTES = 64 * 1024;
constexpr size_t WS_MOD = 1 * MiB;
constexpr size_t WS_LI = 1 * MiB + 256 * 1024;
constexpr size_t WS_LF = 1 * MiB + 512 * 1024;
constexpr size_t WS_BON = 1 * MiB + 768 * 1024;
constexpr size_t WS_WIN = 2 * MiB;
constexpr size_t WS_WBR = 14 * MiB;
constexpr size_t WS_WBM = 15 * MiB;
constexpr size_t WS_WOUT = 16 * MiB;
constexpr size_t WS_WUP = 18 * MiB;
constexpr size_t WS_WDN = 29 * MiB;
constexpr size_t WS_H = 35 * MiB;
constexpr size_t WS_Z = 51 * MiB;
constexpr size_t WS_Z1 = WS_Z, WS_Z2 = WS_Z + 48 * MiB;
constexpr size_t WS_P = 147 * MiB;
constexpr size_t WS_PR = WS_P, WS_PV = WS_P + 8 * MiB, WS_PKK = WS_P + 16 * MiB;
constexpr size_t WS_PW = WS_P + 24 * MiB, WS_PKD = WS_P + 40 * MiB, WS_PB = WS_P + 56 * MiB;
constexpr size_t WS_PG = WS_P + 72 * MiB;
constexpr size_t WS_YRB = WS_P, WS_YMB = WS_P + 16 * MiB;
constexpr size_t WS_FIN = WS_P;
constexpr size_t WS_MQ = 227 * MiB, WS_MK = 235 * MiB;
constexpr size_t WS_DCC = WS_Z1 + 32 * MiB;
constexpr size_t WS_DCL = WS_H;
constexpr size_t WS_PRM = WS_Z1;
constexpr size_t WS_OUT1 = WS_P;
constexpr size_t WS_X1B = WS_P + 64 * MiB;
constexpr size_t WS_SP = WS_Z1;
constexpr size_t WS_DN = 243 * MiB;
constexpr size_t WS_MS = 243 * MiB + 512 * 1024;
constexpr size_t WS_WUPT = 243 * MiB + 576 * 1024, WS_AUPT = WS_WUPT + 131072, WS_GUPT = WS_WUPT + 262144;
constexpr size_t WS_END = 244 * MiB;
constexpr size_t OUT_YP = 0, OUT_SR = 8388608, OUT_SC = OUT_SR + 1048576, OUT_SN = OUT_SC + 2097152, OUT_SM = OUT_SN + 16384, OUT_TOTAL = OUT_SM + 128;

constexpr int LDS_BYTES = 163840;
constexpr int MISC_OFF = LDS_BYTES - 256;

#define LDS_WAIT() asm volatile("s_waitcnt lgkmcnt(0)" ::: "memory")
#define VM_WAIT() asm volatile("s_waitcnt vmcnt(0)" ::: "memory")

__device__ __forceinline__ float bf2f(unsigned v) { return __builtin_bit_cast(float, v << 16); }
__device__ __forceinline__ unsigned f2bf(float f) { unsigned u = __builtin_bit_cast(unsigned, f); return (u + 0x7fffu + ((u >> 16) & 1u)) >> 16; }
typedef __bf16 bf16v2_t __attribute__((ext_vector_type(2)));
__device__ __forceinline__ unsigned cvt_pk(float lo, float hi) { const f32x2 v = {lo, hi}; return __builtin_bit_cast(unsigned, __builtin_convertvector(v, bf16v2_t)); }
__device__ __forceinline__ unsigned pk2(float lo, float hi) { return cvt_pk(lo, hi); }
__device__ __forceinline__ void st16_wt(void* p, const u32x4 v) { asm volatile("global_store_dwordx4 %0, %1, off sc1\n\ts_nop 1" :: "v"(p), "v"(v) : "memory"); }
__device__ __forceinline__ float sigm(float x) { return __builtin_amdgcn_rcpf(1.f + __expf(-x)); }
__device__ __forceinline__ float silu(float x) { return x * __builtin_amdgcn_rcpf(1.f + __expf(-x)); }
__device__ __forceinline__ float wave_sum(float v) {
#pragma unroll
    for (int o = 1; o < 64; o <<= 1) v += __shfl_xor(v, o);
    return v;
}
__device__ __forceinline__ void unpack8(const u32x4 w, float (&f)[8]) {
    f[0] = bf2f(w.x & 0xffffu); f[1] = bf2f(w.x >> 16); f[2] = bf2f(w.y & 0xffffu); f[3] = bf2f(w.y >> 16);
    f[4] = bf2f(w.z & 0xffffu); f[5] = bf2f(w.z >> 16); f[6] = bf2f(w.w & 0xffffu); f[7] = bf2f(w.w >> 16);
}
__device__ __forceinline__ u32x4 pack8(const float (&f)[8]) { u32x4 w; w.x = pk2(f[0], f[1]); w.y = pk2(f[2], f[3]); w.z = pk2(f[4], f[5]); w.w = pk2(f[6], f[7]); return w; }

#define XB_TMO      128
#define XB_XCNT(j)  (256  + 64 * (j))
#define XB_XSUB(j)  (1280 + 64 * (j))
#define XB_XGEN(j)  (2304 + 64 * (j))
#define XB_TOP      3328
#define XB_TOPGEN   3392
#define XCD_BAR_WORDS 3456
#define XB_SPIN_CAP (1u << 22)
__device__ __forceinline__ unsigned xb_ld(unsigned* p)              { return __hip_atomic_load(p, __ATOMIC_RELAXED, __HIP_MEMORY_SCOPE_AGENT); }
__device__ __forceinline__ unsigned xb_add(unsigned* p, unsigned v) { return __hip_atomic_fetch_add(p, v, __ATOMIC_RELAXED, __HIP_MEMORY_SCOPE_AGENT); }
__device__ __forceinline__ unsigned xb_xcc_id() { return (unsigned)__builtin_amdgcn_s_getreg((3 << 11) | 20) & 0xFu; }
#define XB_SPIN(cond, bar) do { unsigned _sp = 0; while (cond) { __builtin_amdgcn_s_sleep(1); \
    if ((++_sp & 255u) == 0u) { if (xb_ld(&(bar)[XB_TMO])) break; if (_sp > XB_SPIN_CAP) { atomicAdd(&(bar)[XB_TMO], 1u); break; } } } } while (0)
struct XcdBarrier { unsigned* bar; unsigned x; volatile LAS unsigned* st; };
__device__ __forceinline__ XcdBarrier xcd_barrier_post(unsigned* bar, volatile LAS unsigned* st) {
    XcdBarrier b; b.bar = bar; b.x = xb_xcc_id(); b.st = st;
    if (threadIdx.x == 0) (void)xb_add(&bar[XB_XCNT(b.x)], 1u);
    return b;
}
__device__ __forceinline__ void xcd_barrier_complete(unsigned* bar, unsigned x, unsigned& nloc, unsigned& nx) {
    const unsigned G = gridDim.x * gridDim.y * gridDim.z;
    unsigned sum, cnt, mine, sp = 0u;
    for (;;) {
        sum = 0u; cnt = 0u; mine = 0u;
#pragma unroll
        for (unsigned j = 0; j < 16; ++j) { const unsigned c = xb_ld(&bar[XB_XCNT(j)]); sum += c; cnt += (c > 0u) ? 1u : 0u; mine = (j == x) ? c : mine; }
        if (sum == G) break;
        __builtin_amdgcn_s_sleep(1);
        if ((++sp & 255u) == 0u) { if (xb_ld(&bar[XB_TMO])) break; if (sp > XB_SPIN_CAP) { atomicAdd(&bar[XB_TMO], 1u); break; } }
    }
    nloc = mine > 0u ? mine : 1u; nx = cnt > 0u ? cnt : 1u;
}
__device__ __forceinline__ void xcd_barrier(const XcdBarrier& b) {
    asm volatile("s_waitcnt vmcnt(0)" ::: "memory");
    __syncthreads();
    if (threadIdx.x == 0) {
        unsigned* bar = b.bar;
        __builtin_amdgcn_s_waitcnt(0);
        unsigned nloc = b.st[0], nx = b.st[1];
        if (nloc == 0u) { xcd_barrier_complete(bar, b.x, nloc, nx); b.st[0] = nloc; b.st[1] = nx; }
        const unsigned old = xb_add(&bar[XB_XSUB(b.x)], 1u);
        const unsigned gen = old / nloc;
        if (old + 1u == (gen + 1u) * nloc) {
            __builtin_amdgcn_fence(__ATOMIC_RELEASE, "agent");
            asm volatile("s_waitcnt vmcnt(0)" ::: "memory");
            const unsigned og = xb_add(&bar[XB_TOP], 1u);
            const unsigned tg = og / nx;
            if (og + 1u == (tg + 1u) * nx) {
#pragma unroll
                for (unsigned j = 0; j < 16; ++j) (void)__hip_atomic_fetch_add(&bar[XB_XGEN(j)], 1u, __ATOMIC_RELAXED, __HIP_MEMORY_SCOPE_AGENT);
            } else XB_SPIN(xb_ld(&bar[XB_XGEN(b.x)]) == gen, bar);
            __builtin_amdgcn_fence(__ATOMIC_ACQUIRE, "agent");
            asm volatile("s_waitcnt vmcnt(0)" ::: "memory");
        } else {
            XB_SPIN(xb_ld(&bar[XB_XGEN(b.x)]) == gen, bar);
            __builtin_amdgcn_fence(__ATOMIC_ACQUIRE, "agent");
            asm volatile("s_waitcnt vmcnt(0)" ::: "memory");
        }
    }
    __syncthreads();
}

__device__ __forceinline__ float dpp_ror1(float v) { return __builtin_bit_cast(float, __builtin_amdgcn_update_dpp(0, __builtin_bit_cast(int, v), 0x121, 0xF, 0xF, false)); }
__device__ __forceinline__ float dpp_rol1(float v) { return __builtin_bit_cast(float, __builtin_amdgcn_update_dpp(0, __builtin_bit_cast(int, v), 0x12F, 0xF, 0xF, false)); }
namespace pg8 {
constexpr int BM = 256, BK = 64, HALF = 128, HTB = HALF * BK * 2, STAGE_BYTES = 8 * HTB, NXCD = 8, WGM = 8;
__host__ __device__ __forceinline__ int lds_byte(int r, int c) { const int st = (r >> 4) * 2 + (c >> 5), rr = r & 15, cc = c & 31, ob = rr * 64 + cc * 2; return st * 1024 + (ob ^ (((ob >> 9) & 1) << 5)); }
__host__ __device__ __forceinline__ void stage_rc(int b, int& R, int& C) { const int st = b / 1024, sb = b % 1024, swz = sb ^ (((sb >> 9) & 1) << 5); R = (st >> 1) * 16 + swz / 64; C = (st & 1) * 32 + (swz % 64) / 2; }
__host__ __device__ __forceinline__ int perm32(int rho) { const int n = rho >> 4, i = rho & 15; return 8 * (i >> 2) + 4 * n + (i & 3); }
struct Unit { const char* a; const char* b; int pm, pn, z; };
struct Gemm { int K, lda, ldb; };
struct StaticOrder {
    int nM, nN, nZ, nwg, G, c, lda, ldb; const bf16_t* Az[2]; const bf16_t* Bz[2];
    __device__ void init(int M, int N, int nZ_, int G_, int c_, const Gemm& g, const bf16_t* A0, const bf16_t* B0, const bf16_t* A1, const bf16_t* B1) {
        nM = M / BM; nZ = nZ_; nN = (N / BM) * nZ_; nwg = nM * nN; G = G_; c = c_; lda = g.lda; ldb = g.ldb; Az[0] = A0; Az[1] = A1; Bz[0] = B0; Bz[1] = B1; }
    __device__ bool next(int i, Unit& u) const {
        const long L = (long)i * G + c; if (L >= nwg) return false;
        int wgid = (int)L; { const int q = nwg / NXCD, r = nwg % NXCD, xcd = wgid % NXCD, off = wgid / NXCD; wgid = (xcd < r ? xcd * (q + 1) : r * (q + 1) + (xcd - r) * q) + off; }
        const int nig = WGM * nN, gid = wgid / nig, fm = gid * WGM, gsz = (nM - fm) < WGM ? (nM - fm) : WGM;
        u.pm = fm + ((wgid % nig) % gsz); const int pnz = (wgid % nig) / gsz; u.pn = pnz / nZ; u.z = pnz - u.pn * nZ;
        u.a = (const char*)(u.z ? Az[1] : Az[0]) + (size_t)u.pm * BM * lda * 2; u.b = (const char*)(u.z ? Bz[1] : Bz[0]) + (size_t)u.pn * BM * ldb * 2; return true;
    }
};

struct EpiBf16 {
    static constexpr bool PERM = true;
    bf16_t* O; int ldc; bf16_t* O2; int split_pn;
    __device__ __forceinline__ void operator()(const f32x4 (&acc)[2][2][4][2], const Unit& u, int wr, int wc, int fr, int fq) const {
        const bool hi = u.pn >= split_pn; bf16_t* Ob = (hi ? O2 : O) + (size_t)u.z * NTOK * ldc;
        const int row0 = u.pm * BM + wr * 64 + fr, col0 = (hi ? u.pn - split_pn : u.pn) * BM + wc * 32 + 8 * fq;
#pragma unroll
        for (int ai = 0; ai < 2; ++ai)
#pragma unroll
            for (int m = 0; m < 4; ++m) { bf16_t* rowp = Ob + (size_t)(row0 + ai * HALF + m * 16) * ldc + col0;
#pragma unroll
                for (int bj = 0; bj < 2; ++bj) { const f32x4 v0 = acc[ai][bj][m][0], v1 = acc[ai][bj][m][1];
                    u32x4 w; w.x = pk2(v0[0], v0[1]); w.y = pk2(v0[2], v0[3]); w.z = pk2(v1[0], v1[1]); w.w = pk2(v1[2], v1[3]);
                    st16_wt(rowp + bj * HALF, w); } }
    }
};
struct EpiGate {
    static constexpr bool PERM = true;
    bf16_t* O; const bf16_t* Z; int gcol0;
    __device__ __forceinline__ void operator()(const f32x4 (&acc)[2][2][4][2], const Unit& u, int wr, int wc, int fr, int fq) const {
        const int row0 = u.pm * BM + wr * 64 + fr, col0 = u.pn * BM + wc * 32 + 8 * fq;
        bf16_t* Ob = O + (size_t)u.z * NTOK * D; const int gc = gcol0 + u.z * D;
#pragma unroll
        for (int ai = 0; ai < 2; ++ai)
#pragma unroll
            for (int m = 0; m < 4; ++m) { const int row = row0 + ai * HALF + m * 16; bf16_t* rowp = Ob + (size_t)row * D + col0; const bf16_t* gp = Z + (size_t)row * Z2C + gc + col0;
#pragma unroll
                for (int bj = 0; bj < 2; ++bj) { const f32x4 v0 = acc[ai][bj][m][0], v1 = acc[ai][bj][m][1];
                    float g[8]; unpack8(*(const u32x4*)(gp + bj * HALF), g);
                    u32x4 w; w.x = cvt_pk(v0[0] * sigm(g[0]), v0[1] * sigm(g[1])); w.y = cvt_pk(v0[2] * sigm(g[2]), v0[3] * sigm(g[3]));
                    w.z = cvt_pk(v1[0] * sigm(g[4]), v1[1] * sigm(g[5])); w.w = cvt_pk(v1[2] * sigm(g[6]), v1[3] * sigm(g[7]));
                    *(u32x4*)(rowp + bj * HALF) = w; } }
    }
};
struct EpiFfnUp {
    static constexpr bool PERM = true;
    bf16_t* U; bf16_t* FIN; const float* cw; const float* cb; LAS float* xch;
    __device__ __forceinline__ void operator()(const f32x4 (&acc)[2][2][4][2], const Unit& u, int wr, int wc, int fr, int fq) const {
        if (u.pm >= NCTX / BM) {
            const int row0 = u.pm * BM + wr * 64 + fr, col0 = u.pn * BM + wc * 32 + 8 * fq;
#pragma unroll
            for (int ai = 0; ai < 2; ++ai)
#pragma unroll
                for (int m = 0; m < 4; ++m) { bf16_t* rowp = U + (size_t)(row0 + ai * HALF + m * 16) * UPC + col0;
#pragma unroll
                    for (int bj = 0; bj < 2; ++bj) { const f32x4 v0 = acc[ai][bj][m][0], v1 = acc[ai][bj][m][1];
                        u32x4 w; w.x = pk2(v0[0], v0[1]); w.y = pk2(v0[2], v0[3]); w.z = pk2(v1[0], v1[1]); w.w = pk2(v1[2], v1[3]);
                        st16_wt(rowp + bj * HALF, w); } }
            return;
        }
        const int cl = wc * 32 + 8 * fq, ch = u.pn * 128 + cl;
#pragma unroll
        for (int ai = 0; ai < 2; ++ai) { const int band = 2 * ai + wr;
            if (fr == 0) { *(LAS f32x4*)(xch + (band * 2 + 0) * 128 + cl) = acc[ai][0][0][0]; *(LAS f32x4*)(xch + (band * 2 + 0) * 128 + cl + 4) = acc[ai][0][0][1]; }
            if (fr == 15) { *(LAS f32x4*)(xch + (band * 2 + 1) * 128 + cl) = acc[ai][0][3][0]; *(LAS f32x4*)(xch + (band * 2 + 1) * 128 + cl + 4) = acc[ai][0][3][1]; } }
        asm volatile("s_waitcnt lgkmcnt(0)" ::: "memory");
        __builtin_amdgcn_s_barrier();
        asm volatile("" ::: "memory"); __builtin_amdgcn_sched_barrier(0);
        float w0[8], w1[8], w2[8], bb[8];
        { const f32x4 a0 = *(const f32x4*)(cw + 3 * DFF + ch), a1 = *(const f32x4*)(cw + 3 * DFF + ch + 4), b0 = *(const f32x4*)(cw + 4 * DFF + ch), b1 = *(const f32x4*)(cw + 4 * DFF + ch + 4);
            const f32x4 c0 = *(const f32x4*)(cw + 5 * DFF + ch), c1 = *(const f32x4*)(cw + 5 * DFF + ch + 4), d0 = *(const f32x4*)(cb + ch), d1 = *(const f32x4*)(cb + ch + 4);
#pragma unroll
            for (int e = 0; e < 4; ++e) { w0[e] = a0[e]; w0[4 + e] = a1[e]; w1[e] = b0[e]; w1[4 + e] = b1[e]; w2[e] = c0[e]; w2[4 + e] = c1[e]; bb[e] = d0[e]; bb[4 + e] = d1[e]; } }
        const int row0 = u.pm * BM + wr * 64 + fr;
#pragma unroll
        for (int ai = 0; ai < 2; ++ai) { const int band = 2 * ai + wr;
            f32x4 ht[2], hb[2];
#pragma unroll
            for (int n = 0; n < 2; ++n) { ht[n] = band > 0 ? *(const LAS f32x4*)(xch + ((band - 1) * 2 + 1) * 128 + cl + 4 * n) : (f32x4){0.f, 0.f, 0.f, 0.f};
                hb[n] = band < 3 ? *(const LAS f32x4*)(xch + ((band + 1) * 2 + 0) * 128 + cl + 4 * n) : (f32x4){0.f, 0.f, 0.f, 0.f}; }
#pragma unroll
            for (int m = 0; m < 4; ++m) { unsigned pk[4];
#pragma unroll
                for (int n = 0; n < 2; ++n) { float o[4];
#pragma unroll
                    for (int e = 0; e < 4; ++e) { const float cur = acc[ai][0][m][n][e];
                        const float rp = dpp_ror1(acc[ai][0][m > 0 ? m - 1 : 0][n][e]), rn = dpp_rol1(acc[ai][0][m < 3 ? m + 1 : 3][n][e]), rc = dpp_ror1(cur), lc = dpp_rol1(cur);
                        const float pt = m > 0 ? rp : ht[n][e], nt_ = m < 3 ? rn : hb[n][e];
                        const float prev = fr > 0 ? rc : pt, next = fr < 15 ? lc : nt_;
                        const float v = bb[4 * n + e] + w0[4 * n + e] * prev + w1[4 * n + e] * cur + w2[4 * n + e] * next;
                        o[e] = silu(v) * acc[ai][1][m][n][e]; }
                    pk[2 * n] = pk2(o[0], o[1]); pk[2 * n + 1] = pk2(o[2], o[3]); }
                u32x4 w; w.x = pk[0]; w.y = pk[1]; w.z = pk[2]; w.w = pk[3];
                st16_wt(FIN + (size_t)(row0 + ai * HALF + m * 16) * DFF + ch, w); } }
    }
};
template <class Epi>
__device__ __forceinline__ void gemm_phase(LAS unsigned char* lds, const Gemm g, const StaticOrder& S, const Epi& E, const int tid) {
    const int wid = __builtin_amdgcn_readfirstlane(tid >> 6), lane = tid & 63, wr = wid >> 2, wc = wid & 3, fr = lane & 15, fq = lane >> 4;
    const int nt = g.K / BK;
    unsigned voffA[2], voffB[2];
#pragma unroll
    for (int i = 0; i < 2; ++i) { int R, C; stage_rc(tid * 16 + i * 8192, R, C); const int Rb = Epi::PERM ? ((R & ~31) + perm32(R & 31)) : R;
        voffA[i] = (unsigned)(R * g.lda + C) * 2u; voffB[i] = (unsigned)(Rb * g.ldb + C) * 2u; }
    const size_t kstep = (size_t)(BK * 2);
    const size_t hstepA = (size_t)HALF * g.lda * 2, hstepB = (size_t)HALF * g.ldb * 2;
    const unsigned ldsw = (unsigned)wid * 1024u;
    const int aoff = lds_byte(wr * 64 + fr, fq * 8), boff = lds_byte(wc * 32 + fr, fq * 8);
#define PG8_SA(b, h) (((b) * 2 + (h)) * HTB)
#define PG8_SB(b, h) ((4 + (b) * 2 + (h)) * HTB)
#define PG8_STAGE(bufoff, gbase, voff) do { _Pragma("unroll") for (int _i = 0; _i < 2; ++_i) \
        __builtin_amdgcn_global_load_lds((const unsigned*)((const char*)(gbase) + (voff)[_i]), (LAS unsigned*)(lds + (bufoff) + ldsw + _i * 8192), 16, 0, 0); } while (0)
#define PG8_LDA(dst, b, h) do { _Pragma("unroll") for (int m = 0; m < 4; ++m) _Pragma("unroll") for (int k = 0; k < 2; ++k) dst[m][k] = *(const LAS bf16x8*)(lds + PG8_SA(b, h) + aoff + m * 2048 + k * 1024); } while (0)
#define PG8_LDB(dst, b, h) do { _Pragma("unroll") for (int n = 0; n < 2; ++n) _Pragma("unroll") for (int k = 0; k < 2; ++k) dst[n][k] = *(const LAS bf16x8*)(lds + PG8_SB(b, h) + boff + n * 2048 + k * 1024); } while (0)
#define PG8_MMA(ai, bj, At, Bt) do { __builtin_amdgcn_s_setprio(1); _Pragma("unroll") for (int m = 0; m < 4; ++m) _Pragma("unroll") for (int n = 0; n < 2; ++n) _Pragma("unroll") for (int k = 0; k < 2; ++k) \
        acc[ai][bj][m][n] = __builtin_amdgcn_mfma_f32_16x16x32_bf16(Bt[n][k], At[m][k], acc[ai][bj][m][n], 0, 0, 0); __builtin_amdgcn_s_setprio(0); } while (0)
#define PG8_WAIT_V(n) asm volatile("s_waitcnt vmcnt(" #n ")" ::: "memory")
#define PG8_WAIT_L(n) asm volatile("s_waitcnt lgkmcnt(" #n ")" ::: "memory")
#define PG8_BAR __builtin_amdgcn_s_barrier()
#define PG8_SCHED __builtin_amdgcn_sched_barrier(0)
    Unit cur, nxt; int ui = 0;
    if (!S.next(0, cur)) return;
    f32x4 acc[2][2][4][2];
#pragma unroll
    for (int a = 0; a < 2; ++a)
#pragma unroll
        for (int b = 0; b < 2; ++b)
#pragma unroll
            for (int m = 0; m < 4; ++m)
#pragma unroll
                for (int n = 0; n < 2; ++n) acc[a][b][m][n] = (f32x4){0.f, 0.f, 0.f, 0.f};
    bf16x8 At[4][2], B0[2][2], B1[2][2];
    const char* cA = cur.a; const char* cB = cur.b;
    PG8_STAGE(PG8_SB(0, 0), cB, voffB); PG8_STAGE(PG8_SB(0, 1), cB + hstepB, voffB); PG8_STAGE(PG8_SA(0, 0), cA, voffA); PG8_STAGE(PG8_SA(0, 1), cA + hstepA, voffA);
    if (wr == 1) PG8_BAR;
    PG8_WAIT_V(2); PG8_BAR;
    PG8_STAGE(PG8_SB(1, 0), cB + kstep, voffB); PG8_STAGE(PG8_SA(1, 0), cA + kstep, voffA); PG8_STAGE(PG8_SB(1, 1), cB + hstepB + kstep, voffB);
    PG8_WAIT_V(6); PG8_BAR;
    for (;;) {
        const bool has_next = S.next(ui + 1, nxt);
        const char* nA = has_next ? nxt.a : cA; const char* nB = has_next ? nxt.b : cB;
        for (int t = 0; t < nt; t += 2) {
            const bool last = (t == nt - 2);
            const char* a1 = cA + (size_t)(t + 1) * kstep;
            const char* a2 = last ? nA : cA + (size_t)(t + 2) * kstep; const char* b2 = last ? nB : cB + (size_t)(t + 2) * kstep;
            const char* a3 = a2 + kstep; const char* b3 = b2 + kstep;
            PG8_LDB(B0, 0, 0); PG8_LDB(B1, 0, 1); PG8_SCHED; PG8_LDA(At, 0, 0); PG8_STAGE(PG8_SA(1, 1), a1 + hstepA, voffA);
            PG8_WAIT_V(8); PG8_WAIT_L(0); PG8_BAR; PG8_MMA(0, 0, At, B0); PG8_MMA(0, 1, At, B1); PG8_BAR; PG8_SCHED;
            PG8_LDA(At, 0, 1); PG8_STAGE(PG8_SB(0, 0), b2, voffB); PG8_STAGE(PG8_SB(0, 1), b2 + hstepB, voffB); PG8_STAGE(PG8_SA(0, 0), a2, voffA);
            PG8_WAIT_V(8); PG8_WAIT_L(0); PG8_BAR; PG8_MMA(1, 0, At, B0); PG8_MMA(1, 1, At, B1); PG8_BAR; PG8_SCHED;
            PG8_LDB(B0, 1, 0); PG8_LDB(B1, 1, 1); PG8_SCHED; PG8_LDA(At, 1, 0); PG8_STAGE(PG8_SA(0, 1), a2 + hstepA, voffA);
            PG8_WAIT_V(8); PG8_WAIT_L(0); PG8_BAR; PG8_MMA(0, 0, At, B0); PG8_MMA(0, 1, At, B1); PG8_BAR; PG8_SCHED;
            PG8_LDA(At, 1, 1); PG8_STAGE(PG8_SB(1, 0), b3, voffB); PG8_STAGE(PG8_SB(1, 1), b3 + hstepB, voffB); PG8_STAGE(PG8_SA(1, 0), a3, voffA);
            PG8_WAIT_V(8); PG8_WAIT_L(0); PG8_BAR; PG8_MMA(1, 0, At, B0); PG8_MMA(1, 1, At, B1); PG8_BAR; PG8_SCHED;
        }
        if (wr == 0) PG8_BAR;
        E(acc, cur, wr, wc, fr, fq);
        if (!has_next) break;
#pragma unroll
        for (int a = 0; a < 2; ++a)
#pragma unroll
            for (int b = 0; b < 2; ++b)
#pragma unroll
                for (int m = 0; m < 4; ++m)
#pragma unroll
                    for (int n = 0; n < 2; ++n) acc[a][b][m][n] = (f32x4){0.f, 0.f, 0.f, 0.f};
        cur = nxt; cA = nA; cB = nB; ++ui;
        if (wr == 1) PG8_BAR;
    }
    PG8_WAIT_V(0);
    PG8_BAR;
#undef PG8_SA
#undef PG8_SB
#undef PG8_STAGE
#undef PG8_LDA
#undef PG8_LDB
#undef PG8_MMA
#undef PG8_WAIT_V
#undef PG8_WAIT_L
#undef PG8_BAR
#undef PG8_SCHED
}
}

struct Args { const float* in[33]; float* out; unsigned char* ws; int ph_lo, ph_hi; };
enum { I_XP = 0, I_XS, I_C, I_SR, I_SC, I_SN, I_SM, I_CCTX, I_ADAW, I_ADAB, I_NORMG, I_WIN, I_MU, I_W0, I_WUP, I_A0, I_AUP, I_GUP, I_KKS, I_KA, I_RK, I_LNG, I_LNB,
       I_MCONV, I_MGB, I_MGNG, I_WBR, I_WBM, I_WOUT, I_FUP, I_FCONV, I_FCB, I_FDN };

struct Frame {
    LAS unsigned char* lds; const Args* a;
    int tid, lane, wave, G, vcu, gw, NGW;
    unsigned char* ws; float* out;
};
__device__ __forceinline__ const float* xrow_ptr(const Args& a, int tok) { return tok < NCTX ? a.in[I_XP] + (size_t)tok * D : a.in[I_XS] + (size_t)(tok - NCTX) * D; }
__device__ __forceinline__ int cond_of(int tok) { return tok < NCTX ? 0 : 1 + ((tok - NCTX) >> 11); }
__device__ __forceinline__ int seq_base(int s) { return s < 16 ? s * 256 : NCTX + (s - 16) * 2048; }
__device__ __forceinline__ int seq_len(int s) { return s < 16 ? 256 : 2048; }

__device__ __forceinline__ int win_col(int n) { return n < 2944 ? n : (n < 2960 ? n + 1024 : (n < 3072 ? 1 << 20 : (n < 4096 ? n - 128 : n - 112))); }
__device__ __forceinline__ int fup_col(int n) { const int t = n >> 8, j = n & 255; return j < 128 ? 128 * t + j : DFF + 128 * t + (j - 128); }
__device__ __forceinline__ void transpose_item(const int REMAP, const float* W, int K, int N, bf16_t* WT, int nblk, LAS float* scr, int item, int lane) {
    const int kb = item / nblk, nb = item % nblk, k0 = 64 * kb, n0 = 32 * nb;
    const int nn = REMAP == 1 ? win_col(n0 + (lane & 31)) : (REMAP == 2 ? fup_col(n0 + (lane & 31)) : n0 + (lane & 31));
#pragma unroll
    for (int i = 0; i < 32; ++i) { const int kk = 2 * i + (lane >> 5); scr[kk * 33 + (lane & 31)] = (nn < N) ? W[(size_t)(k0 + kk) * N + nn] : 0.f; }
    LDS_WAIT(); asm volatile("" ::: "memory");
    const int c = lane & 7;
#pragma unroll
    for (int j = 0; j < 4; ++j) { const int n = (lane >> 3) + 8 * j; const LAS float* s = scr + (8 * c) * 33 + n;
        u32x4 o; o.x = pk2(s[0 * 33], s[1 * 33]); o.y = pk2(s[2 * 33], s[3 * 33]); o.z = pk2(s[4 * 33], s[5 * 33]); o.w = pk2(s[6 * 33], s[7 * 33]);
        *(u32x4*)(WT + (size_t)(n0 + n) * K + k0 + 8 * c) = o; }
    LDS_WAIT(); asm volatile("" ::: "memory");
}
__device__ __forceinline__ void p0_prologue(Frame& F) {
    const Args& a = *F.a;
    if (blockIdx.x < 96) {
        LAS float* sc = (LAS float*)(F.lds + 69632);
        LAS float* part = (LAS float*)(F.lds + 69632 + 12288);
        for (int i = F.tid; i < 3072; i += 512) { const int ci = i >> 10, k = i & 1023; const float cv = ci == 0 ? a.in[I_CCTX][k] : a.in[I_C][(ci - 1) * D + k]; sc[i] = silu(cv); }
        __syncthreads();
        const int col = blockIdx.x * 64 + F.lane; float a0 = 0.f, a1 = 0.f, a2 = 0.f;
        const float* aw = a.in[I_ADAW];
#pragma unroll 64
        for (int k = F.wave * 128; k < F.wave * 128 + 128; ++k) { const float w = aw[(size_t)k * 6144 + col]; a0 += sc[k] * w; a1 += sc[1024 + k] * w; a2 += sc[2048 + k] * w; }
        part[(F.wave * 3 + 0) * 64 + F.lane] = a0; part[(F.wave * 3 + 1) * 64 + F.lane] = a1; part[(F.wave * 3 + 2) * 64 + F.lane] = a2;
        __syncthreads();
        if (F.tid < 192) { const int ci = F.tid >> 6, l = F.tid & 63; float s = a.in[I_ADAB][blockIdx.x * 64 + l];
#pragma unroll
            for (int w = 0; w < 8; ++w) s += part[(w * 3 + ci) * 64 + l];
            ((float*)(F.ws + WS_MOD))[ci * 6144 + blockIdx.x * 64 + l] = s; }
        asm volatile("s_waitcnt vmcnt(0)" ::: "memory");
        __syncthreads();
        if (F.tid == 0) { __builtin_amdgcn_fence(__ATOMIC_RELEASE, "agent"); asm volatile("s_waitcnt vmcnt(0)" ::: "memory");
            (void)__hip_atomic_fetch_add((unsigned*)(F.ws + WS_CTL) + 1024, 1u, __ATOMIC_RELAXED, __HIP_MEMORY_SCOPE_AGENT); }
    }
    LAS float* scr = (LAS float*)(F.lds + F.wave * 8448);
    constexpr int I_1 = 16 * 192, I_2 = 8 * 32, I_3 = 8 * 32, I_4 = 16 * 32, I_5 = 16 * 176, I_6 = 44 * 32;
    constexpr int I_7 = 96;
    constexpr int NITEMS = I_1 + I_2 + I_3 + I_4 + I_5 + I_7;
    const bool adab = blockIdx.x < 96; const int nw = ((int)blockIdx.x - 96) * 8 + F.wave;
    for (int rd = 0; rd < (adab ? 3 : 5); ++rd) {
        const int it = rd < 3 ? rd * 2048 + F.gw : 6144 + (rd - 3) * 1280 + nw; if (it >= NITEMS) break;
        int r = it; const float* W; bf16_t* WT; int K, N, nblk; int remap = 0;
        if (r < I_1) { W = a.in[I_WIN]; K = 1024; N = 6032; WT = (bf16_t*)(F.ws + WS_WIN); nblk = 192; remap = 1; }
        else if ((r -= I_1) < I_2) { W = a.in[I_WBR]; K = 512; N = 1024; WT = (bf16_t*)(F.ws + WS_WBR); nblk = 32; }
        else if ((r -= I_2) < I_3) { W = a.in[I_WBM]; K = 512; N = 1024; WT = (bf16_t*)(F.ws + WS_WBM); nblk = 32; }
        else if ((r -= I_3) < I_4) { W = a.in[I_WOUT]; K = 1024; N = 1024; WT = (bf16_t*)(F.ws + WS_WOUT); nblk = 32; }
        else if ((r -= I_4) < I_5) { W = a.in[I_FUP]; K = 1024; N = 5632; WT = (bf16_t*)(F.ws + WS_WUP); nblk = 176; remap = 2; }
        else if ((r -= I_5) < 32) { const int d = r >> 4; r &= 15; W = a.in[I_WUP] + d * 32768; K = 64; N = 512; WT = (bf16_t*)(F.ws + WS_WUPT) + d * 32768; nblk = 16; }
        else if ((r -= 32) < 32) { const int d = r >> 4; r &= 15; W = a.in[I_AUP] + d * 32768; K = 64; N = 512; WT = (bf16_t*)(F.ws + WS_AUPT) + d * 32768; nblk = 16; }
        else { r -= 32; W = a.in[I_GUP]; K = 128; N = 512; WT = (bf16_t*)(F.ws + WS_GUPT); nblk = 16; }
        transpose_item(remap, W, K, N, WT, nblk, scr, r, F.lane);
    }
}

__device__ __forceinline__ void p1_h1(Frame& F) {
    const Args& a = *F.a; const float* ng = a.in[I_NORMG];
    const bool adab = blockIdx.x < 96; const int nw = ((int)blockIdx.x - 96) * 8 + F.wave;
    for (int rd = 0; rd < (adab ? 3 : 5); ++rd) { const int row = rd < 3 ? rd * 2048 + F.gw : 6144 + (rd - 3) * 1280 + nw; if (row >= NTOK) break;
        const f32x4* xr = (const f32x4*)xrow_ptr(a, row) + F.lane; const float* mod = (const float*)(F.ws + WS_MOD) + cond_of(row) * 6144;
        f32x4 v[4]; float ss = 0.f;
#pragma unroll
        for (int j = 0; j < 4; ++j) { v[j] = xr[64 * j]; ss += (v[j].x * v[j].x + v[j].y * v[j].y) + (v[j].z * v[j].z + v[j].w * v[j].w); }
        const float rstd = rsqrtf(wave_sum(ss) * (1.f / D) + 1e-6f);
        u32x2* o = (u32x2*)((bf16_t*)(F.ws + WS_H) + (size_t)row * D) + F.lane;
#pragma unroll
        for (int j = 0; j < 4; ++j) { const int col = 4 * (64 * j + F.lane);
            const f32x4 g = *(const f32x4*)(ng + col), sh = *(const f32x4*)(mod + col), sc = *(const f32x4*)(mod + 1024 + col);
            const f32x4 h = v[j] * rstd * g * (sc + 1.f) + sh;
            u32x2 w; w.x = pk2(h.x, h.y); w.y = pk2(h.z, h.w); o[64 * j] = w; }
    }
}

constexpr int ZS_STRIDE = 3856;
__device__ __forceinline__ void ld4(const LAS unsigned char* p, float (&f)[4]) { const u32x2 w = *(const LAS u32x2*)p; f[0] = bf2f(w.x & 0xffffu); f[1] = bf2f(w.x >> 16); f[2] = bf2f(w.y & 0xffffu); f[3] = bf2f(w.y >> 16); }
__device__ __forceinline__ void st4(bf16_t* p, const float (&f)[4]) { u32x2 o; o.x = cvt_pk(f[0], f[1]); o.y = cvt_pk(f[2], f[3]); *(u32x2*)p = o; }
__device__ __forceinline__ void flush_rows(LAS unsigned char* stg, bf16_t* g  , const float (&v)[4][4], int fr, int fq, int lane) {
#pragma unroll
    for (int ct = 0; ct < 4; ++ct) { u32x2 o; o.x = cvt_pk(v[ct][0], v[ct][1]); o.y = cvt_pk(v[ct][2], v[ct][3]); *(LAS u32x2*)(stg + fr * 144 + ct * 32 + fq * 8) = o; }
    LDS_WAIT(); asm volatile("" ::: "memory");
#pragma unroll
    for (int i = 0; i < 2; ++i) { const int t = (lane >> 3) + 8 * i; *(u32x4*)(g + (size_t)t * 512 + (lane & 7) * 8) = *(const LAS u32x4*)(stg + t * 144 + (lane & 7) * 16); }
    LDS_WAIT(); asm volatile("" ::: "memory");
}
template <int SM = 7>
__device__ __forceinline__ void p3_prep(Frame& F) {
    const Args& a = *F.a;
    const bf16_t* Z = (const bf16_t*)(F.ws + WS_Z1);
    LAS unsigned char* L = F.lds;
    const int tid = F.tid, lane = F.lane, h = F.wave, fr = lane & 15, fq = lane >> 4;
    { const int unit = blockIdx.x;
        const int tok0 = unit * 32;
        const int s = tok0 < NCTX ? (tok0 >> 8) : 16 + ((tok0 - NCTX) >> 11);
        const int sb = seq_base(s), T = seq_len(s), t0 = tok0 - sb;
        __syncthreads();
        LAS float* prm = (LAS float*)(L + 32 * ZS_STRIDE);
        { prm[tid] = a.in[I_KKS][tid]; prm[512 + tid] = a.in[I_KA][tid]; prm[1024 + tid] = a.in[I_RK][tid]; prm[1536 + tid] = a.in[I_A0][tid]; prm[2048 + tid] = a.in[I_A0][512 + tid];
          prm[2560 + tid] = a.in[I_W0][tid]; prm[3072 + tid] = a.in[I_W0][512 + tid]; }
#pragma unroll 5
        for (int itk = 0; itk < ((SM & 1) ? 15 : 0); ++itk) { const int it = tid + 512 * itk;
            const int j = it / 240, g8 = (it - j * 240) * 8, t = t0 + j;
            const bf16_t* zp = Z + (size_t)(tok0 + j) * Z1C + g8;
            const float ml = t > 0 ? 0.5f : 0.f, mr = t < T - 1 ? 0.5f : 0.f;
            float zc[8], zl[8], zr[8], v[8];
            unpack8(*(const u32x4*)zp, zc); unpack8(*(const u32x4*)(zp - (t > 0 ? Z1C : 0)), zl); unpack8(*(const u32x4*)(zp + (t < T - 1 ? Z1C : 0)), zr);
            const f32x4 m0 = *(const f32x4*)(a.in[I_MU] + g8), m1 = *(const f32x4*)(a.in[I_MU] + g8 + 4);
#pragma unroll
            for (int i = 0; i < 8; ++i) { const float mu = i < 4 ? m0[i] : m1[i - 4]; v[i] = zc[i] + mu * ((ml * zl[i] + mr * zr[i]) - zc[i]); }
            if (g8 >= ZR_WD && g8 < ZR_AD) {
#pragma unroll
                for (int i = 0; i < 8; ++i) v[i] = tanhf(v[i]);
            } else if (g8 >= ZR_GD) {
#pragma unroll
                for (int i = 0; i < 8; ++i) v[i] = sigm(v[i]);
            }
            u32x4 o; o.x = cvt_pk(v[0], v[1]); o.y = cvt_pk(v[2], v[3]); o.z = cvt_pk(v[4], v[5]); o.w = cvt_pk(v[6], v[7]);
            *(LAS u32x4*)(L + j * ZS_STRIDE + g8 * 2) = o;
        }
        __syncthreads();
        if (SM & 2) {
            const bf16_t* WUPT = (const bf16_t*)(F.ws + WS_WUPT); const bf16_t* AUPT = (const bf16_t*)(F.ws + WS_AUPT); const bf16_t* GUPT = (const bf16_t*)(F.ws + WS_GUPT);
            const f32x4 Z4 = {0.f, 0.f, 0.f, 0.f};
            float kx[2][4][4], kk[2][4][4], rx[2][4][4], bon[2] = {0.f, 0.f};
            LAS unsigned char* stg = L + 32 * ZS_STRIDE + 14336 + h * 2304;
#define TILE(WS_, tt_) ((bf16_t*)(F.ws + (WS_)) + (size_t)(tok0 + 16 * (tt_)) * 512 + 64 * h)
#pragma unroll
            for (int tt = 0; tt < 2; ++tt) {
                const LAS unsigned char* zrow = L + (16 * tt + fr) * ZS_STRIDE; const size_t tok = (size_t)(tok0 + 16 * tt + fr);
                float ss = 0.f;
                float vx[4][4];
#pragma unroll
                for (int ct = 0; ct < 4; ++ct) { const int col = 64 * h + 16 * ct + 4 * fq;
                    ld4(zrow + (ZR_R + col) * 2, rx[tt][ct]); ld4(zrow + (ZR_K + col) * 2, kx[tt][ct]); ld4(zrow + (ZR_V + col) * 2, vx[ct]);
                    const f32x4 ks = *(const LAS f32x4*)(prm + col);
#pragma unroll
                    for (int j = 0; j < 4; ++j) { kk[tt][ct][j] = kx[tt][ct][j] * ks[j]; ss += kk[tt][ct][j] * kk[tt][ct][j]; }
                }
                flush_rows(stg, TILE(WS_PR, tt), rx[tt], fr, fq, lane); flush_rows(stg, TILE(WS_PV, tt), vx, fr, fq, lane);
                ss += __shfl_xor(ss, 16); ss += __shfl_xor(ss, 32);
                const float rn = 1.f / fmaxf(sqrtf(ss), 1e-12f);
#pragma unroll
                for (int ct = 0; ct < 4; ++ct) {
#pragma unroll
                    for (int j = 0; j < 4; ++j) kk[tt][ct][j] *= rn; }
                flush_rows(stg, TILE(WS_PKK, tt), kk[tt], fr, fq, lane);
            }
#pragma unroll
            for (int d = 0; d < 2; ++d) {
                asm volatile("" ::: "memory"); __builtin_amdgcn_sched_barrier(0);
                bf16x8 af[2][4];
#pragma unroll
                for (int ks = 0; ks < 2; ++ks)
#pragma unroll
                    for (int ct = 0; ct < 4; ++ct) af[ks][ct] = *(const bf16x8*)(AUPT + ((size_t)(d * 512 + 64 * h + 16 * ct + fr)) * 64 + 32 * ks + 8 * fq);
#pragma unroll
                for (int tt = 0; tt < 2; ++tt) { const LAS unsigned char* zrow = L + (16 * tt + fr) * ZS_STRIDE; const size_t tok = (size_t)(tok0 + 16 * tt + fr);
                    f32x4 acc[4] = {Z4, Z4, Z4, Z4};
#pragma unroll
                    for (int ks = 0; ks < 2; ++ks) { const bf16x8 bv = *(const LAS bf16x8*)(zrow + (ZR_AD + 64 * d + 32 * ks + 8 * fq) * 2);
#pragma unroll
                        for (int ct = 0; ct < 4; ++ct) acc[ct] = __builtin_amdgcn_mfma_f32_16x16x32_bf16(af[ks][ct], bv, acc[ct], 0, 0, 0); }
                    float kd[4][4], bv4[4][4];
#pragma unroll
                    for (int ct = 0; ct < 4; ++ct) { const int col = 64 * h + 16 * ct + 4 * fq;
                        const f32x4 a0 = *(const LAS f32x4*)(prm + 1536 + d * 512 + col), ka = *(const LAS f32x4*)(prm + 512 + col), rk = *(const LAS f32x4*)(prm + 1024 + col);
#pragma unroll
                        for (int j = 0; j < 4; ++j) { const float av = sigm(a0[j] + acc[ct][j]); kd[ct][j] = kx[tt][ct][j] * (1.f + (av - 1.f) * ka[j]); bv4[ct][j] = kk[tt][ct][j] * av; bon[tt] += rx[tt][ct][j] * kd[ct][j] * rk[j]; } }
                    flush_rows(stg, TILE(WS_PKD, tt) + (size_t)d * NTOK * 512, kd, fr, fq, lane); flush_rows(stg, TILE(WS_PB, tt) + (size_t)d * NTOK * 512, bv4, fr, fq, lane); (void)tok;
                }
            }
#pragma unroll
            for (int d = 0; d < 2; ++d) {
                asm volatile("" ::: "memory"); __builtin_amdgcn_sched_barrier(0);
                bf16x8 af[2][4];
#pragma unroll
                for (int ks = 0; ks < 2; ++ks)
#pragma unroll
                    for (int ct = 0; ct < 4; ++ct) af[ks][ct] = *(const bf16x8*)(WUPT + ((size_t)(d * 512 + 64 * h + 16 * ct + fr)) * 64 + 32 * ks + 8 * fq);
#pragma unroll
                for (int tt = 0; tt < 2; ++tt) { const LAS unsigned char* zrow = L + (16 * tt + fr) * ZS_STRIDE; const size_t tok = (size_t)(tok0 + 16 * tt + fr);
                    f32x4 acc[4] = {Z4, Z4, Z4, Z4};
#pragma unroll
                    for (int ks = 0; ks < 2; ++ks) { const bf16x8 bv = *(const LAS bf16x8*)(zrow + (ZR_WD + 64 * d + 32 * ks + 8 * fq) * 2);
#pragma unroll
                        for (int ct = 0; ct < 4; ++ct) acc[ct] = __builtin_amdgcn_mfma_f32_16x16x32_bf16(af[ks][ct], bv, acc[ct], 0, 0, 0); }
                    float dc[4][4];
#pragma unroll
                    for (int ct = 0; ct < 4; ++ct) { const int col = 64 * h + 16 * ct + 4 * fq; const f32x4 w0 = *(const LAS f32x4*)(prm + 2560 + d * 512 + col);
#pragma unroll
                        for (int j = 0; j < 4; ++j) dc[ct][j] = __expf(-0.606531f * sigm(w0[j] + acc[ct][j])); }
                    flush_rows(stg, TILE(WS_PW, tt) + (size_t)d * NTOK * 512, dc, fr, fq, lane); (void)tok;
                }
            }
            {
                asm volatile("" ::: "memory"); __builtin_amdgcn_sched_barrier(0);
                bf16x8 af[4][4];
#pragma unroll
                for (int ks = 0; ks < 4; ++ks)
#pragma unroll
                    for (int ct = 0; ct < 4; ++ct) af[ks][ct] = *(const bf16x8*)(GUPT + ((size_t)(64 * h + 16 * ct + fr)) * 128 + 32 * ks + 8 * fq);
#pragma unroll
                for (int tt = 0; tt < 2; ++tt) { const LAS unsigned char* zrow = L + (16 * tt + fr) * ZS_STRIDE; const size_t tok = (size_t)(tok0 + 16 * tt + fr);
                    f32x4 acc[4] = {Z4, Z4, Z4, Z4};
#pragma unroll
                    for (int ks = 0; ks < 4; ++ks) { const bf16x8 bv = *(const LAS bf16x8*)(zrow + (ZR_GD + 32 * ks + 8 * fq) * 2);
#pragma unroll
                        for (int ct = 0; ct < 4; ++ct) acc[ct] = __builtin_amdgcn_mfma_f32_16x16x32_bf16(af[ks][ct], bv, acc[ct], 0, 0, 0); }
                    float g4[4][4];
#pragma unroll
                    for (int ct = 0; ct < 4; ++ct) { g4[ct][0] = acc[ct][0]; g4[ct][1] = acc[ct][1]; g4[ct][2] = acc[ct][2]; g4[ct][3] = acc[ct][3]; }
                    flush_rows(stg, TILE(WS_PG, tt), g4, fr, fq, lane); (void)tok;
                }
            }
#pragma unroll
            for (int tt = 0; tt < 2; ++tt) { float b = bon[tt]; b += __shfl_xor(b, 16); b += __shfl_xor(b, 32);
                if (fq == 0) ((float*)(F.ws + WS_BON))[(size_t)(tok0 + 16 * tt + fr) * 8 + h] = b; }
        }
        asm volatile("" ::: "memory"); __builtin_amdgcn_sched_barrier(0);
        if (SM & 4) {
            int tid = F.tid; asm volatile("" : "+v"(tid));
            const bool lat = s >= 16;
            const int y = lat ? (t0 >> 6) : 0, W = lat ? 64 : 256, j0 = (tid >> 7) * 8, x0 = (lat ? (t0 & 63) : t0) + j0;
#pragma unroll 1
            for (int half = 0; half < 2; ++half) {
                const int c4 = (tid & 127) * 4 + half * 512;
                const float* cw = a.in[I_MCONV] + c4;
                float acc[8][4];
#pragma unroll
                for (int jj = 0; jj < 8; ++jj)
#pragma unroll
                    for (int e = 0; e < 4; ++e) acc[jj][e] = 0.f;
#pragma unroll 1
                for (int dy = -1; dy <= 1; ++dy) {
                    const bool rowok = dy == 0 || (lat && y + dy >= 0 && y + dy < 32);
                    const int dyo = rowok ? dy * 64 : 0; const float rmask = rowok ? 1.f : 0.f;
                    f32x4 wt[3];
#pragma unroll
                    for (int dx = 0; dx < 3; ++dx) wt[dx] = *(const f32x4*)(cw + ((dy + 1) * 3 + dx) * 1024) * rmask;
#pragma unroll
                    for (int i = 0; i < 10; ++i) { const int xx = x0 - 1 + i; const bool ok = xx >= 0 && xx < W;
                        const u32x2 raw = *(const u32x2*)(Z + ((long)(tok0 + j0 + dyo) + (i - 1)) * Z1C + ZM_Q + c4);
                        const float cm = ok ? 1.f : 0.f;
                        const f32x4 xv = (f32x4){bf2f(raw.x & 0xffffu), bf2f(raw.x >> 16), bf2f(raw.y & 0xffffu), bf2f(raw.y >> 16)} * cm;
#pragma unroll
                        for (int dx = -1; dx <= 1; ++dx) { const int jj = i - 1 - dx;
                            if (jj >= 0 && jj < 8) {
#pragma unroll
                                for (int e = 0; e < 4; ++e) acc[jj][e] += wt[dx + 1][e] * xv[e]; } }
                    }
                }
                const float sc = half == 0 ? 0.08838834764831845f : 1.f;
                bf16_t* dst = (half == 0 ? (bf16_t*)(F.ws + WS_MQ) : (bf16_t*)(F.ws + WS_MK)) + (tid & 127) * 4;
#pragma unroll
                for (int jj = 0; jj < 8; ++jj) {
#pragma unroll
                    for (int e = 0; e < 4; ++e) acc[jj][e] = silu(acc[jj][e]) * sc;
                    u32x2 o; o.x = cvt_pk(acc[jj][0], acc[jj][1]); o.y = cvt_pk(acc[jj][2], acc[jj][3]);
                    *(u32x2*)(dst + (size_t)(tok0 + j0 + jj) * 512) = o; }
                asm volatile("" ::: "memory"); __builtin_amdgcn_sched_barrier(0);
            }
            { const int j = tid >> 4, gi = tid & 15, tok = tok0 + j;
                const float val = bf2f(Z[(size_t)tok * Z1C + ZM_G + gi]) + a.in[I_MGB][gi];
                if (gi < 8) ((float*)(F.ws + WS_LI))[(size_t)gi * NTOK + tok] = val;
                else ((float*)(F.ws + WS_LF))[(size_t)(gi - 8) * NTOK + tok] = fminf(val, 0.f) - log1pf(__expf(-fabsf(val))); }
        }
    }
}

typedef short bf16x4 __attribute__((ext_vector_type(4)));
__device__ __forceinline__ bf16x4 to_b4(const f32x4 c) { u32x2 p; p.x = cvt_pk(c[0], c[1]); p.y = cvt_pk(c[2], c[3]); return __builtin_bit_cast(bf16x4, p); }
__device__ __forceinline__ bf16x8 cat8(const bf16x4 a, const bf16x4 b) { return __builtin_shufflevector(a, b, 0, 1, 2, 3, 4, 5, 6, 7); }
#define MM2(a0, b0, a1, b1, c) __builtin_amdgcn_mfma_f32_16x16x32_bf16(cat8(a0, a1), cat8(b0, b1), c, 0, 0, 0)
#define MM1(a, b, c) __builtin_amdgcn_mfma_f32_16x16x32_bf16(cat8(a, (bf16x4){0, 0, 0, 0}), cat8(b, (bf16x4){0, 0, 0, 0}), c, 0, 0, 0)
constexpr int R1_AA = 0, R1_BB = 2304, R1_KK = 4608, R1_RR = 6912, R1_BPT = 9216, R1_KPT = 12288, R1_VT = 15360, R1_GB = 18432, R1_BYTES = 18688;
__device__ __forceinline__ int r_slot0(int s, int dir, int h) { return s < 16 ? (((s * 2 + dir) * 8 + h) * 4) : 1024 + ((((s - 16) * 2 + dir) * 8 + h) * 32); }
template <int PM = 0>
__device__ __forceinline__ void rwkv_pass1(Frame& F, int unit) {
    int c, s, dir; const int h = unit & 7, g = unit >> 3;
    if (g < 128) { c = g & 3; s = g >> 3; dir = (g >> 2) & 1; } else { const int g2 = g - 128; c = g2 & 31; s = 16 + (g2 >> 6); dir = (g2 >> 5) & 1; }
    const int slot = r_slot0(s, dir, h) + c;
    const int sb = seq_base(s), T = seq_len(s), lane = F.lane, fr = lane & 15, fq = lane >> 4;
    LAS unsigned char* wl = F.lds + F.wave * R1_BYTES;
    const bf16_t* PR = (const bf16_t*)(F.ws + WS_PR) + h * 64; const bf16_t* PV = (const bf16_t*)(F.ws + WS_PV) + h * 64; const bf16_t* PKK = (const bf16_t*)(F.ws + WS_PKK) + h * 64;
    const bf16_t* PW = (const bf16_t*)(F.ws + WS_PW) + (size_t)dir * NTOK * 512 + h * 64; const bf16_t* PKD = (const bf16_t*)(F.ws + WS_PKD) + (size_t)dir * NTOK * 512 + h * 64;
    const bf16_t* PB = (const bf16_t*)(F.ws + WS_PB) + (size_t)dir * NTOK * 512 + h * 64;
    bf16_t* ybase = PM ? (bf16_t*)(F.ws + WS_PW) : (bf16_t*)F.out;
    bf16_t* YS = ybase + (size_t)dir * NTOK * 512 + h * 64; bf16_t* US = ybase + (size_t)(2 + dir) * NTOK * 512 + h * 64;
    f32x4 XT[4][8];
#pragma unroll
    for (int kt = 0; kt < 4; ++kt)
#pragma unroll
        for (int rt = 0; rt < 8; ++rt)
#pragma unroll
            for (int j = 0; j < 4; ++j) XT[kt][rt][j] = (rt >= 4 && (16 * kt + 4 * fq + j) == (16 * (rt - 4) + fr)) ? 1.f : 0.f;
#pragma unroll 1
    for (int blk = 0; blk < 4; ++blk) {
        const int pos0 = c * 64 + blk * 16;
        {
            const int t = lane >> 2, cp = (lane & 3) * 8, p = pos0 + t, tt = dir ? T - 1 - p : p; const size_t off = (size_t)(sb + tt) * 512 + cp;
            u32x4 raw[6][2];
            if (PM == 1) {
#pragma unroll
                for (int q = 0; q < 6; ++q) { raw[q][0] = (u32x4){0x3e003e00u + (unsigned)lane, 0x3e003e00u, 0x3e003e00u, 0x3e003e00u}; raw[q][1] = raw[q][0]; }
            } else {
                raw[0][0] = *(const u32x4*)(PKK + off); raw[0][1] = *(const u32x4*)(PKK + off + 32); raw[1][0] = *(const u32x4*)(PB + off); raw[1][1] = *(const u32x4*)(PB + off + 32);
                raw[2][0] = *(const u32x4*)(PKD + off); raw[2][1] = *(const u32x4*)(PKD + off + 32); raw[3][0] = *(const u32x4*)(PR + off); raw[3][1] = *(const u32x4*)(PR + off + 32);
                raw[4][0] = *(const u32x4*)(PW + off); raw[4][1] = *(const u32x4*)(PW + off + 32); raw[5][0] = *(const u32x4*)(PV + off); raw[5][1] = *(const u32x4*)(PV + off + 32);
            }
            const int lo = t * 144 + cp * 2;
            *(LAS u32x4*)(wl + R1_AA + lo) = raw[0][0]; *(LAS u32x4*)(wl + R1_AA + lo + 64) = raw[0][1]; *(LAS u32x4*)(wl + R1_BB + lo) = raw[1][0]; *(LAS u32x4*)(wl + R1_BB + lo + 64) = raw[1][1];
            *(LAS u32x4*)(wl + R1_KK + lo) = raw[2][0]; *(LAS u32x4*)(wl + R1_KK + lo + 64) = raw[2][1]; *(LAS u32x4*)(wl + R1_RR + lo) = raw[3][0]; *(LAS u32x4*)(wl + R1_RR + lo + 64) = raw[3][1];
            *(LAS u32x4*)(wl + R1_BPT + lo) = raw[4][0]; *(LAS u32x4*)(wl + R1_BPT + lo + 64) = raw[4][1]; *(LAS u32x4*)(wl + R1_KPT + lo) = raw[5][0]; *(LAS u32x4*)(wl + R1_KPT + lo + 64) = raw[5][1];
        }
        LDS_WAIT(); asm volatile("" ::: "memory");
        {
            float gt[16], vv[16], gB = 1.f;
#pragma unroll
            for (int t = 0; t < 16; ++t) { gB *= bf2f(*(const LAS bf16_t*)(wl + R1_BPT + t * 144 + lane * 2)); gt[t] = gB; vv[t] = bf2f(*(const LAS bf16_t*)(wl + R1_KPT + t * 144 + lane * 2)); }
            LDS_WAIT(); asm volatile("" ::: "memory");
#pragma unroll
            for (int tp = 0; tp < 8; ++tp) {
                float bp[2], kp[2];
#pragma unroll
                for (int e = 0; e < 2; ++e) { const int t = 2 * tp + e; const int lo = t * 144 + lane * 2;
                    const float kk = bf2f(*(const LAS bf16_t*)(wl + R1_AA + lo)), b = bf2f(*(const LAS bf16_t*)(wl + R1_BB + lo)), kd = bf2f(*(const LAS bf16_t*)(wl + R1_KK + lo)), r = bf2f(*(const LAS bf16_t*)(wl + R1_RR + lo));
                    const float g = gt[t], gm1 = t ? gt[t > 0 ? t - 1 : 0] : 1.f, inv = __builtin_amdgcn_rcpf(g), bb = b * inv, kq = kd * inv;
                    bp[e] = bb * gB; kp[e] = kq * gB;
                    *(LAS bf16_t*)(wl + R1_AA + lo) = (bf16_t)cvt_pk(gm1 * kk, 0.f); *(LAS bf16_t*)(wl + R1_BB + lo) = (bf16_t)cvt_pk(bb, 0.f);
                    *(LAS bf16_t*)(wl + R1_KK + lo) = (bf16_t)cvt_pk(kq, 0.f); *(LAS bf16_t*)(wl + R1_RR + lo) = (bf16_t)cvt_pk(g * r, 0.f); }
                *(LAS unsigned*)(wl + R1_BPT + lane * 48 + tp * 4) = cvt_pk(bp[0], bp[1]);
                *(LAS unsigned*)(wl + R1_KPT + lane * 48 + tp * 4) = cvt_pk(kp[0], kp[1]);
                *(LAS unsigned*)(wl + R1_VT + lane * 48 + tp * 4) = cvt_pk(vv[2 * tp], vv[2 * tp + 1]);
            }
            *(LAS float*)(wl + R1_GB + lane * 4) = gB;
        }
        LDS_WAIT(); asm volatile("" ::: "memory");
        bf16x4 fAA[4], fRR[4];
        f32x4 Nn = {0.f, 0.f, 0.f, 0.f}, NT = Nn, P2T = Nn, Q1T = Nn, Q2T = Nn;
        {
            bf16x4 fB[4], fK[4];
#pragma unroll
            for (int kt = 0; kt < 4; ++kt) { const int o1 = fr * 144 + (16 * kt + 4 * fq) * 2;
                fAA[kt] = *(const LAS bf16x4*)(wl + R1_AA + o1); fRR[kt] = *(const LAS bf16x4*)(wl + R1_RR + o1); fB[kt] = *(const LAS bf16x4*)(wl + R1_BB + o1); fK[kt] = *(const LAS bf16x4*)(wl + R1_KK + o1); }
#pragma unroll
            for (int kp = 0; kp < 4; kp += 2) {
                Nn = MM2(fAA[kp], fB[kp], fAA[kp + 1], fB[kp + 1], Nn); NT = MM2(fB[kp], fAA[kp], fB[kp + 1], fAA[kp + 1], NT); P2T = MM2(fK[kp], fAA[kp], fK[kp + 1], fAA[kp + 1], P2T);
                Q1T = MM2(fB[kp], fRR[kp], fB[kp + 1], fRR[kp + 1], Q1T); Q2T = MM2(fK[kp], fRR[kp], fK[kp + 1], fRR[kp + 1], Q2T); }
        }
        f32x4 Ic;
#pragma unroll
        for (int j = 0; j < 4; ++j) { const int m = 4 * fq + j, n = fr;
            Nn[j] = (n < m) ? Nn[j] : 0.f; NT[j] = (m < n) ? NT[j] : 0.f; P2T[j] = (m < n) ? P2T[j] : 0.f; Q1T[j] = (m <= n) ? Q1T[j] : 0.f; Q2T[j] = (m <= n) ? Q2T[j] : 0.f; Ic[j] = (m == n) ? 1.f : 0.f; }
        const f32x4 Z4 = {0.f, 0.f, 0.f, 0.f};
        const bf16x4 bNn = to_b4(Nn), bNT = to_b4(NT);
        const f32x4 N2 = MM1(bNT, bNn, Z4), N2T = MM1(bNn, bNT, Z4);
        const bf16x4 bN2 = to_b4(N2), bN2T = to_b4(N2T);
        const f32x4 N4 = MM1(bN2T, bN2, Z4), N4T = MM1(bN2, bN2T, Z4);
        const f32x4 N8 = MM1(to_b4(N4T), to_b4(N4), Z4);
        const f32x4 T2T = MM1(to_b4(Ic + N2), to_b4(Ic - NT), Z4);
        const f32x4 T3T = MM1(to_b4(Ic + N4), to_b4(T2T), Z4);
        const f32x4 TiT = MM1(to_b4(Ic + N8), to_b4(T3T), Z4);
        const bf16x4 bTn = to_b4(Z4 - TiT), bP2T = to_b4(P2T), bQ1T = to_b4(Q1T), bQ2T = to_b4(Q2T);
#pragma unroll
        for (int rt = 0; rt < (PM == 3 ? 0 : 8); ++rt) {
            bf16x4 bX[4];
#pragma unroll
            for (int kt = 0; kt < 4; ++kt) bX[kt] = to_b4(XT[kt][rt]);
            const bf16x4 z4b = {0, 0, 0, 0};
            f32x4 cg = MM2(fAA[0], bX[0], fAA[1], bX[1], Z4); cg = MM2(fAA[2], bX[2], fAA[3], bX[3], cg);
            bf16x4 bV = z4b;
            if (rt < 4) { bV = *(const LAS bf16x4*)(wl + R1_VT + (16 * rt + fr) * 48 + 8 * fq); cg = MM1(bP2T, bV, cg); }
            const bf16x4 bD = to_b4(MM1(bTn, to_b4(cg), Z4));
            f32x4 y = MM2(fRR[0], bX[0], fRR[1], bX[1], Z4); y = MM2(fRR[2], bX[2], fRR[3], bX[3], y);
            y = MM2(bQ1T, bD, (rt < 4 ? bQ2T : z4b), bV, y);
#pragma unroll
            for (int j = 0; j < 4; ++j) *(LAS bf16_t*)(wl + (4 * fq + j) * 256 + (16 * rt + fr) * 2) = (bf16_t)cvt_pk(y[j], 0.f);
#pragma unroll
            for (int kt = 0; kt < 4; ++kt) { const int o2 = (16 * kt + fr) * 48 + 8 * fq;
                const f32x4 x = XT[kt][rt] * *(const LAS f32x4*)(wl + R1_GB + (16 * kt + 4 * fq) * 4);
                XT[kt][rt] = MM2(*(const LAS bf16x4*)(wl + R1_BPT + o2), bD, (rt < 4 ? *(const LAS bf16x4*)(wl + R1_KPT + o2) : z4b), bV, x); }
            __builtin_amdgcn_sched_barrier(0);
        }
        LDS_WAIT(); asm volatile("" ::: "memory");
        if (PM != 2) {
            const int t = lane >> 2, part = lane & 3, p = pos0 + t, tt = dir ? T - 1 - p : p;
            bf16_t* yo = (part < 2 ? YS : US) + (size_t)(sb + tt) * 512 + 32 * (part & 1);
#pragma unroll
            for (int i = 0; i < 4; ++i) *(u32x4*)(yo + 8 * i) = *(const LAS u32x4*)(wl + t * 256 + part * 64 + 16 * i);
        }
        LDS_WAIT(); asm volatile("" ::: "memory");
    }
    if (PM) {
#pragma unroll
        for (int kt = 0; kt < 4; ++kt)
#pragma unroll
            for (int rt = 0; rt < 8; ++rt) asm volatile("" :: "v"(XT[kt][rt]));
        return; }
    bf16_t* sp = (bf16_t*)(F.ws + WS_SP) + (size_t)slot * 8192;
#pragma unroll
    for (int rt = 0; rt < 4; ++rt) {
        u32x4 o0, o1;
        o0.x = cvt_pk(XT[0][rt][0], XT[0][rt][1]); o0.y = cvt_pk(XT[0][rt][2], XT[0][rt][3]); o0.z = cvt_pk(XT[1][rt][0], XT[1][rt][1]); o0.w = cvt_pk(XT[1][rt][2], XT[1][rt][3]);
        o1.x = cvt_pk(XT[2][rt][0], XT[2][rt][1]); o1.y = cvt_pk(XT[2][rt][2], XT[2][rt][3]); o1.z = cvt_pk(XT[3][rt][0], XT[3][rt][1]); o1.w = cvt_pk(XT[3][rt][2], XT[3][rt][3]);
        *(u32x4*)(sp + 4096 + (16 * rt + fr) * 64 + fq * 16) = o0; *(u32x4*)(sp + 4096 + (16 * rt + fr) * 64 + fq * 16 + 8) = o1;
#pragma unroll
        for (int kt = 0; kt < 4; ++kt)
#pragma unroll
            for (int j = 0; j < 4; ++j) *(LAS bf16_t*)(wl + (16 * kt + 4 * fq + j) * 128 + ((fr >> 2) * 16 + rt * 4 + (fr & 3)) * 2) = (bf16_t)cvt_pk(XT[kt][4 + rt][j], 0.f);
    }
    LDS_WAIT(); asm volatile("" ::: "memory");
#pragma unroll
    for (int i = 0; i < 8; ++i) { const int id = lane + 64 * i; *(u32x4*)(sp + (id >> 3) * 64 + (id & 7) * 8) = *(const LAS u32x4*)(wl + (id >> 3) * 128 + (id & 7) * 16); }
}
struct PropStage { bf16x4 a[4][4]; u32x2 sl[4]; };
template <int MODE = 0>
__device__ __forceinline__ void rwkv_prop(Frame& F, int wu, size_t st_off = 0, bool fin = true) {
    const Args& a = *F.a;
    int s, dir, h, vt;
    if (wu < 128) { const int hs = wu >> 2; vt = wu & 3; s = 16 + (hs >> 4); dir = (hs >> 3) & 1; h = hs & 7; } else { const int u2 = wu - 128, hs = u2 >> 2; vt = u2 & 3; s = hs >> 4; dir = (hs >> 3) & 1; h = hs & 7; }
    const int nch = seq_len(s) / 64, lane = F.lane, fr = lane & 15, fq = lane >> 4;
    bf16_t* sp0 = (bf16_t*)(F.ws + WS_SP) + (size_t)r_slot0(s, dir, h) * 8192;
    bf16x4 bS[4]; f32x4 acc[4];
    if (s >= 16) { const float* s0 = a.in[I_SR] + ((((size_t)(s - 16) * 2 + dir) * 8 + h) * 4096) + (16 * vt + fr) * 64 + 4 * fq;
#pragma unroll
        for (int it = 0; it < 4; ++it) bS[it] = to_b4(*(const f32x4*)(s0 + 16 * it));
    } else {
#pragma unroll
        for (int it = 0; it < 4; ++it) bS[it] = (bf16x4){0, 0, 0, 0};
    }
#pragma unroll
    for (int kt = 0; kt < 4; ++kt) acc[kt] = (f32x4){0.f, 0.f, 0.f, 0.f};
    PropStage st[4];
#define PROP_LOAD(u, cidx) do { const bf16_t* spc = sp0 + (size_t)(cidx) * 8192; \
        _Pragma("unroll") for (int kt = 0; kt < 4; ++kt) { const u32x4 lo_ = *(const u32x4*)(spc + (16 * kt + fr) * 64 + fq * 16), hi_ = *(const u32x4*)(spc + (16 * kt + fr) * 64 + fq * 16 + 8); \
            st[u].a[kt][0] = __builtin_bit_cast(bf16x4, (u32x2){lo_.x, lo_.y}); st[u].a[kt][1] = __builtin_bit_cast(bf16x4, (u32x2){lo_.z, lo_.w}); \
            st[u].a[kt][2] = __builtin_bit_cast(bf16x4, (u32x2){hi_.x, hi_.y}); st[u].a[kt][3] = __builtin_bit_cast(bf16x4, (u32x2){hi_.z, hi_.w}); } \
        { const u32x4 lo_ = *(const u32x4*)(spc + 4096 + (16 * vt + fr) * 64 + fq * 16), hi_ = *(const u32x4*)(spc + 4096 + (16 * vt + fr) * 64 + fq * 16 + 8); \
            st[u].sl[0] = (u32x2){lo_.x, lo_.y}; st[u].sl[1] = (u32x2){lo_.z, lo_.w}; st[u].sl[2] = (u32x2){hi_.x, hi_.y}; st[u].sl[3] = (u32x2){hi_.z, hi_.w}; } } while (0)
#pragma unroll
    for (int u = 0; u < 4; ++u) PROP_LOAD(u, u);
    for (int c0 = 0; c0 < nch; c0 += 4) {
#pragma unroll
        for (int u = 0; u < 4; ++u) { const int c = c0 + u; bf16_t* spc = sp0 + (size_t)c * 8192;
#pragma unroll
            for (int kt = 0; kt < 4; ++kt) { acc[kt][0] = bf2f(st[u].sl[kt].x & 0xffffu); acc[kt][1] = bf2f(st[u].sl[kt].x >> 16); acc[kt][2] = bf2f(st[u].sl[kt].y & 0xffffu); acc[kt][3] = bf2f(st[u].sl[kt].y >> 16); }
#pragma unroll
            for (int it = 0; it < 4; ++it) *(bf16x4*)(spc + st_off + 4096 + (16 * vt + fr) * 64 + 16 * it + 4 * fq) = bS[it];
#pragma unroll
            for (int kt = 0; kt < 4; ++kt)
#pragma unroll
                for (int it = 0; it < 4; it += 2) { if (MODE == 2) { acc[kt][0] += __builtin_bit_cast(float, (int)st[u].a[kt][it][0] + (int)bS[it][0]); } else acc[kt] = MM2(st[u].a[kt][it], bS[it], st[u].a[kt][it + 1], bS[it + 1], acc[kt]); }
#pragma unroll
            for (int kt = 0; kt < 4; ++kt) bS[kt] = to_b4(acc[kt]);
            if (MODE != 1) { const int cn = c + 4 < nch ? c + 4 : nch - 1; PROP_LOAD(u, cn); }
        }
    }
#undef PROP_LOAD
    if (s < 16 && fin) { float* so = F.out + OUT_SR + ((((size_t)s * 2 + dir) * 8 + h) * 4096) + (16 * vt + fr) * 64 + 4 * fq;
#pragma unroll
        for (int kt = 0; kt < 4; ++kt) *(f32x4*)(so + 16 * kt) = acc[kt]; }
}
constexpr int RPL_SLOT = 11520, RPL_NS = 12, RPL_FLG = RPL_SLOT * RPL_NS;
__device__ __forceinline__ void rwkv_prop_lat(Frame& F, int wu) {
    const Args& a = *F.a;
    const int hs = wu >> 2, vt = wu & 3, s = 16 + (hs >> 4), dir = (hs >> 3) & 1, h = hs & 7;
    const int lane = F.lane, fr = lane & 15, fq = lane >> 4;
    bf16_t* sp0 = (bf16_t*)(F.ws + WS_SP) + (size_t)r_slot0(s, dir, h) * 8192;
    LAS unsigned char* L = F.lds; volatile LAS unsigned* flg = (volatile LAS unsigned*)(L + RPL_FLG);
    __syncthreads();
    if (F.tid < 64) flg[F.tid] = 0u;
    __syncthreads();
    if (F.wave == 0) {
        bf16x4 bS[4];
        { const float* s0 = a.in[I_SR] + ((((size_t)(s - 16) * 2 + dir) * 8 + h) * 4096) + (16 * vt + fr) * 64 + 4 * fq;
#pragma unroll
            for (int it = 0; it < 4; ++it) bS[it] = to_b4(*(const f32x4*)(s0 + 16 * it)); }
#pragma unroll 1
        for (int c = 0; c < 32; ++c) {
            while (flg[c] == 0u) __builtin_amdgcn_s_sleep(1);
            asm volatile("" ::: "memory");
            const LAS unsigned char* sl_ = L + (c % RPL_NS) * RPL_SLOT;
            bf16x4 af[4][4]; f32x4 acc[4];
#pragma unroll
            for (int kt = 0; kt < 4; ++kt) { const u32x4 lo_ = *(const LAS u32x4*)(sl_ + (16 * kt + fr) * 144 + fq * 32), hi_ = *(const LAS u32x4*)(sl_ + (16 * kt + fr) * 144 + fq * 32 + 16);
                af[kt][0] = __builtin_bit_cast(bf16x4, (u32x2){lo_.x, lo_.y}); af[kt][1] = __builtin_bit_cast(bf16x4, (u32x2){lo_.z, lo_.w});
                af[kt][2] = __builtin_bit_cast(bf16x4, (u32x2){hi_.x, hi_.y}); af[kt][3] = __builtin_bit_cast(bf16x4, (u32x2){hi_.z, hi_.w}); }
            { const u32x4 lo_ = *(const LAS u32x4*)(sl_ + 9216 + fr * 144 + fq * 32), hi_ = *(const LAS u32x4*)(sl_ + 9216 + fr * 144 + fq * 32 + 16);
                const unsigned w8[8] = {lo_.x, lo_.y, lo_.z, lo_.w, hi_.x, hi_.y, hi_.z, hi_.w};
#pragma unroll
                for (int kt = 0; kt < 4; ++kt) { acc[kt][0] = bf2f(w8[2 * kt] & 0xffffu); acc[kt][1] = bf2f(w8[2 * kt] >> 16); acc[kt][2] = bf2f(w8[2 * kt + 1] & 0xffffu); acc[kt][3] = bf2f(w8[2 * kt + 1] >> 16); } }
            LDS_WAIT(); asm volatile("" ::: "memory");
            flg[32] = (unsigned)(c + 1);
            bf16_t* spc = sp0 + (size_t)c * 8192;
#pragma unroll
            for (int it = 0; it < 4; ++it) *(bf16x4*)(spc + 4096 + (16 * vt + fr) * 64 + 16 * it + 4 * fq) = bS[it];
#pragma unroll
            for (int kt = 0; kt < 4; ++kt)
#pragma unroll
                for (int it = 0; it < 4; it += 2) acc[kt] = MM2(af[kt][it], bS[it], af[kt][it + 1], bS[it + 1], acc[kt]);
#pragma unroll
            for (int kt = 0; kt < 4; ++kt) bS[kt] = to_b4(acc[kt]);
        }
    } else {
#pragma unroll 1
        for (int c = F.wave - 1; c < 32; c += 14) {
            const int c2 = c + 7; const bool two = c2 < 32;
            const unsigned char* g1 = (const unsigned char*)(sp0 + (size_t)c * 8192); const unsigned char* g2 = (const unsigned char*)(sp0 + (size_t)(two ? c2 : c) * 8192);
            u32x4 r1[10], r2[10];
#pragma unroll
            for (int j = 0; j < 8; ++j) r1[j] = *(const u32x4*)(g1 + (lane + 64 * j) * 16);
#pragma unroll
            for (int j = 0; j < 2; ++j) r1[8 + j] = *(const u32x4*)(g1 + 8192 + vt * 2048 + (lane + 64 * j) * 16);
#pragma unroll
            for (int j = 0; j < 8; ++j) r2[j] = *(const u32x4*)(g2 + (lane + 64 * j) * 16);
#pragma unroll
            for (int j = 0; j < 2; ++j) r2[8 + j] = *(const u32x4*)(g2 + 8192 + vt * 2048 + (lane + 64 * j) * 16);
            while ((int)flg[32] < c - (RPL_NS - 1)) __builtin_amdgcn_s_sleep(1);
            { LAS unsigned char* d = L + (c % RPL_NS) * RPL_SLOT;
#pragma unroll
                for (int j = 0; j < 8; ++j) { const int idx = lane + 64 * j; *(LAS u32x4*)(d + (idx >> 3) * 144 + (idx & 7) * 16) = r1[j]; }
#pragma unroll
                for (int j = 0; j < 2; ++j) { const int idx = lane + 64 * j; *(LAS u32x4*)(d + 9216 + (idx >> 3) * 144 + (idx & 7) * 16) = r1[8 + j]; }
                LDS_WAIT(); asm volatile("" ::: "memory"); flg[c] = 1u; }
            if (two) {
                while ((int)flg[32] < c2 - (RPL_NS - 1)) __builtin_amdgcn_s_sleep(1);
                LAS unsigned char* d = L + (c2 % RPL_NS) * RPL_SLOT;
#pragma unroll
                for (int j = 0; j < 8; ++j) { const int idx = lane + 64 * j; *(LAS u32x4*)(d + (idx >> 3) * 144 + (idx & 7) * 16) = r2[j]; }
#pragma unroll
                for (int j = 0; j < 2; ++j) { const int idx = lane + 64 * j; *(LAS u32x4*)(d + 9216 + (idx >> 3) * 144 + (idx & 7) * 16) = r2[8 + j]; }
                LDS_WAIT(); asm volatile("" ::: "memory"); flg[c2] = 1u; }
        }
    }
}
__device__ __forceinline__ void rwkv_fix(Frame& F, int wu2) {
    const Args& a = *F.a; const int wu = wu2 >> 1, th = wu2 & 1;
    int s, cc, h;
    if (wu < 512) { const int cg = wu >> 3; h = wu & 7; s = cg >> 2; cc = cg & 3; } else { const int u2 = wu - 512, cg = u2 >> 3; h = u2 & 7; s = 16 + (cg >> 5); cc = cg & 31; }
    const int sb = seq_base(s), nch = seq_len(s) / 64, tok0 = sb + cc * 64, lane = F.lane, fr = lane & 15, fq = lane >> 4;
    f32x4 acc[4][2];
#pragma unroll
    for (int vt = 0; vt < 4; ++vt)
#pragma unroll
        for (int tt = 0; tt < 2; ++tt) acc[vt][tt] = (f32x4){0.f, 0.f, 0.f, 0.f};
#pragma unroll
    for (int d = 0; d < 2; ++d) {
        const bf16_t* sin = (const bf16_t*)(F.ws + WS_SP) + (size_t)(r_slot0(s, d, h) + (d ? nch - 1 - cc : cc)) * 8192 + 4096;
        const bf16_t* us = (const bf16_t*)F.out + (size_t)(2 + d) * NTOK * 512 + h * 64;
#pragma unroll
        for (int ks = 0; ks < 2; ++ks) { bf16x8 aS[4], bU[2];
#pragma unroll
            for (int i = 0; i < 4; ++i) aS[i] = *(const bf16x8*)(sin + (16 * i + fr) * 64 + 32 * ks + 8 * fq);
#pragma unroll
            for (int i = 0; i < 2; ++i) bU[i] = *(const bf16x8*)(us + (size_t)(tok0 + 32 * th + 16 * i + fr) * 512 + 32 * ks + 8 * fq);
#pragma unroll
            for (int vt = 0; vt < 4; ++vt)
#pragma unroll
                for (int tt = 0; tt < 2; ++tt) acc[vt][tt] = __builtin_amdgcn_mfma_f32_16x16x32_bf16(aS[vt], bU[tt], acc[vt][tt], 0, 0, 0); }
    }
    const bf16_t* YS = (const bf16_t*)F.out + h * 64 + 4 * fq;
#pragma unroll
    for (int tt = 0; tt < 2; ++tt) { const size_t tok = (size_t)(tok0 + 32 * th + 16 * tt + fr);
        float sm = 0.f;
#pragma unroll
        for (int vt = 0; vt < 4; ++vt) { const u32x2 y0 = *(const u32x2*)(YS + tok * 512 + 16 * vt), y1 = *(const u32x2*)(YS + ((size_t)NTOK + tok) * 512 + 16 * vt);
            acc[vt][tt][0] += bf2f(y0.x & 0xffffu) + bf2f(y1.x & 0xffffu); acc[vt][tt][1] += bf2f(y0.x >> 16) + bf2f(y1.x >> 16);
            acc[vt][tt][2] += bf2f(y0.y & 0xffffu) + bf2f(y1.y & 0xffffu); acc[vt][tt][3] += bf2f(y0.y >> 16) + bf2f(y1.y >> 16);
            sm += (acc[vt][tt][0] + acc[vt][tt][1]) + (acc[vt][tt][2] + acc[vt][tt][3]); }
        sm += __shfl_xor(sm, 16); sm += __shfl_xor(sm, 32);
        const float mean = sm * (1.f / 64.f); float vs = 0.f;
#pragma unroll
        for (int vt = 0; vt < 4; ++vt)
#pragma unroll
            for (int j = 0; j < 4; ++j) { acc[vt][tt][j] -= mean; vs += acc[vt][tt][j] * acc[vt][tt][j]; }
        vs += __shfl_xor(vs, 16); vs += __shfl_xor(vs, 32);
        const float rstd = rsqrtf(vs * (1.f / 64.f) + 64e-5f), bon = ((const float*)(F.ws + WS_BON))[tok * 8 + h];
#pragma unroll
        for (int vt = 0; vt < 4; ++vt) { const int c = h * 64 + 16 * vt + 4 * fq;
            const u32x2 vv = *(const u32x2*)((const bf16_t*)(F.ws + WS_PV) + tok * 512 + c), gg = *(const u32x2*)((const bf16_t*)(F.ws + WS_PG) + tok * 512 + c);
            const f32x4 lg = *(const f32x4*)(a.in[I_LNG] + c), lb = *(const f32x4*)(a.in[I_LNB] + c);
            const float v4[4] = {bf2f(vv.x & 0xffffu), bf2f(vv.x >> 16), bf2f(vv.y & 0xffffu), bf2f(vv.y >> 16)}, g4[4] = {bf2f(gg.x & 0xffffu), bf2f(gg.x >> 16), bf2f(gg.y & 0xffffu), bf2f(gg.y >> 16)};
            float r[4];
#pragma unroll
            for (int j = 0; j < 4; ++j) r[j] = (acc[vt][tt][j] * rstd * lg[j] + lb[j] + bon * v4[j]) * g4[j];
            u32x2 o; o.x = cvt_pk(r[0], r[1]); o.y = cvt_pk(r[2], r[3]);
            *(u32x2*)((bf16_t*)(F.ws + WS_YRB) + tok * 512 + c) = o; }
    }
}

__device__ __forceinline__ f32x4 mma16(const LAS unsigned char* A, int sa, const LAS unsigned char* B, int sb, int K, f32x4 acc, int fr, int fq) {
#pragma unroll
    for (int k0 = 0; k0 < K; k0 += 32) {
        const bf16x8 av = *(const LAS bf16x8*)(A + fr * sa + (k0 + fq * 8) * 2);
        const bf16x8 bv = *(const LAS bf16x8*)(B + fr * sb + (k0 + fq * 8) * 2);
        acc = __builtin_amdgcn_mfma_f32_16x16x32_bf16(av, bv, acc, 0, 0, 0);
    }
    return acc;
}
typedef short v4i16_t __attribute__((ext_vector_type(4)));
__device__ __forceinline__ bf16x4 tr_frag(const LAS unsigned char* tile, int rs, int r0, int c0, int lane) {
    const int g = lane >> 4, q = (lane & 15) >> 2, p = lane & 3;
    return __builtin_bit_cast(bf16x4, __builtin_amdgcn_ds_read_tr16_b64_v4i16((LAS v4i16_t*)(tile + (r0 + 4 * g + q) * rs + (c0 + 4 * p) * 2)));
}
__device__ __forceinline__ int m_slot(int s, int dir, int h, int c) { return s < 16 ? (((s * 2 + dir) * 4 + h) * 2 + c) : 256 + ((((s - 16) * 2 + dir) * 4 + h) * 16 + c); }
__device__ __forceinline__ bf16_t* dc_ptr(unsigned char* ws, int slot) { return (bf16_t*)(ws + WS_DCC) + (size_t)slot * 16384; }
__device__ __forceinline__ float wave_max(float v) {
#pragma unroll
    for (int o = 1; o < 64; o <<= 1) v = fmaxf(v, __shfl_xor(v, o));
    return v;
}
constexpr int PA_K = 0, PA_V = 36864, PA_F = 73728, PA_S = 288, PA_SET = 75264;
__device__ __forceinline__ void pa_decode(int slot, int& dir, int& h, int& tok0) {
    int s, c;
    if (slot < 256) { const int hs = slot >> 1; c = slot & 1; s = hs >> 3; dir = (hs >> 2) & 1; h = hs & 3; } else { const int u2 = slot - 256, hs = u2 >> 4; c = u2 & 15; s = 16 + (hs >> 3); dir = (hs >> 2) & 1; h = hs & 3; }
    const int T = seq_len(s), oc = dir ? T / 128 - 1 - c : c; tok0 = seq_base(s) + oc * 128;
}
__device__ __forceinline__ void mlstm_passA(Frame& F, int slotA) {
    const int tid = F.tid, lane = F.lane, w = F.wave, fr = lane & 15, fq = lane >> 4;
    LAS unsigned char* L = F.lds;
    __syncthreads();
#pragma unroll
    for (int p = 0; p < 2; ++p) { int dir, h, tok0; pa_decode(slotA + 256 * p, dir, h, tok0);
        LAS unsigned char* Lp = L + p * PA_SET; LAS float* fv = (LAS float*)(Lp + PA_F);
        const bf16_t* MK = (const bf16_t*)(F.ws + WS_MK) + h * 128; const bf16_t* ZV = (const bf16_t*)(F.ws + WS_Z2) + Z2_V + h * 128;
        const int j = tid >> 2, part = tid & 3; const size_t tok = (size_t)(tok0 + j);
#pragma unroll
        for (int q = 0; q < 4; ++q) { const int c8 = part * 32 + q * 8;
            *(LAS u32x4*)(Lp + PA_K + j * PA_S + c8 * 2) = *(const u32x4*)(MK + tok * 512 + c8); *(LAS u32x4*)(Lp + PA_V + j * PA_S + c8 * 2) = *(const u32x4*)(ZV + tok * Z2C + c8); }
        if (tid < 128) fv[tid] = ((const float*)(F.ws + WS_LI) + (size_t)(dir * 4 + h) * NTOK)[tok0 + tid];
        else if (tid < 256) fv[tid] = ((const float*)(F.ws + WS_LF) + (size_t)(dir * 4 + h) * NTOK)[tok0 + tid - 128]; }
    __syncthreads();
    if (w < 2) {
        int dir, h, tok0; pa_decode(slotA + 256 * w, dir, h, tok0); (void)h; (void)tok0;
        LAS float* fv = (LAS float*)(L + w * PA_SET + PA_F); LAS float *vli = fv, *vlf = fv + 128, *vwj = fv + 256;
        const int op0 = dir ? 127 - 2 * lane : 2 * lane, op1 = dir ? op0 - 1 : op0 + 1;
        const float f0 = vlf[op0], f1 = vlf[op1]; float sc = f0 + f1;
#pragma unroll
        for (int o = 1; o < 64; o <<= 1) { const float t = __shfl_up(sc, o); if (lane >= o) sc += t; }
        const float b1 = sc, b0 = sc - f1, a0 = vli[op0] - b0, a1 = vli[op1] - b1, mx = wave_max(fmaxf(a0, a1)), bL = __shfl(b1, 63);
        vwj[op0] = __expf(a0 - mx); vwj[op1] = __expf(a1 - mx);
        if (lane == 0) { float* ms = (float*)(F.ws + WS_MS) + (size_t)(slotA + 256 * w) * 4; ms[0] = mx; ms[1] = bL; }
    }
    __syncthreads();
#pragma unroll
    for (int p = 0; p < 2; ++p) { const int slot = slotA + 256 * p;
        const LAS unsigned char* Lp = L + p * PA_SET; const LAS float* vwj = (const LAS float*)(Lp + PA_F) + 256;
        bf16x4 bv[8], bw[8];
#pragma unroll
        for (int sl = 0; sl < 8; ++sl) { const u32x2 r = __builtin_bit_cast(u32x2, tr_frag(Lp + PA_V, PA_S, 16 * sl, 16 * w, lane)); const f32x4 wj4 = *(const LAS f32x4*)(vwj + 16 * sl + 4 * fq);
            u32x2 o; o.x = cvt_pk(bf2f(r.x & 0xffffu) * wj4[0], bf2f(r.x >> 16) * wj4[1]); o.y = cvt_pk(bf2f(r.y & 0xffffu) * wj4[2], bf2f(r.y >> 16) * wj4[3]);
            bv[sl] = __builtin_bit_cast(bf16x4, o);
            u32x2 ow; ow.x = cvt_pk(wj4[0], wj4[1]); ow.y = cvt_pk(wj4[2], wj4[3]); bw[sl] = __builtin_bit_cast(bf16x4, ow); }
        bf16_t* dc = dc_ptr(F.ws, slot);
#pragma unroll
        for (int kt = 0; kt < 8; ++kt) {
            f32x4 acc = {0.f, 0.f, 0.f, 0.f};
#pragma unroll
            for (int sl = 0; sl < 8; sl += 2) acc = MM2(tr_frag(Lp + PA_K, PA_S, 16 * sl, 16 * kt, lane), bv[sl], tr_frag(Lp + PA_K, PA_S, 16 * sl + 16, 16 * kt, lane), bv[sl + 1], acc);
            u32x2 o; o.x = cvt_pk(acc[0], acc[1]); o.y = cvt_pk(acc[2], acc[3]);
            *(u32x2*)(dc + (size_t)(16 * w + fr) * 128 + 16 * kt + 4 * fq) = o; }
        { f32x4 acc = {0.f, 0.f, 0.f, 0.f};
#pragma unroll
            for (int sl = 0; sl < 8; sl += 2) acc = MM2(tr_frag(Lp + PA_K, PA_S, 16 * sl, 16 * w, lane), bw[sl], tr_frag(Lp + PA_K, PA_S, 16 * sl + 16, 16 * w, lane), bw[sl + 1], acc);
            if (fr == 0) *(f32x4*)((float*)(F.ws + WS_DN) + (size_t)slot * 128 + 16 * w + 4 * fq) = acc; }
    }
}
constexpr int C3_SC = 0, C3_K = 4096, C3_VT = 4096 + 34816, C3_CIN = 4096 + 2 * 34816, C3_S = 272;
__device__ __forceinline__ void mlstm_passC3(Frame& F, int ch) {
    const Args& a = *F.a;
    int s, h, cc;
    if (ch < 128) { s = ch >> 3; h = (ch >> 1) & 3; cc = ch & 1; } else { const int u2 = ch - 128; s = 16 + (u2 >> 6); h = (u2 >> 4) & 3; cc = u2 & 15; }
    const int sb = seq_base(s), nch = seq_len(s) / 128, tok0 = sb + cc * 128, tid = F.tid, lane = F.lane, st = F.wave, fr = lane & 15, fq = lane >> 4;
    const size_t tok = (size_t)(tok0 + 16 * st + fr);
    const bf16_t* MQ = (const bf16_t*)(F.ws + WS_MQ) + h * 128; const bf16_t* MK = (const bf16_t*)(F.ws + WS_MK) + h * 128;
    const int slotd[2] = {m_slot(s, 0, h, cc), m_slot(s, 1, h, nch - 1 - cc)};
    LAS unsigned char* L = F.lds; LAS float* scl_ = (LAS float*)(L + C3_SC);
    __syncthreads();
    {
        const int j = tid >> 2, part = tid & 3; const size_t tj = (size_t)(tok0 + j);
        const bf16_t* Z2v = (const bf16_t*)(F.ws + WS_Z2) + Z2_V + h * 128;
#pragma unroll
        for (int q = 0; q < 4; ++q) { const int c8 = part * 32 + q * 8;
            *(LAS u32x4*)(L + C3_K + j * C3_S + c8 * 2) = *(const u32x4*)(MK + tj * 512 + c8);
            const u32x4 v0 = *(const u32x4*)(Z2v + tj * Z2C + c8); const unsigned vw[4] = {v0.x, v0.y, v0.z, v0.w};
#pragma unroll
            for (int i = 0; i < 4; ++i) { *(LAS bf16_t*)(L + C3_VT + (c8 + 2 * i) * C3_S + j * 2) = (bf16_t)(vw[i] & 0xffffu); *(LAS bf16_t*)(L + C3_VT + (c8 + 2 * i + 1) * C3_S + j * 2) = (bf16_t)(vw[i] >> 16); } }
        if (F.wave < 2) {
            const int d = F.wave; LAS float* dv = scl_ + d * 512;
            const float m_in = ((const float*)(F.ws + WS_MS))[(size_t)slotd[d] * 4 + 2];
            const float* LI = (const float*)(F.ws + WS_LI) + (size_t)(d * 4 + h) * NTOK + tok0; const float* LF = (const float*)(F.ws + WS_LF) + (size_t)(d * 4 + h) * NTOK + tok0;
            const int op0 = d ? 127 - 2 * lane : 2 * lane, op1 = d ? op0 - 1 : op0 + 1;
            const float f0 = LF[op0], f1 = LF[op1]; float sc = f0 + f1;
#pragma unroll
            for (int o = 1; o < 64; o <<= 1) { const float t = __shfl_up(sc, o); if (lane >= o) sc += t; }
            const float b1 = sc, b0 = sc - f1, a0 = LI[op0] - b0, a1 = LI[op1] - b1;
            float mxp = fmaxf(a0, a1);
#pragma unroll
            for (int o = 1; o < 64; o <<= 1) { const float t = __shfl_up(mxp, o); if (lane >= o) mxp = fmaxf(mxp, t); }
            float mprev = __shfl_up(mxp, 1); if (lane == 0) mprev = -3.0e38f;
            const float M0 = fmaxf(m_in, fmaxf(mprev, a0)), M1 = fmaxf(m_in, mxp);
            dv[op0] = a0; dv[128 + op0] = M0; dv[256 + op0] = __expf(m_in - M0); dv[384 + op0] = __expf(-b0 - M0);
            dv[op1] = a1; dv[128 + op1] = M1; dv[256 + op1] = __expf(m_in - M1); dv[384 + op1] = __expf(-b1 - M1); } }
    bf16x8 qf[4];
#pragma unroll
    for (int ks = 0; ks < 4; ++ks) qf[ks] = *(const bf16x8*)(MQ + tok * 512 + 32 * ks + 8 * fq);
    __syncthreads();
    f32x4 ST[8];
#pragma unroll
    for (int jt = 0; jt < 8; ++jt) { f32x4 acc = {0.f, 0.f, 0.f, 0.f};
#pragma unroll
        for (int ks = 0; ks < 4; ++ks) acc = __builtin_amdgcn_mfma_f32_16x16x32_bf16(*(const LAS bf16x8*)(L + C3_K + (16 * jt + fr) * C3_S + (32 * ks + 8 * fq) * 2), qf[ks], acc, 0, 0, 0);
        ST[jt] = acc; }
    const int sl = 16 * st + fr;
    float hv[8][4];
#pragma unroll
    for (int vt = 0; vt < 8; ++vt)
#pragma unroll
        for (int jj = 0; jj < 4; ++jj) hv[vt][jj] = 0.f;
#pragma unroll 1
    for (int d = 0; d < 2; ++d) {
        const LAS float* dv = scl_ + d * 512;
        __syncthreads();
        { const bf16_t* cin = dc_ptr(F.ws, slotd[d]);
#pragma unroll
            for (int r = 0; r < 4; ++r) { const int idx = tid + 512 * r, row = idx >> 4, c8 = (idx & 15) * 8; *(LAS u32x4*)(L + C3_CIN + row * C3_S + c8 * 2) = *(const u32x4*)(cin + (size_t)row * 128 + c8); } }
        const float Ms = dv[128 + sl], inter = dv[256 + sl], eneg = dv[384 + sl];
        bf16x4 bS[8]; float rs = 0.f;
#pragma unroll
        for (int jt = 0; jt < 8; ++jt) { const f32x4 a4 = *(const LAS f32x4*)(dv + 16 * jt + 4 * fq); f32x4 v;
#pragma unroll
            for (int jj = 0; jj < 4; ++jj) { const int j = 16 * jt + 4 * fq + jj; const bool keep = d ? (j >= sl) : (j <= sl); v[jj] = keep ? ST[jt][jj] * __expf(a4[jj] - Ms) : 0.f; rs += v[jj]; }
            bS[jt] = to_b4(v); }
        rs += __shfl_xor(rs, 16); rs += __shfl_xor(rs, 32);
        float qn = 0.f; { const float* nd = (const float*)(F.ws + WS_DN) + (size_t)slotd[d] * 128;
#pragma unroll
            for (int ks = 0; ks < 4; ++ks) { float qv[8]; unpack8(__builtin_bit_cast(u32x4, qf[ks]), qv); const f32x4 n0 = *(const f32x4*)(nd + 32 * ks + 8 * fq), n1 = *(const f32x4*)(nd + 32 * ks + 8 * fq + 4);
#pragma unroll
                for (int i = 0; i < 4; ++i) qn += qv[i] * n0[i] + qv[4 + i] * n1[i]; } }
        qn += __shfl_xor(qn, 16); qn += __shfl_xor(qn, 32);
        const float scl = 1.f / fmaxf(fabsf(inter * qn + rs), eneg);
        __syncthreads();
#pragma unroll
        for (int vt = 0; vt < 8; ++vt) {
            f32x4 ai = {0.f, 0.f, 0.f, 0.f}, av = {0.f, 0.f, 0.f, 0.f};
#pragma unroll
            for (int ks = 0; ks < 4; ++ks) ai = __builtin_amdgcn_mfma_f32_16x16x32_bf16(*(const LAS bf16x8*)(L + C3_CIN + (16 * vt + fr) * C3_S + (32 * ks + 8 * fq) * 2), qf[ks], ai, 0, 0, 0);
#pragma unroll
            for (int jt = 0; jt < 8; jt += 2) av = MM2(*(const LAS bf16x4*)(L + C3_VT + (16 * vt + fr) * C3_S + (16 * jt + 4 * fq) * 2), bS[jt], *(const LAS bf16x4*)(L + C3_VT + (16 * vt + fr) * C3_S + (16 * jt + 16 + 4 * fq) * 2), bS[jt + 1], av);
#pragma unroll
            for (int jj = 0; jj < 4; ++jj) hv[vt][jj] += (inter * ai[jj] + av[jj]) * scl;
        }
    }
    float s1 = 0.f, s2 = 0.f;
#pragma unroll
    for (int vt = 0; vt < 8; ++vt)
#pragma unroll
        for (int jj = 0; jj < 4; ++jj) { s1 += hv[vt][jj]; s2 += hv[vt][jj] * hv[vt][jj]; }
    s1 += __shfl_xor(s1, 16); s1 += __shfl_xor(s1, 32); s2 += __shfl_xor(s2, 16); s2 += __shfl_xor(s2, 32);
    const float mean = s1 * (1.f / 128.f), rstd = rsqrtf(fmaxf(s2 * (1.f / 128.f) - mean * mean, 0.f) + 1e-5f);
#pragma unroll
    for (int vt = 0; vt < 8; ++vt) { const int c = h * 128 + 16 * vt + 4 * fq;
        const u32x2 ow = *(const u32x2*)((const bf16_t*)(F.ws + WS_Z2) + tok * Z2C + Z2_O + c); const f32x4 gg = *(const f32x4*)(a.in[I_MGNG] + c);
        const float o4[4] = {bf2f(ow.x & 0xffffu), bf2f(ow.x >> 16), bf2f(ow.y & 0xffffu), bf2f(ow.y >> 16)};
        u32x2 o; o.x = cvt_pk((hv[vt][0] - mean) * rstd * gg[0] * sigm(o4[0]), (hv[vt][1] - mean) * rstd * gg[1] * sigm(o4[1]));
        o.y = cvt_pk((hv[vt][2] - mean) * rstd * gg[2] * sigm(o4[2]), (hv[vt][3] - mean) * rstd * gg[3] * sigm(o4[3]));
        *(u32x2*)((bf16_t*)(F.ws + WS_YMB) + tok * 512 + c) = o; }
}
template <int EPT  , int NCH, int PF>
__device__ __forceinline__ void mlstm_prop_t(Frame& F, int s, int dir, int h, int slice) {
    const Args& a = *F.a;
    const int tid = F.tid, e0 = slice * (512 * EPT) + tid * EPT;
    const int slot0 = m_slot(s, dir, h, 0);
    float* MSp = (float*)(F.ws + WS_MS); float* DNp = (float*)(F.ws + WS_DN);
    LAS float* sc = (LAS float*)F.lds;
    __syncthreads();
    if (F.wave == 0) {
        float mx = 0.f, bL = 0.f; if (F.lane < NCH) { mx = MSp[(size_t)(slot0 + F.lane) * 4]; bL = MSp[(size_t)(slot0 + F.lane) * 4 + 1]; }
        float m = s >= 16 ? a.in[I_SM][((size_t)(s - 16) * 2 + dir) * 4 + h] : 0.f;
        for (int c = 0; c < NCH; ++c) { const float mxc = __shfl(mx, c), blc = __shfl(bL, c), Mf = fmaxf(m, mxc);
            if (F.lane == 0) { sc[2 * c] = __expf(m - Mf); sc[2 * c + 1] = __expf(mxc - Mf); if (slice == 0) MSp[(size_t)(slot0 + c) * 4 + 2] = m; }
            m = blc + Mf; }
        if (F.lane == 0 && slice == 0 && s < 16) F.out[OUT_SM + ((size_t)s * 2 + dir) * 4 + h] = m;
    }
    __syncthreads();
    float Cf[EPT];
    if (s >= 16) { const float* c0 = a.in[I_SC] + (((size_t)(s - 16) * 2 + dir) * 4 + h) * 16384 + e0;
#pragma unroll
        for (int i = 0; i < EPT / 4; ++i) { const f32x4 v = *(const f32x4*)(c0 + 4 * i); Cf[4 * i] = v.x; Cf[4 * i + 1] = v.y; Cf[4 * i + 2] = v.z; Cf[4 * i + 3] = v.w; }
    } else {
#pragma unroll
        for (int i = 0; i < EPT; ++i) Cf[i] = 0.f;
    }
    u32x2 ring[PF][EPT / 4];
#pragma unroll
    for (int u = 0; u < PF; ++u) { const bf16_t* dc = dc_ptr(F.ws, slot0 + u) + e0;
#pragma unroll
        for (int i = 0; i < EPT / 4; ++i) ring[u][i] = *(const u32x2*)(dc + 4 * i); }
    for (int c0 = 0; c0 < NCH; c0 += PF) {
#pragma unroll
        for (int u = 0; u < PF; ++u) { const int c = c0 + u; bf16_t* dcw = dc_ptr(F.ws, slot0 + c) + e0; const float e1 = sc[2 * c], e2 = sc[2 * c + 1];
#pragma unroll
            for (int i = 0; i < EPT / 4; ++i) { const u32x2 d = ring[u][i];
                u32x2 o; o.x = cvt_pk(Cf[4 * i], Cf[4 * i + 1]); o.y = cvt_pk(Cf[4 * i + 2], Cf[4 * i + 3]); *(u32x2*)(dcw + 4 * i) = o;
                Cf[4 * i] = e1 * Cf[4 * i] + e2 * bf2f(d.x & 0xffffu); Cf[4 * i + 1] = e1 * Cf[4 * i + 1] + e2 * bf2f(d.x >> 16);
                Cf[4 * i + 2] = e1 * Cf[4 * i + 2] + e2 * bf2f(d.y & 0xffffu); Cf[4 * i + 3] = e1 * Cf[4 * i + 3] + e2 * bf2f(d.y >> 16); }
            { const int cn = c + PF < NCH ? c + PF : NCH - 1; const bf16_t* dc = dc_ptr(F.ws, slot0 + cn) + e0;
#pragma unroll
                for (int i = 0; i < EPT / 4; ++i) ring[u][i] = *(const u32x2*)(dc + 4 * i); }
        }
    }
    if (slice == 0 && tid < 128) {
        float nf = s >= 16 ? a.in[I_SN][(((size_t)(s - 16) * 2 + dir) * 4 + h) * 128 + tid] : 0.f;
        float dn[NCH];
#pragma unroll
        for (int c = 0; c < NCH; ++c) dn[c] = DNp[(size_t)(slot0 + c) * 128 + tid];
#pragma unroll
        for (int c = 0; c < NCH; ++c) { DNp[(size_t)(slot0 + c) * 128 + tid] = nf; nf = sc[2 * c] * nf + sc[2 * c + 1] * dn[c]; }
        if (s < 16) F.out[OUT_SN + (((size_t)s * 2 + dir) * 4 + h) * 128 + tid] = nf;
    }
    if (s < 16) { float* co = F.out + OUT_SC + (((size_t)s * 2 + dir) * 4 + h) * 16384 + e0;
#pragma unroll
        for (int i = 0; i < EPT / 4; ++i) *(f32x4*)(co + 4 * i) = (f32x4){Cf[4 * i], Cf[4 * i + 1], Cf[4 * i + 2], Cf[4 * i + 3]}; }
}
__device__ __forceinline__ void p8_rows(Frame& F) {
    const Args& a = *F.a; const float* ng = a.in[I_NORMG];
    for (int row = F.gw; row < NTOK; row += F.NGW) {
        const f32x4* xr = (const f32x4*)xrow_ptr(a, row) + F.lane; const u32x2* orow = (const u32x2*)((const bf16_t*)(F.ws + WS_OUT1) + (size_t)row * D) + F.lane;
        const float* mod = (const float*)(F.ws + WS_MOD) + cond_of(row) * 6144;
        f32x4 v[4]; float ss = 0.f;
#pragma unroll
        for (int j = 0; j < 4; ++j) { const u32x2 p0 = orow[64 * j], p1 = orow[64 * j + (size_t)NTOK * D / 4];
            v[j] = (f32x4){bf2f(p0.x & 0xffffu) + bf2f(p1.x & 0xffffu), bf2f(p0.x >> 16) + bf2f(p1.x >> 16), bf2f(p0.y & 0xffffu) + bf2f(p1.y & 0xffffu), bf2f(p0.y >> 16) + bf2f(p1.y >> 16)};
            ss += (v[j].x * v[j].x + v[j].y * v[j].y) + (v[j].z * v[j].z + v[j].w * v[j].w); }
        const float rstd = rsqrtf(wave_sum(ss) * (1.f / D) + 1e-6f);
        u32x2* x1o = (u32x2*)((bf16_t*)(F.ws + WS_X1B) + (size_t)row * D) + F.lane; ss = 0.f;
#pragma unroll
        for (int j = 0; j < 4; ++j) { const int col = 4 * (64 * j + F.lane);
            const f32x4 g = *(const f32x4*)(ng + 1024 + col), g1 = *(const f32x4*)(mod + 2048 + col);
            v[j] = xr[64 * j] + g1 * (v[j] * rstd * g); { u32x2 w; w.x = cvt_pk(v[j].x, v[j].y); w.y = cvt_pk(v[j].z, v[j].w); x1o[64 * j] = w; }
            ss += (v[j].x * v[j].x + v[j].y * v[j].y) + (v[j].z * v[j].z + v[j].w * v[j].w); }
        const float rstd2 = rsqrtf(wave_sum(ss) * (1.f / D) + 1e-6f);
        u32x2* o = (u32x2*)((bf16_t*)(F.ws + WS_H) + (size_t)row * D) + F.lane;
#pragma unroll
        for (int j = 0; j < 4; ++j) { const int col = 4 * (64 * j + F.lane);
            const f32x4 g = *(const f32x4*)(ng + 2048 + col), sh = *(const f32x4*)(mod + 3072 + col), sc = *(const f32x4*)(mod + 4096 + col);
            const f32x4 h = v[j] * rstd2 * g * (sc + 1.f) + sh;
            u32x2 w; w.x = pk2(h.x, h.y); w.y = pk2(h.z, h.w); o[64 * j] = w; }
    }
}

template <int NT>
__device__ __forceinline__ void p10_item(Frame& F, int tok0, int c8) {
    const Args& a = *F.a;
    const bf16_t* U = (const bf16_t*)(F.ws + WS_Z); bf16_t* FIN = (bf16_t*)(F.ws + WS_FIN);
    const int uc = 256 * (c8 >> 7) + (c8 & 127);
    const int t0 = (tok0 - NCTX) & 2047, y = t0 >> 6, x0 = t0 & 63;
    const float* cw = a.in[I_FCONV] + c8;
    u32x4 vraw[NT];
#pragma unroll
    for (int jj = 0; jj < NT; ++jj) vraw[jj] = *(const u32x4*)(U + (size_t)(tok0 + jj) * UPC + uc + 128);
    float acc[NT][8];
    { const f32x4 b0 = *(const f32x4*)(a.in[I_FCB] + c8), b1 = *(const f32x4*)(a.in[I_FCB] + c8 + 4);
#pragma unroll
        for (int jj = 0; jj < NT; ++jj) { acc[jj][0] = b0[0]; acc[jj][1] = b0[1]; acc[jj][2] = b0[2]; acc[jj][3] = b0[3]; acc[jj][4] = b1[0]; acc[jj][5] = b1[1]; acc[jj][6] = b1[2]; acc[jj][7] = b1[3]; } }
#pragma unroll 1
    for (int dy = -1; dy <= 1; ++dy) {
        const bool rowok = y + dy >= 0 && y + dy < 32;
        if (!rowok) continue;
        float wt[3][8];
#pragma unroll
        for (int dx = 0; dx < 3; ++dx) { const f32x4 w0 = *(const f32x4*)(cw + ((dy + 1) * 3 + dx) * DFF), w1 = *(const f32x4*)(cw + ((dy + 1) * 3 + dx) * DFF + 4);
#pragma unroll
            for (int e = 0; e < 4; ++e) { wt[dx][e] = w0[e]; wt[dx][4 + e] = w1[e]; } }
#pragma unroll
        for (int i = 0; i < NT + 2; ++i) { const int xx = x0 - 1 + i; const bool ok = xx >= 0 && xx < 64;
            float xv[8]; unpack8(*(const u32x4*)(U + ((long)(tok0 + dy * 64) + (i - 1)) * UPC + uc), xv);
            const float cm = ok ? 1.f : 0.f;
#pragma unroll
            for (int dx = -1; dx <= 1; ++dx) { const int jj = i - 1 - dx;
                if (jj >= 0 && jj < NT) {
#pragma unroll
                    for (int e = 0; e < 8; ++e) acc[jj][e] += (wt[dx + 1][e] * cm) * xv[e]; } }
        }
    }
#pragma unroll
    for (int jj = 0; jj < NT; ++jj) { float x[8]; unpack8(vraw[jj], x);
        u32x4 o; o.x = cvt_pk(silu(acc[jj][0]) * x[0], silu(acc[jj][1]) * x[1]); o.y = cvt_pk(silu(acc[jj][2]) * x[2], silu(acc[jj][3]) * x[3]);
        o.z = cvt_pk(silu(acc[jj][4]) * x[4], silu(acc[jj][5]) * x[5]); o.w = cvt_pk(silu(acc[jj][6]) * x[6], silu(acc[jj][7]) * x[7]);
        *(u32x4*)(FIN + (size_t)(tok0 + jj) * DFF + c8) = o; }
}
__device__ __forceinline__ void p10_ffn_conv(Frame& F) {
    const int t = (int)blockIdx.x * 512 + F.tid;
    { const int sl = t / 352, c8 = (t - sl * 352) * 8; p10_item<8>(F, NCTX + sl * 8, c8); }
    asm volatile("" ::: "memory"); __builtin_amdgcn_sched_barrier(0);
    if (t < 98304) { const int it = 131072 + (t >> 1), sl = it / 352, c8 = (it - sl * 352) * 8; p10_item<4>(F, NCTX + sl * 8 + 4 * (t & 1), c8); }
}

__device__ __forceinline__ void p12_final(Frame& F) {
    const Args& a = *F.a; const float* ng = a.in[I_NORMG];
    for (int row = F.gw; row < NTOK; row += F.NGW) {
        const u32x2* fr_ = (const u32x2*)((const bf16_t*)(F.ws + WS_Z) + (size_t)row * D) + F.lane; f32x4* xo = (f32x4*)(F.out + (size_t)row * D) + F.lane;
        const float* mod = (const float*)(F.ws + WS_MOD) + cond_of(row) * 6144;
        f32x4 v[4]; float ss = 0.f;
#pragma unroll
        for (int j = 0; j < 4; ++j) { const u32x2 p0 = fr_[64 * j], p1 = fr_[64 * j + (size_t)NTOK * D / 4];
            v[j] = (f32x4){bf2f(p0.x & 0xffffu) + bf2f(p1.x & 0xffffu), bf2f(p0.x >> 16) + bf2f(p1.x >> 16), bf2f(p0.y & 0xffffu) + bf2f(p1.y & 0xffffu), bf2f(p0.y >> 16) + bf2f(p1.y >> 16)}; ss += (v[j].x * v[j].x + v[j].y * v[j].y) + (v[j].z * v[j].z + v[j].w * v[j].w); }
        const float rstd = rsqrtf(wave_sum(ss) * (1.f / D) + 1e-6f);
#pragma unroll
        for (int j = 0; j < 4; ++j) { const int col = 4 * (64 * j + F.lane);
            const f32x4 g = *(const f32x4*)(ng + 3072 + col), g2 = *(const f32x4*)(mod + 5120 + col);
            const u32x2 xw = ((const u32x2*)((const bf16_t*)(F.ws + WS_X1B) + (size_t)row * D) + F.lane)[64 * j];
            const f32x4 x1 = {bf2f(xw.x & 0xffffu), bf2f(xw.x >> 16), bf2f(xw.y & 0xffffu), bf2f(xw.y >> 16)};
            xo[64 * j] = x1 + g2 * (v[j] * rstd * g); }
    }
}

__global__ void __launch_bounds__(512, 2) trunk_fwd(Args args) {
    extern __shared__ __attribute__((aligned(16))) unsigned char lds_raw[];
    Frame F;
    F.lds = (LAS unsigned char*)lds_raw; F.a = &args;
    F.tid = threadIdx.x; F.lane = F.tid & 63; F.wave = __builtin_amdgcn_readfirstlane(F.tid >> 6);
    F.G = gridDim.x; { const int bx = blockIdx.x; F.vcu = (F.G % 8 == 0) ? (bx % 8) * (F.G / 8) + bx / 8 : bx; }
    F.gw = F.vcu * 8 + F.wave; F.NGW = F.G * 8;
    F.ws = args.ws; F.out = args.out;
    volatile LAS unsigned* MISC = (volatile LAS unsigned*)(F.lds + MISC_OFF);
    if (F.tid < 64) MISC[F.tid] = 0u;
    __syncthreads();
    XcdBarrier bar = xcd_barrier_post((unsigned*)(F.ws + WS_CTL) + 4096, MISC + 8);
#ifndef PROBE_MASK
#define PROBE_MASK 0
#endif
#define RELANE() do { int t_ = threadIdx.x; asm volatile("" : "+v"(t_)); F.tid = t_; F.lane = t_ & 63; } while (0)
#define PH(k, ...) do { { RELANE(); __VA_ARGS__ } if (((PROBE_MASK) >> (k)) & 1) { xcd_barrier(bar); { RELANE(); __VA_ARGS__ } } if ((k) != NPH - 1) xcd_barrier(bar); } while (0)
    PH(0, p0_prologue(F);
        if (F.tid == 0) { unsigned sp = 0; unsigned* cnt = (unsigned*)(F.ws + WS_CTL) + 1024;
            while (__hip_atomic_load(cnt, __ATOMIC_RELAXED, __HIP_MEMORY_SCOPE_AGENT) < 96u) { __builtin_amdgcn_s_sleep(2); if (++sp > (1u << 22)) break; }
            __builtin_amdgcn_fence(__ATOMIC_ACQUIRE, "agent"); asm volatile("s_waitcnt vmcnt(0)" ::: "memory"); }
        __syncthreads();
        p1_h1(F););
    PH(1, const pg8::Gemm g{D, D, D}; pg8::StaticOrder S; S.init(NTOK, ZC, 1, F.G, (int)blockIdx.x, g, (const bf16_t*)(F.ws + WS_H), (const bf16_t*)(F.ws + WS_WIN), nullptr, nullptr);
        pg8::EpiBf16 E{(bf16_t*)(F.ws + WS_Z1), Z1C, (bf16_t*)(F.ws + WS_Z2), 12}; pg8::gemm_phase(F.lds, g, S, E, F.tid););
#ifndef PROBE_XBAR
#define PROBE_XBAR 0
#endif
    for (int xb_ = 0; xb_ < PROBE_XBAR; ++xb_) xcd_barrier(bar);
    PH(2, p3_prep(F););
#ifndef PROBE_P3
#define PROBE_P3 0
#endif
    if (PROBE_P3) { RELANE(); p3_prep<(PROBE_P3 ? PROBE_P3 : 7)>(F); xcd_barrier(bar); }
    PH(3, mlstm_passA(F, (int)blockIdx.x); __syncthreads(); { const int u = (int)blockIdx.x * 8 + F.wave; rwkv_pass1(F, u); });
#ifndef PROBE_P1
#define PROBE_P1 (-1)
#endif
    if (PROBE_P1 >= 0) { RELANE(); const int u = (int)blockIdx.x * 8 + F.wave; rwkv_pass1<(PROBE_P1 < 0 ? 0 : PROBE_P1)>(F, u); xcd_barrier(bar); }
    PH(4, const int bi = blockIdx.x;
        if (bi < 128) { const int u = bi >> 3; mlstm_prop_t<4, 16, 8>(F, 16 + (u >> 3), (u >> 2) & 1, u & 3, bi & 7); rwkv_prop_lat(F, (((bi & 7) * 4 + (bi >> 5)) << 2) | ((bi >> 3) & 3)); }
        else { const int v = bi - 128; mlstm_prop_t<32, 2, 2>(F, v >> 3, (v >> 2) & 1, v & 3, 0); rwkv_prop(F, 128 + v * 8 + F.wave); });
    PH(5, { mlstm_passC3(F, (int)blockIdx.x); rwkv_fix(F, (int)blockIdx.x * 8 + F.wave); });
    PH(6, const pg8::Gemm g{512, 512, 512}; pg8::StaticOrder S;
        S.init(NTOK, D, 2, F.G, (int)blockIdx.x, g, (const bf16_t*)(F.ws + WS_YRB), (const bf16_t*)(F.ws + WS_WBR), (const bf16_t*)(F.ws + WS_YMB), (const bf16_t*)(F.ws + WS_WBM));
        pg8::EpiGate E{(bf16_t*)(F.ws + WS_PRM), (const bf16_t*)(F.ws + WS_Z2), Z2_GR}; pg8::gemm_phase(F.lds, g, S, E, F.tid););
    PH(7, const pg8::Gemm g{D, D, D}; pg8::StaticOrder S;
        S.init(NTOK, D, 2, F.G, (int)blockIdx.x, g, (const bf16_t*)(F.ws + WS_PRM), (const bf16_t*)(F.ws + WS_WOUT), (const bf16_t*)(F.ws + WS_PRM) + (size_t)NTOK * D, (const bf16_t*)(F.ws + WS_WOUT));
        pg8::EpiBf16 E{(bf16_t*)(F.ws + WS_OUT1), D, (bf16_t*)(F.ws + WS_OUT1), 1 << 20}; pg8::gemm_phase(F.lds, g, S, E, F.tid););
    PH(8, p8_rows(F););
    PH(9, const pg8::Gemm g{D, D, D}; pg8::StaticOrder S; S.init(NTOK, UPC, 1, F.G, (int)blockIdx.x, g, (const bf16_t*)(F.ws + WS_H), (const bf16_t*)(F.ws + WS_WUP), nullptr, nullptr);
        pg8::EpiFfnUp E{(bf16_t*)(F.ws + WS_Z), (bf16_t*)(F.ws + WS_FIN), F.a->in[I_FCONV], F.a->in[I_FCB], (LAS float*)(F.lds + 131072)}; pg8::gemm_phase(F.lds, g, S, E, F.tid);
        if (blockIdx.x >= 192) { LAS float* scr = (LAS float*)(F.lds + F.wave * 8448);
            for (int it = ((int)blockIdx.x - 192) * 8 + F.wave; it < 44 * 32; it += 512) transpose_item(0, F.a->in[I_FDN], 2816, 1024, (bf16_t*)(F.ws + WS_WDN), 32, scr, it, F.lane); });
    PH(10, p10_ffn_conv(F););
    PH(11, const pg8::Gemm g{DFF / 2, DFF, DFF}; pg8::StaticOrder S;
        S.init(NTOK, D, 2, F.G, (int)blockIdx.x, g, (const bf16_t*)(F.ws + WS_FIN), (const bf16_t*)(F.ws + WS_WDN), (const bf16_t*)(F.ws + WS_FIN) + DFF / 2, (const bf16_t*)(F.ws + WS_WDN) + DFF / 2);
        pg8::EpiBf16 E{(bf16_t*)(F.ws + WS_Z), D, (bf16_t*)(F.ws + WS_Z), 1 << 20}; pg8::gemm_phase(F.lds, g, S, E, F.tid););
    PH(12, p12_final(F););
#undef PH
}

extern "C" void kernel_launch(void* const* d_in, const int* in_sizes, int n_in, void* d_out, int out_size, void* d_ws, size_t ws_size, hipStream_t stream) {
    if (n_in != 33 || (size_t)out_size != OUT_TOTAL || ws_size < WS_END) {
        fprintf(stderr, "kernel_launch: unexpected problem (n_in %d, out %d, ws %zu)\n", n_in, out_size, ws_size); return; }
    (void)hipFuncSetAttribute((const void*)trunk_fwd, hipFuncAttributeMaxDynamicSharedMemorySize, LDS_BYTES);
    (void)hipMemsetAsync((char*)d_ws + WS_CTL, 0, CTL_ZERO_BYTES, stream);
    Args a{};
    for (int i = 0; i < 33; ++i) a.in[i] = (const float*)d_in[i];
    a.out = (float*)d_out; a.ws = (unsigned char*)d_ws;
    a.ph_lo = 0; a.ph_hi = NPH;
    hipLaunchKernelGGL(trunk_fwd, dim3(256), dim3(512), LDS_BYTES, stream, a);
}
```

```cpp
#include <hip/hip_runtime.h>
#include <cstdio>
#include <cstdint>

#define GAS __attribute__((address_space(1)))
#define LAS __attribute__((address_space(3)))
typedef unsigned short bf16_t;
typedef short bf16x8 __attribute__((ext_vector_type(8)));
typedef float f32x4 __attribute__((ext_vector_type(4)));
typedef float f32x2 __attribute__((ext_vector_type(2)));
typedef unsigned u32x4 __attribute__((ext_vector_type(4)));
typedef unsigned u32x2 __attribute__((ext_vector_type(2)));

#ifndef MK_ONE_LAUNCH
#define MK_ONE_LAUNCH 1
#endif

constexpr int D = 1024, NTOK = 8192, NCTX = 4096;
constexpr int ZC = 6144;
constexpr int DFF = 2816, UPC = 5632;
constexpr int NPH = 13;
constexpr int ZR_R = 0, ZR_K = 512, ZR_V = 1024, ZR_WD = 1536, ZR_AD = 1664, ZR_GD = 1792;
constexpr int Z1C = 3072, Z2C = 3072;
constexpr int ZM_Q = 1920, ZM_K = 2432, ZM_G = 2944;
constexpr int Z2_V = 0, Z2_O = 512, Z2_GR = 1024, Z2_GM = 2048;

constexpr size_t MiB = 1u << 20;
constexpr size_t WS_CTL = 0, CTL_ZERO_BYTES = 64 * 1024;
constexpr size_t WS_MOD = 1 * MiB;
constexpr size_t WS_LI = 1 * MiB + 256 * 1024;
constexpr size_t WS_LF = 1 * MiB + 512 * 1024;
constexpr size_t WS_BON = 1 * MiB + 768 * 1024;
constexpr size_t WS_WIN = 2 * MiB;
constexpr size_t WS_WBR = 14 * MiB;
constexpr size_t WS_WBM = 15 * MiB;
constexpr size_t WS_WOUT = 16 * MiB;
constexpr size_t WS_WUP = 18 * MiB;
constexpr size_t WS_WDN = 29 * MiB;
constexpr size_t WS_H = 35 * MiB;
constexpr size_t WS_Z = 51 * MiB;
constexpr size_t WS_Z1 = WS_Z, WS_Z2 = WS_Z + 48 * MiB;
constexpr size_t WS_P = 147 * MiB;
constexpr size_t WS_PR = WS_P, WS_PV = WS_P + 8 * MiB, WS_PKK = WS_P + 16 * MiB;
constexpr size_t WS_PW = WS_P + 24 * MiB, WS_PKD = WS_P + 40 * MiB, WS_PB = WS_P + 56 * MiB;
constexpr size_t WS_PG = WS_P + 72 * MiB;
constexpr size_t WS_YRB = WS_P, WS_YMB = WS_P + 16 * MiB;
constexpr size_t WS_FIN = WS_P;
constexpr size_t WS_MQ = 227 * MiB, WS_MK = 235 * MiB;
constexpr size_t WS_DCC = WS_Z1 + 32 * MiB;
constexpr size_t WS_DCL = WS_H;
constexpr size_t WS_PRM = WS_Z1;
constexpr size_t WS_OUT1 = WS_P;
constexpr size_t WS_X1B = WS_P + 64 * MiB;
constexpr size_t WS_SP = WS_Z1;
constexpr size_t WS_DN = 243 * MiB;
constexpr size_t WS_MS = 243 * MiB + 512 * 1024;
constexpr size_t WS_WUPT = 243 * MiB + 576 * 1024, WS_AUPT = WS_WUPT + 131072, WS_GUPT = WS_WUPT + 262144;
constexpr size_t WS_END = 244 * MiB;
constexpr size_t OUT_YP = 0, OUT_SR = 8388608, OUT_SC = OUT_SR + 1048576, OUT_SN = OUT_SC + 2097152, OUT_SM = OUT_SN + 16384, OUT_TOTAL = OUT_SM + 128;

constexpr int LDS_BYTES = 163840;
constexpr int MISC_OFF = LDS_BYTES - 256;

#define LDS_WAIT() asm volatile("s_waitcnt lgkmcnt(0)" ::: "memory")
#define VM_WAIT() asm volatile("s_waitcnt vmcnt(0)" ::: "memory")

__device__ __forceinline__ float bf2f(unsigned v) { return __builtin_bit_cast(float, v << 16); }
__device__ __forceinline__ unsigned f2bf(float f) { unsigned u = __builtin_bit_cast(unsigned, f); return (u + 0x7fffu + ((u >> 16) & 1u)) >> 16; }
typedef __bf16 bf16v2_t __attribute__((ext_vector_type(2)));
__device__ __forceinline__ unsigned cvt_pk(float lo, float hi) { const f32x2 v = {lo, hi}; return __builtin_bit_cast(unsigned, __builtin_convertvector(v, bf16v2_t)); }
__device__ __forceinline__ unsigned pk2(float lo, float hi) { return cvt_pk(lo, hi); }
__device__ __forceinline__ void st16_wt(void* p, const u32x4 v) { asm volatile("global_store_dwordx4 %0, %1, off sc1\n\ts_nop 1" :: "v"(p), "v"(v) : "memory"); }
__device__ __forceinline__ float sigm(float x) { return __builtin_amdgcn_rcpf(1.f + __expf(-x)); }
__device__ __forceinline__ float silu(float x) { return x * __builtin_amdgcn_rcpf(1.f + __expf(-x)); }
__device__ __forceinline__ float wave_sum(float v) {
#pragma unroll
    for (int o = 1; o < 64; o <<= 1) v += __shfl_xor(v, o);
    return v;
}
__device__ __forceinline__ void unpack8(const u32x4 w, float (&f)[8]) {
    f[0] = bf2f(w.x & 0xffffu); f[1] = bf2f(w.x >> 16); f[2] = bf2f(w.y & 0xffffu); f[3] = bf2f(w.y >> 16);
    f[4] = bf2f(w.z & 0xffffu); f[5] = bf2f(w.z >> 16); f[6] = bf2f(w.w & 0xffffu); f[7] = bf2f(w.w >> 16);
}
__device__ __forceinline__ u32x4 pack8(const float (&f)[8]) { u32x4 w; w.x = pk2(f[0], f[1]); w.y = pk2(f[2], f[3]); w.z = pk2(f[4], f[5]); w.w = pk2(f[6], f[7]); return w; }

#define XB_TMO      128
#define XB_XCNT(j)  (256  + 64 * (j))
#define XB_XSUB(j)  (1280 + 64 * (j))
#define XB_XGEN(j)  (2304 + 64 * (j))
#define XB_TOP      3328
#define XB_TOPGEN   3392
#define XCD_BAR_WORDS 3456
#define XB_SPIN_CAP (1u << 22)
__device__ __forceinline__ unsigned xb_ld(unsigned* p)              { return __hip_atomic_load(p, __ATOMIC_RELAXED, __HIP_MEMORY_SCOPE_AGENT); }
__device__ __forceinline__ unsigned xb_add(unsigned* p, unsigned v) { return __hip_atomic_fetch_add(p, v, __ATOMIC_RELAXED, __HIP_MEMORY_SCOPE_AGENT); }
__device__ __forceinline__ unsigned xb_xcc_id() { return (unsigned)__builtin_amdgcn_s_getreg((3 << 11) | 20) & 0xFu; }
#define XB_SPIN(cond, bar) do { unsigned _sp = 0; while (cond) { __builtin_amdgcn_s_sleep(1); \
    if ((++_sp & 255u) == 0u) { if (xb_ld(&(bar)[XB_TMO])) break; if (_sp > XB_SPIN_CAP) { atomicAdd(&(bar)[XB_TMO], 1u); break; } } } } while (0)
struct XcdBarrier { unsigned* bar; unsigned x; volatile LAS unsigned* st; };
__device__ __forceinline__ XcdBarrier xcd_barrier_post(unsigned* bar, volatile LAS unsigned* st) {
    XcdBarrier b; b.bar = bar; b.x = xb_xcc_id(); b.st = st;
    if (threadIdx.x == 0) (void)xb_add(&bar[XB_XCNT(b.x)], 1u);
    return b;
}
__device__ __forceinline__ void xcd_barrier_complete(unsigned* bar, unsigned x, unsigned& nloc, unsigned& nx) {
    const unsigned G = gridDim.x * gridDim.y * gridDim.z;
    unsigned sum, cnt, mine, sp = 0u;
    for (;;) {
        sum = 0u; cnt = 0u; mine = 0u;
#pragma unroll
        for (unsigned j = 0; j < 16; ++j) { const unsigned c = xb_ld(&bar[XB_XCNT(j)]); sum += c; cnt += (c > 0u) ? 1u : 0u; mine = (j == x) ? c : mine; }
        if (sum == G) break;
        __builtin_amdgcn_s_sleep(1);
        if ((++sp & 255u) == 0u) { if (xb_ld(&bar[XB_TMO])) break; if (sp > XB_SPIN_CAP) { atomicAdd(&bar[XB_TMO], 1u); break; } }
    }
    nloc = mine > 0u ? mine : 1u; nx = cnt > 0u ? cnt : 1u;
}
__device__ __forceinline__ void xcd_barrier(const XcdBarrier& b) {
    asm volatile("s_waitcnt vmcnt(0)" ::: "memory");
    __syncthreads();
    if (threadIdx.x == 0) {
        unsigned* bar = b.bar;
        __builtin_amdgcn_s_waitcnt(0);
        unsigned nloc = b.st[0], nx = b.st[1];
        if (nloc == 0u) { xcd_barrier_complete(bar, b.x, nloc, nx); b.st[0] = nloc; b.st[1] = nx; }
        const unsigned old = xb_add(&bar[XB_XSUB(b.x)], 1u);
        const unsigned gen = old / nloc;
        if (old + 1u == (gen + 1u) * nloc) {
            __builtin_amdgcn_fence(__ATOMIC_RELEASE, "agent");
            asm volatile("s_waitcnt vmcnt(0)" ::: "memory");
            const unsigned og = xb_add(&bar[XB_TOP], 1u);
            const unsigned tg = og / nx;
            if (og + 1u == (tg + 1u) * nx) {
#pragma unroll
                for (unsigned j = 0; j < 16; ++j) (void)__hip_atomic_fetch_add(&bar[XB_XGEN(j)], 1u, __ATOMIC_RELAXED, __HIP_MEMORY_SCOPE_AGENT);
            } else XB_SPIN(xb_ld(&bar[XB_XGEN(b.x)]) == gen, bar);
            __builtin_amdgcn_fence(__ATOMIC_ACQUIRE, "agent");
            asm volatile("s_waitcnt vmcnt(0)" ::: "memory");
        } else {
            XB_SPIN(xb_ld(&bar[XB_XGEN(b.x)]) == gen, bar);
            __builtin_amdgcn_fence(__ATOMIC_ACQUIRE, "agent");
            asm volatile("s_waitcnt vmcnt(0)" ::: "memory");
        }
    }
    __syncthreads();
}

__device__ __forceinline__ float dpp_ror1(float v) { return __builtin_bit_cast(float, __builtin_amdgcn_update_dpp(0, __builtin_bit_cast(int, v), 0x121, 0xF, 0xF, false)); }
__device__ __forceinline__ float dpp_rol1(float v) { return __builtin_bit_cast(float, __builtin_amdgcn_update_dpp(0, __builtin_bit_cast(int, v), 0x12F, 0xF, 0xF, false)); }
namespace pg8 {
constexpr int BM = 256, BK = 64, HALF = 128, HTB = HALF * BK * 2, STAGE_BYTES = 8 * HTB, NXCD = 8, WGM = 8;
__host__ __device__ __forceinline__ int lds_byte(int r, int c) { const int st = (r >> 4) * 2 + (c >> 5), rr = r & 15, cc = c & 31, ob = rr * 64 + cc * 2; return st * 1024 + (ob ^ (((ob >> 9) & 1) << 5)); }
__host__ __device__ __forceinline__ void stage_rc(int b, int& R, int& C) { const int st = b / 1024, sb = b % 1024, swz = sb ^ (((sb >> 9) & 1) << 5); R = (st >> 1) * 16 + swz / 64; C = (st & 1) * 32 + (swz % 64) / 2; }
__host__ __device__ __forceinline__ int perm32(int rho) { const int n = rho >> 4, i = rho & 15; return 8 * (i >> 2) + 4 * n + (i & 3); }
struct Unit { const char* a; const char* b; int pm, pn, z; };
struct Gemm { int K, lda, ldb; };
struct StaticOrder {
    int nM, nN, nZ, nwg, G, c, lda, ldb; const bf16_t* Az[2]; const bf16_t* Bz[2];
    __device__ void init(int M, int N, int nZ_, int G_, int c_, const Gemm& g, const bf16_t* A0, const bf16_t* B0, const bf16_t* A1, const bf16_t* B1) {
        nM = M / BM; nZ = nZ_; nN = (N / BM) * nZ_; nwg = nM * nN; G = G_; c = c_; lda = g.lda; ldb = g.ldb; Az[0] = A0; Az[1] = A1; Bz[0] = B0; Bz[1] = B1; }
    __device__ bool next(int i, Unit& u) const {
        const long L = (long)i * G + c; if (L >= nwg) return false;
        int wgid = (int)L; { const int q = nwg / NXCD, r = nwg % NXCD, xcd = wgid % NXCD, off = wgid / NXCD; wgid = (xcd < r ? xcd * (q + 1) : r * (q + 1) + (xcd - r) * q) + off; }
        const int nig = WGM * nN, gid = wgid / nig, fm = gid * WGM, gsz = (nM - fm) < WGM ? (nM - fm) : WGM;
        u.pm = fm + ((wgid % nig) % gsz); const int pnz = (wgid % nig) / gsz; u.pn = pnz / nZ; u.z = pnz - u.pn * nZ;
        u.a = (const char*)(u.z ? Az[1] : Az[0]) + (size_t)u.pm * BM * lda * 2; u.b = (const char*)(u.z ? Bz[1] : Bz[0]) + (size_t)u.pn * BM * ldb * 2; return true;
    }
};

struct EpiBf16 {
    static constexpr bool PERM = true;
    bf16_t* O; int ldc; bf16_t* O2; int split_pn;
    __device__ __forceinline__ void operator()(const f32x4 (&acc)[2][2][4][2], const Unit& u, int wr, int wc, int fr, int fq) const {
        const bool hi = u.pn >= split_pn; bf16_t* Ob = (hi ? O2 : O) + (size_t)u.z * NTOK * ldc;
        const int row0 = u.pm * BM + wr * 64 + fr, col0 = (hi ? u.pn - split_pn : u.pn) * BM + wc * 32 + 8 * fq;
#pragma unroll
        for (int ai = 0; ai < 2; ++ai)
#pragma unroll
            for (int m = 0; m < 4; ++m) { bf16_t* rowp = Ob + (size_t)(row0 + ai * HALF + m * 16) * ldc + col0;
#pragma unroll
                for (int bj = 0; bj < 2; ++bj) { const f32x4 v0 = acc[ai][bj][m][0], v1 = acc[ai][bj][m][1];
                    u32x4 w; w.x = pk2(v0[0], v0[1]); w.y = pk2(v0[2], v0[3]); w.z = pk2(v1[0], v1[1]); w.w = pk2(v1[2], v1[3]);
                    st16_wt(rowp + bj * HALF, w); } }
    }
};
struct EpiGate {
    static constexpr bool PERM = true;
    bf16_t* O; const bf16_t* Z; int gcol0;
    __device__ __forceinline__ void operator()(const f32x4 (&acc)[2][2][4][2], const Unit& u, int wr, int wc, int fr, int fq) const {
        const int row0 = u.pm * BM + wr * 64 + fr, col0 = u.pn * BM + wc * 32 + 8 * fq;
        bf16_t* Ob = O + (size_t)u.z * NTOK * D; const int gc = gcol0 + u.z * D;
#pragma unroll
        for (int ai = 0; ai < 2; ++ai)
#pragma unroll
            for (int m = 0; m < 4; ++m) { const int row = row0 + ai * HALF + m * 16; bf16_t* rowp = Ob + (size_t)row * D + col0; const bf16_t* gp = Z + (size_t)row * Z2C + gc + col0;
#pragma unroll
                for (int bj = 0; bj < 2; ++bj) { const f32x4 v0 = acc[ai][bj][m][0], v1 = acc[ai][bj][m][1];
                    float g[8]; unpack8(*(const u32x4*)(gp + bj * HALF), g);
                    u32x4 w; w.x = cvt_pk(v0[0] * sigm(g[0]), v0[1] * sigm(g[1])); w.y = cvt_pk(v0[2] * sigm(g[2]), v0[3] * sigm(g[3]));
                    w.z = cvt_pk(v1[0] * sigm(g[4]), v1[1] * sigm(g[5])); w.w = cvt_pk(v1[2] * sigm(g[6]), v1[3] * sigm(g[7]));
                    *(u32x4*)(rowp + bj * HALF) = w; } }
    }
};
struct EpiFfnUp {
    static constexpr bool PERM = true;
    bf16_t* U; bf16_t* FIN; const float* cw; const float* cb; LAS float* xch;
    __device__ __forceinline__ void operator()(const f32x4 (&acc)[2][2][4][2], const Unit& u, int wr, int wc, int fr, int fq) const {
        if (u.pm >= NCTX / BM) {
            const int row0 = u.pm * BM + wr * 64 + fr, col0 = u.pn * BM + wc * 32 + 8 * fq;
#pragma unroll
            for (int ai = 0; ai < 2; ++ai)
#pragma unroll
                for (int m = 0; m < 4; ++m) { bf16_t* rowp = U + (size_t)(row0 + ai * HALF + m * 16) * UPC + col0;
#pragma unroll
                    for (int bj = 0; bj < 2; ++bj) { const f32x4 v0 = acc[ai][bj][m][0], v1 = acc[ai][bj][m][1];
                        u32x4 w; w.x = pk2(v0[0], v0[1]); w.y = pk2(v0[2], v0[3]); w.z = pk2(v1[0], v1[1]); w.w = pk2(v1[2], v1[3]);
                        st16_wt(rowp + bj * HALF, w); } }
            return;
        }
        const int cl = wc * 32 + 8 * fq, ch = u.pn * 128 + cl;
#pragma unroll
        for (int ai = 0; ai < 2; ++ai) { const int band = 2 * ai + wr;
            if (fr == 0) { *(LAS f32x4*)(xch + (band * 2 + 0) * 128 + cl) = acc[ai][0][0][0]; *(LAS f32x4*)(xch + (band * 2 + 0) * 128 + cl + 4) = acc[ai][0][0][1]; }
            if (fr == 15) { *(LAS f32x4*)(xch + (band * 2 + 1) * 128 + cl) = acc[ai][0][3][0]; *(LAS f32x4*)(xch + (band * 2 + 1) * 128 + cl + 4) = acc[ai][0][3][1]; } }
        asm volatile("s_waitcnt lgkmcnt(0)" ::: "memory");
        __builtin_amdgcn_s_barrier();
        asm volatile("" ::: "memory"); __builtin_amdgcn_sched_barrier(0);
        float w0[8], w1[8], w2[8], bb[8];
        { const f32x4 a0 = *(const f32x4*)(cw + 3 * DFF + ch), a1 = *(const f32x4*)(cw + 3 * DFF + ch + 4), b0 = *(const f32x4*)(cw + 4 * DFF + ch), b1 = *(const f32x4*)(cw + 4 * DFF + ch + 4);
            const f32x4 c0 = *(const f32x4*)(cw + 5 * DFF + ch), c1 = *(const f32x4*)(cw + 5 * DFF + ch + 4), d0 = *(const f32x4*)(cb + ch), d1 = *(const f32x4*)(cb + ch + 4);
#pragma unroll
            for (int e = 0; e < 4; ++e) { w0[e] = a0[e]; w0[4 + e] = a1[e]; w1[e] = b0[e]; w1[4 + e] = b1[e]; w2[e] = c0[e]; w2[4 + e] = c1[e]; bb[e] = d0[e]; bb[4 + e] = d1[e]; } }
        const int row0 = u.pm * BM + wr * 64 + fr;
#pragma unroll
        for (int ai = 0; ai < 2; ++ai) { const int band = 2 * ai + wr;
            f32x4 ht[2], hb[2];
#pragma unroll
            for (int n = 0; n < 2; ++n) { ht[n] = band > 0 ? *(const LAS f32x4*)(xch + ((band - 1) * 2 + 1) * 128 + cl + 4 * n) : (f32x4){0.f, 0.f, 0.f, 0.f};
                hb[n] = band < 3 ? *(const LAS f32x4*)(xch + ((band + 1) * 2 + 0) * 128 + cl + 4 * n) : (f32x4){0.f, 0.f, 0.f, 0.f}; }
#pragma unroll
            for (int m = 0; m < 4; ++m) { unsigned pk[4];
#pragma unroll
                for (int n = 0; n < 2; ++n) { float o[4];
#pragma unroll
                    for (int e = 0; e < 4; ++e) { const float cur = acc[ai][0][m][n][e];
                        const float rp = dpp_ror1(acc[ai][0][m > 0 ? m - 1 : 0][n][e]), rn = dpp_rol1(acc[ai][0][m < 3 ? m + 1 : 3][n][e]), rc = dpp_ror1(cur), lc = dpp_rol1(cur);
                        const float pt = m > 0 ? rp : ht[n][e], nt_ = m < 3 ? rn : hb[n][e];
                        const float prev = fr > 0 ? rc : pt, next = fr < 15 ? lc : nt_;
                        const float v = bb[4 * n + e] + w0[4 * n + e] * prev + w1[4 * n + e] * cur + w2[4 * n + e] * next;
                        o[e] = silu(v) * acc[ai][1][m][n][e]; }
                    pk[2 * n] = pk2(o[0], o[1]); pk[2 * n + 1] = pk2(o[2], o[3]); }
                u32x4 w; w.x = pk[0]; w.y = pk[1]; w.z = pk[2]; w.w = pk[3];
                st16_wt(FIN + (size_t)(row0 + ai * HALF + m * 16) * DFF + ch, w); } }
    }
};
template <class Epi>
__device__ __forceinline__ void gemm_phase(LAS unsigned char* lds, const Gemm g, const StaticOrder& S, const Epi& E, const int tid) {
    const int wid = __builtin_amdgcn_readfirstlane(tid >> 6), lane = tid & 63, wr = wid >> 2, wc = wid & 3, fr = lane & 15, fq = lane >> 4;
    const int nt = g.K / BK;
    unsigned voffA[2], voffB[2];
#pragma unroll
    for (int i = 0; i < 2; ++i) { int R, C; stage_rc(tid * 16 + i * 8192, R, C); const int Rb = Epi::PERM ? ((R & ~31) + perm32(R & 31)) : R;
        voffA[i] = (unsigned)(R * g.lda + C) * 2u; voffB[i] = (unsigned)(Rb * g.ldb + C) * 2u; }
    const size_t kstep = (size_t)(BK * 2);
    const size_t hstepA = (size_t)HALF * g.lda * 2, hstepB = (size_t)HALF * g.ldb * 2;
    const unsigned ldsw = (unsigned)wid * 1024u;
    const int aoff = lds_byte(wr * 64 + fr, fq * 8), boff = lds_byte(wc * 32 + fr, fq * 8);
#define PG8_SA(b, h) (((b) * 2 + (h)) * HTB)
#define PG8_SB(b, h) ((4 + (b) * 2 + (h)) * HTB)
#define PG8_STAGE(bufoff, gbase, voff) do { _Pragma("unroll") for (int _i = 0; _i < 2; ++_i) \
        __builtin_amdgcn_global_load_lds((const unsigned*)((const char*)(gbase) + (voff)[_i]), (LAS unsigned*)(lds + (bufoff) + ldsw + _i * 8192), 16, 0, 0); } while (0)
#define PG8_LDA(dst, b, h) do { _Pragma("unroll") for (int m = 0; m < 4; ++m) _Pragma("unroll") for (int k = 0; k < 2; ++k) dst[m][k] = *(const LAS bf16x8*)(lds + PG8_SA(b, h) + aoff + m * 2048 + k * 1024); } while (0)
#define PG8_LDB(dst, b, h) do { _Pragma("unroll") for (int n = 0; n < 2; ++n) _Pragma("unroll") for (int k = 0; k < 2; ++k) dst[n][k] = *(const LAS bf16x8*)(lds + PG8_SB(b, h) + boff + n * 2048 + k * 1024); } while (0)
#define PG8_MMA(ai, bj, At, Bt) do { __builtin_amdgcn_s_setprio(1); _Pragma("unroll") for (int m = 0; m < 4; ++m) _Pragma("unroll") for (int n = 0; n < 2; ++n) _Pragma("unroll") for (int k = 0; k < 2; ++k) \
        acc[ai][bj][m][n] = __builtin_amdgcn_mfma_f32_16x16x32_bf16(Bt[n][k], At[m][k], acc[ai][bj][m][n], 0, 0, 0); __builtin_amdgcn_s_setprio(0); } while (0)
#define PG8_WAIT_V(n) asm volatile("s_waitcnt vmcnt(" #n ")" ::: "memory")
#define PG8_WAIT_L(n) asm volatile("s_waitcnt lgkmcnt(" #n ")" ::: "memory")
#define PG8_BAR __builtin_amdgcn_s_barrier()
#define PG8_SCHED __builtin_amdgcn_sched_barrier(0)
    Unit cur, nxt; int ui = 0;
    if (!S.next(0, cur)) return;
    f32x4 acc[2][2][4][2];
#pragma unroll
    for (int a = 0; a < 2; ++a)
#pragma unroll
        for (int b = 0; b < 2; ++b)
#pragma unroll
            for (int m = 0; m < 4; ++m)
#pragma unroll
                for (int n = 0; n < 2; ++n) acc[a][b][m][n] = (f32x4){0.f, 0.f, 0.f, 0.f};
    bf16x8 At[4][2], B0[2][2], B1[2][2];
    const char* cA = cur.a; const char* cB = cur.b;
    PG8_STAGE(PG8_SB(0, 0), cB, voffB); PG8_STAGE(PG8_SB(0, 1), cB + hstepB, voffB); PG8_STAGE(PG8_SA(0, 0), cA, voffA); PG8_STAGE(PG8_SA(0, 1), cA + hstepA, voffA);
    if (wr == 1) PG8_BAR;
    PG8_WAIT_V(2); PG8_BAR;
    PG8_STAGE(PG8_SB(1, 0), cB + kstep, voffB); PG8_STAGE(PG8_SA(1, 0), cA + kstep, voffA); PG8_STAGE(PG8_SB(1, 1), cB + hstepB + kstep, voffB);
    PG8_WAIT_V(6); PG8_BAR;
    for (;;) {
        const bool has_next = S.next(ui + 1, nxt);
        const char* nA = has_next ? nxt.a : cA; const char* nB = has_next ? nxt.b : cB;
        for (int t = 0; t < nt; t += 2) {
            const bool last = (t == nt - 2);
            const char* a1 = cA + (size_t)(t + 1) * kstep;
            const char* a2 = last ? nA : cA + (size_t)(t + 2) * kstep; const char* b2 = last ? nB : cB + (size_t)(t + 2) * kstep;
            const char* a3 = a2 + kstep; const char* b3 = b2 + kstep;
            PG8_LDB(B0, 0, 0); PG8_LDB(B1, 0, 1); PG8_SCHED; PG8_LDA(At, 0, 0); PG8_STAGE(PG8_SA(1, 1), a1 + hstepA, voffA);
            PG8_WAIT_V(8); PG8_WAIT_L(0); PG8_BAR; PG8_MMA(0, 0, At, B0); PG8_MMA(0, 1, At, B1); PG8_BAR; PG8_SCHED;
            PG8_LDA(At, 0, 1); PG8_STAGE(PG8_SB(0, 0), b2, voffB); PG8_STAGE(PG8_SB(0, 1), b2 + hstepB, voffB); PG8_STAGE(PG8_SA(0, 0), a2, voffA);
            PG8_WAIT_V(8); PG8_WAIT_L(0); PG8_BAR; PG8_MMA(1, 0, At, B0); PG8_MMA(1, 1, At, B1); PG8_BAR; PG8_SCHED;
            PG8_LDB(B0, 1, 0); PG8_LDB(B1, 1, 1); PG8_SCHED; PG8_LDA(At, 1, 0); PG8_STAGE(PG8_SA(0, 1), a2 + hstepA, voffA);
            PG8_WAIT_V(8); PG8_WAIT_L(0); PG8_BAR; PG8_MMA(0, 0, At, B0); PG8_MMA(0, 1, At, B1); PG8_BAR; PG8_SCHED;
            PG8_LDA(At, 1, 1); PG8_STAGE(PG8_SB(1, 0), b3, voffB); PG8_STAGE(PG8_SB(1, 1), b3 + hstepB, voffB); PG8_STAGE(PG8_SA(1, 0), a3, voffA);
            PG8_WAIT_V(8); PG8_WAIT_L(0); PG8_BAR; PG8_MMA(1, 0, At, B0); PG8_MMA(1, 1, At, B1); PG8_BAR; PG8_SCHED;
        }
        if (wr == 0) PG8_BAR;
        E(acc, cur, wr, wc, fr, fq);
        if (!has_next) break;
#pragma unroll
        for (int a = 0; a < 2; ++a)
#pragma unroll
            for (int b = 0; b < 2; ++b)
#pragma unroll
                for (int m = 0; m < 4; ++m)
#pragma unroll
                    for (int n = 0; n < 2; ++n) acc[a][b][m][n] = (f32x4){0.f, 0.f, 0.f, 0.f};
        cur = nxt; cA = nA; cB = nB; ++ui;
        if (wr == 1) PG8_BAR;
    }
    PG8_WAIT_V(0);
    PG8_BAR;
#undef PG8_SA
#undef PG8_SB
#undef PG8_STAGE
#undef PG8_LDA
#undef PG8_LDB
#undef PG8_MMA
#undef PG8_WAIT_V
#undef PG8_WAIT_L
#undef PG8_BAR
#undef PG8_SCHED
}
}

struct Args { const float* in[33]; float* out; unsigned char* ws; int ph_lo, ph_hi; };
enum { I_XP = 0, I_XS, I_C, I_SR, I_SC, I_SN, I_SM, I_CCTX, I_ADAW, I_ADAB, I_NORMG, I_WIN, I_MU, I_W0, I_WUP, I_A0, I_AUP, I_GUP, I_KKS, I_KA, I_RK, I_LNG, I_LNB,
       I_MCONV, I_MGB, I_MGNG, I_WBR, I_WBM, I_WOUT, I_FUP, I_FCONV, I_FCB, I_FDN };

struct Frame {
    LAS unsigned char* lds; const Args* a;
    int tid, lane, wave, G, vcu, gw, NGW;
    unsigned char* ws; float* out;
};
__device__ __forceinline__ const float* xrow_ptr(const Args& a, int tok) { return tok < NCTX ? a.in[I_XP] + (size_t)tok * D : a.in[I_XS] + (size_t)(tok - NCTX) * D; }
__device__ __forceinline__ int cond_of(int tok) { return tok < NCTX ? 0 : 1 + ((tok - NCTX) >> 11); }
__device__ __forceinline__ int seq_base(int s) { return s < 16 ? s * 256 : NCTX + (s - 16) * 2048; }
__device__ __forceinline__ int seq_len(int s) { return s < 16 ? 256 : 2048; }

__device__ __forceinline__ int win_col(int n) { return n < 2944 ? n : (n < 2960 ? n + 1024 : (n < 3072 ? 1 << 20 : (n < 4096 ? n - 128 : n - 112))); }
__device__ __forceinline__ int fup_col(int n) { const int t = n >> 8, j = n & 255; return j < 128 ? 128 * t + j : DFF + 128 * t + (j - 128); }
__device__ __forceinline__ void transpose_item(const int REMAP, const float* W, int K, int N, bf16_t* WT, int nblk, LAS float* scr, int item, int lane) {
    const int kb = item / nblk, nb = item % nblk, k0 = 64 * kb, n0 = 32 * nb;
    const int nn = REMAP == 1 ? win_col(n0 + (lane & 31)) : (REMAP == 2 ? fup_col(n0 + (lane & 31)) : n0 + (lane & 31));
#pragma unroll
    for (int i = 0; i < 32; ++i) { const int kk = 2 * i + (lane >> 5); scr[kk * 33 + (lane & 31)] = (nn < N) ? W[(size_t)(k0 + kk) * N + nn] : 0.f; }
    LDS_WAIT(); asm volatile("" ::: "memory");
    const int c = lane & 7;
#pragma unroll
    for (int j = 0; j < 4; ++j) { const int n = (lane >> 3) + 8 * j; const LAS float* s = scr + (8 * c) * 33 + n;
        u32x4 o; o.x = pk2(s[0 * 33], s[1 * 33]); o.y = pk2(s[2 * 33], s[3 * 33]); o.z = pk2(s[4 * 33], s[5 * 33]); o.w = pk2(s[6 * 33], s[7 * 33]);
        *(u32x4*)(WT + (size_t)(n0 + n) * K + k0 + 8 * c) = o; }
    LDS_WAIT(); asm volatile("" ::: "memory");
}
__device__ __forceinline__ void p0_prologue(Frame& F) {
    const Args& a = *F.a;
    if (blockIdx.x < 96) {
        LAS float* sc = (LAS float*)(F.lds + 69632);
        LAS float* part = (LAS float*)(F.lds + 69632 + 12288);
        for (int i = F.tid; i < 3072; i += 512) { const int ci = i >> 10, k = i & 1023; const float cv = ci == 0 ? a.in[I_CCTX][k] : a.in[I_C][(ci - 1) * D + k]; sc[i] = silu(cv); }
        __syncthreads();
        const int col = blockIdx.x * 64 + F.lane; float a0 = 0.f, a1 = 0.f, a2 = 0.f;
        const float* aw = a.in[I_ADAW];
#pragma unroll 64
        for (int k = F.wave * 128; k < F.wave * 128 + 128; ++k) { const float w = aw[(size_t)k * 6144 + col]; a0 += sc[k] * w; a1 += sc[1024 + k] * w; a2 += sc[2048 + k] * w; }
        part[(F.wave * 3 + 0) * 64 + F.lane] = a0; part[(F.wave * 3 + 1) * 64 + F.lane] = a1; part[(F.wave * 3 + 2) * 64 + F.lane] = a2;
        __syncthreads();
        if (F.tid < 192) { const int ci = F.tid >> 6, l = F.tid & 63; float s = a.in[I_ADAB][blockIdx.x * 64 + l];
#pragma unroll
            for (int w = 0; w < 8; ++w) s += part[(w * 3 + ci) * 64 + l];
            ((float*)(F.ws + WS_MOD))[ci * 6144 + blockIdx.x * 64 + l] = s; }
        asm volatile("s_waitcnt vmcnt(0)" ::: "memory");
        __syncthreads();
        if (F.tid == 0) { __builtin_amdgcn_fence(__ATOMIC_RELEASE, "agent"); asm volatile("s_waitcnt vmcnt(0)" ::: "memory");
            (void)__hip_atomic_fetch_add((unsigned*)(F.ws + WS_CTL) + 1024, 1u, __ATOMIC_RELAXED, __HIP_MEMORY_SCOPE_AGENT); }
    }
    LAS float* scr = (LAS float*)(F.lds + F.wave * 8448);
    constexpr int I_1 = 16 * 192, I_2 = 8 * 32, I_3 = 8 * 32, I_4 = 16 * 32, I_5 = 16 * 176, I_6 = 44 * 32;
    constexpr int I_7 = 96;
    constexpr int NITEMS = I_1 + I_2 + I_3 + I_4 + I_5 + I_7;
    const bool adab = blockIdx.x < 96; const int nw = ((int)blockIdx.x - 96) * 8 + F.wave;
    for (int rd = 0; rd < (adab ? 3 : 5); ++rd) {
        const int it = rd < 3 ? rd * 2048 + F.gw : 6144 + (rd - 3) * 1280 + nw; if (it >= NITEMS) break;
        int r = it; const float* W; bf16_t* WT; int K, N, nblk; int remap = 0;
        if (r < I_1) { W = a.in[I_WIN]; K = 1024; N = 6032; WT = (bf16_t*)(F.ws + WS_WIN); nblk = 192; remap = 1; }
        else if ((r -= I_1) < I_2) { W = a.in[I_WBR]; K = 512; N = 1024; WT = (bf16_t*)(F.ws + WS_WBR); nblk = 32; }
        else if ((r -= I_2) < I_3) { W = a.in[I_WBM]; K = 512; N = 1024; WT = (bf16_t*)(F.ws + WS_WBM); nblk = 32; }
        else if ((r -= I_3) < I_4) { W = a.in[I_WOUT]; K = 1024; N = 1024; WT = (bf16_t*)(F.ws + WS_WOUT); nblk = 32; }
        else if ((r -= I_4) < I_5) { W = a.in[I_FUP]; K = 1024; N = 5632; WT = (bf16_t*)(F.ws + WS_WUP); nblk = 176; remap = 2; }
        else if ((r -= I_5) < 32) { const int d = r >> 4; r &= 15; W = a.in[I_WUP] + d * 32768; K = 64; N = 512; WT = (bf16_t*)(F.ws + WS_WUPT) + d * 32768; nblk = 16; }
        else if ((r -= 32) < 32) { const int d = r >> 4; r &= 15; W = a.in[I_AUP] + d * 32768; K = 64; N = 512; WT = (bf16_t*)(F.ws + WS_AUPT) + d * 32768; nblk = 16; }
        else { r -= 32; W = a.in[I_GUP]; K = 128; N = 512; WT = (bf16_t*)(F.ws + WS_GUPT); nblk = 16; }
        transpose_item(remap, W, K, N, WT, nblk, scr, r, F.lane);
    }
}

__device__ __forceinline__ void p1_h1(Frame& F) {
    const Args& a = *F.a; const float* ng = a.in[I_NORMG];
    const bool adab = blockIdx.x < 96; const int nw = ((int)blockIdx.x - 96) * 8 + F.wave;
    for (int rd = 0; rd < (adab ? 3 : 5); ++rd) { const int row = rd < 3 ? rd * 2048 + F.gw : 6144 + (rd - 3) * 1280 + nw; if (row >= NTOK) break;
        const f32x4* xr = (const f32x4*)xrow_ptr(a, row) + F.lane; const float* mod = (const float*)(F.ws + WS_MOD) + cond_of(row) * 6144;
        f32x4 v[4]; float ss = 0.f;
#pragma unroll
        for (int j = 0; j < 4; ++j) { v[j] = xr[64 * j]; ss += (v[j].x * v[j].x + v[j].y * v[j].y) + (v[j].z * v[j].z + v[j].w * v[j].w); }
        const float rstd = rsqrtf(wave_sum(ss) * (1.f / D) + 1e-6f);
        u32x2* o = (u32x2*)((bf16_t*)(F.ws + WS_H) + (size_t)row * D) + F.lane;
#pragma unroll
        for (int j = 0; j < 4; ++j) { const int col = 4 * (64 * j + F.lane);
            const f32x4 g = *(const f32x4*)(ng + col), sh = *(const f32x4*)(mod + col), sc = *(const f32x4*)(mod + 1024 + col);
            const f32x4 h = v[j] * rstd * g * (sc + 1.f) + sh;
            u32x2 w; w.x = pk2(h.x, h.y); w.y = pk2(h.z, h.w); o[64 * j] = w; }
    }
}

constexpr int ZS_STRIDE = 3856;
__device__ __forceinline__ void ld4(const LAS unsigned char* p, float (&f)[4]) { const u32x2 w = *(const LAS u32x2*)p; f[0] = bf2f(w.x & 0xffffu); f[1] = bf2f(w.x >> 16); f[2] = bf2f(w.y & 0xffffu); f[3] = bf2f(w.y >> 16); }
__device__ __forceinline__ void st4(bf16_t* p, const float (&f)[4]) { u32x2 o; o.x = cvt_pk(f[0], f[1]); o.y = cvt_pk(f[2], f[3]); *(u32x2*)p = o; }
__device__ __forceinline__ void flush_rows(LAS unsigned char* stg, bf16_t* g  , const float (&v)[4][4], int fr, int fq, int lane) {
#pragma unroll
    for (int ct = 0; ct < 4; ++ct) { u32x2 o; o.x = cvt_pk(v[ct][0], v[ct][1]); o.y = cvt_pk(v[ct][2], v[ct][3]); *(LAS u32x2*)(stg + fr * 144 + ct * 32 + fq * 8) = o; }
    LDS_WAIT(); asm volatile("" ::: "memory");
#pragma unroll
    for (int i = 0; i < 2; ++i) { const int t = (lane >> 3) + 8 * i; *(u32x4*)(g + (size_t)t * 512 + (lane & 7) * 8) = *(const LAS u32x4*)(stg + t * 144 + (lane & 7) * 16); }
    LDS_WAIT(); asm volatile("" ::: "memory");
}
template <int SM = 7>
__device__ __forceinline__ void p3_prep(Frame& F) {
    const Args& a = *F.a;
    const bf16_t* Z = (const bf16_t*)(F.ws + WS_Z1);
    LAS unsigned char* L = F.lds;
    const int tid = F.tid, lane = F.lane, h = F.wave, fr = lane & 15, fq = lane >> 4;
    { const int unit = blockIdx.x;
        const int tok0 = unit * 32;
        const int s = tok0 < NCTX ? (tok0 >> 8) : 16 + ((tok0 - NCTX) >> 11);
        const int sb = seq_base(s), T = seq_len(s), t0 = tok0 - sb;
        __syncthreads();
        LAS float* prm = (LAS float*)(L + 32 * ZS_STRIDE);
        { prm[tid] = a.in[I_KKS][tid]; prm[512 + tid] = a.in[I_KA][tid]; prm[1024 + tid] = a.in[I_RK][tid]; prm[1536 + tid] = a.in[I_A0][tid]; prm[2048 + tid] = a.in[I_A0][512 + tid];
          prm[2560 + tid] = a.in[I_W0][tid]; prm[3072 + tid] = a.in[I_W0][512 + tid]; }
#pragma unroll 5
        for (int itk = 0; itk < ((SM & 1) ? 15 : 0); ++itk) { const int it = tid + 512 * itk;
            const int j = it / 240, g8 = (it - j * 240) * 8, t = t0 + j;
            const bf16_t* zp = Z + (size_t)(tok0 + j) * Z1C + g8;
            const float ml = t > 0 ? 0.5f : 0.f, mr = t < T - 1 ? 0.5f : 0.f;
            float zc[8], zl[8], zr[8], v[8];
            unpack8(*(const u32x4*)zp, zc); unpack8(*(const u32x4*)(zp - (t > 0 ? Z1C : 0)), zl); unpack8(*(const u32x4*)(zp + (t < T - 1 ? Z1C : 0)), zr);
            const f32x4 m0 = *(const f32x4*)(a.in[I_MU] + g8), m1 = *(const f32x4*)(a.in[I_MU] + g8 + 4);
#pragma unroll
            for (int i = 0; i < 8; ++i) { const float mu = i < 4 ? m0[i] : m1[i - 4]; v[i] = zc[i] + mu * ((ml * zl[i] + mr * zr[i]) - zc[i]); }
            if (g8 >= ZR_WD && g8 < ZR_AD) {
#pragma unroll
                for (int i = 0; i < 8; ++i) v[i] = 1.f - 2.f * __builtin_amdgcn_rcpf(1.f + __expf(2.f * v[i]));
            } else if (g8 >= ZR_GD) {
#pragma unroll
                for (int i = 0; i < 8; ++i) v[i] = sigm(v[i]);
            }
            u32x4 o; o.x = cvt_pk(v[0], v[1]); o.y = cvt_pk(v[2], v[3]); o.z = cvt_pk(v[4], v[5]); o.w = cvt_pk(v[6], v[7]);
            *(LAS u32x4*)(L + j * ZS_STRIDE + g8 * 2) = o;
        }
        __syncthreads();
        if (SM & 2) {
            const bf16_t* WUPT = (const bf16_t*)(F.ws + WS_WUPT); const bf16_t* AUPT = (const bf16_t*)(F.ws + WS_AUPT); const bf16_t* GUPT = (const bf16_t*)(F.ws + WS_GUPT);
            const f32x4 Z4 = {0.f, 0.f, 0.f, 0.f};
            float kx[2][4][4], kk[2][4][4], rx[2][4][4], bon[2] = {0.f, 0.f};
            LAS unsigned char* stg = L + 32 * ZS_STRIDE + 14336 + h * 2304;
#define TILE(WS_, tt_) ((bf16_t*)(F.ws + (WS_)) + (size_t)(tok0 + 16 * (tt_)) * 512 + 64 * h)
#pragma unroll
            for (int tt = 0; tt < 2; ++tt) {
                const LAS unsigned char* zrow = L + (16 * tt + fr) * ZS_STRIDE; const size_t tok = (size_t)(tok0 + 16 * tt + fr);
                float ss = 0.f;
                float vx[4][4];
#pragma unroll
                for (int ct = 0; ct < 4; ++ct) { const int col = 64 * h + 16 * ct + 4 * fq;
                    ld4(zrow + (ZR_R + col) * 2, rx[tt][ct]); ld4(zrow + (ZR_K + col) * 2, kx[tt][ct]); ld4(zrow + (ZR_V + col) * 2, vx[ct]);
                    const f32x4 ks = *(const LAS f32x4*)(prm + col);
#pragma unroll
                    for (int j = 0; j < 4; ++j) { kk[tt][ct][j] = kx[tt][ct][j] * ks[j]; ss += kk[tt][ct][j] * kk[tt][ct][j]; }
                }
                flush_rows(stg, TILE(WS_PR, tt), rx[tt], fr, fq, lane); flush_rows(stg, TILE(WS_PV, tt), vx, fr, fq, lane);
                ss += __shfl_xor(ss, 16); ss += __shfl_xor(ss, 32);
                const float rn = __builtin_amdgcn_rsqf(fmaxf(ss, 1e-24f));
#pragma unroll
                for (int ct = 0; ct < 4; ++ct) {
#pragma unroll
                    for (int j = 0; j < 4; ++j) kk[tt][ct][j] *= rn; }
                flush_rows(stg, TILE(WS_PKK, tt), kk[tt], fr, fq, lane);
            }
#pragma unroll
            for (int d = 0; d < 2; ++d) {
                asm volatile("" ::: "memory"); __builtin_amdgcn_sched_barrier(0);
                bf16x8 af[2][4];
#pragma unroll
                for (int ks = 0; ks < 2; ++ks)
#pragma unroll
                    for (int ct = 0; ct < 4; ++ct) af[ks][ct] = *(const bf16x8*)(AUPT + ((size_t)(d * 512 + 64 * h + 16 * ct + fr)) * 64 + 32 * ks + 8 * fq);
#pragma unroll
                for (int tt = 0; tt < 2; ++tt) { const LAS unsigned char* zrow = L + (16 * tt + fr) * ZS_STRIDE; const size_t tok = (size_t)(tok0 + 16 * tt + fr);
                    f32x4 acc[4] = {Z4, Z4, Z4, Z4};
#pragma unroll
                    for (int ks = 0; ks < 2; ++ks) { const bf16x8 bv = *(const LAS bf16x8*)(zrow + (ZR_AD + 64 * d + 32 * ks + 8 * fq) * 2);
#pragma unroll
                        for (int ct = 0; ct < 4; ++ct) acc[ct] = __builtin_amdgcn_mfma_f32_16x16x32_bf16(af[ks][ct], bv, acc[ct], 0, 0, 0); }
                    float kd[4][4], bv4[4][4];
#pragma unroll
                    for (int ct = 0; ct < 4; ++ct) { const int col = 64 * h + 16 * ct + 4 * fq;
                        const f32x4 a0 = *(const LAS f32x4*)(prm + 1536 + d * 512 + col), ka = *(const LAS f32x4*)(prm + 512 + col), rk = *(const LAS f32x4*)(prm + 1024 + col);
#pragma unroll
                        for (int j = 0; j < 4; ++j) { const float av = sigm(a0[j] + acc[ct][j]); kd[ct][j] = kx[tt][ct][j] * (1.f + (av - 1.f) * ka[j]); bv4[ct][j] = kk[tt][ct][j] * av; bon[tt] += rx[tt][ct][j] * kd[ct][j] * rk[j]; } }
                    flush_rows(stg, TILE(WS_PKD, tt) + (size_t)d * NTOK * 512, kd, fr, fq, lane); flush_rows(stg, TILE(WS_PB, tt) + (size_t)d * NTOK * 512, bv4, fr, fq, lane); (void)tok;
                }
            }
#pragma unroll
            for (int d = 0; d < 2; ++d) {
                asm volatile("" ::: "memory"); __builtin_amdgcn_sched_barrier(0);
                bf16x8 af[2][4];
#pragma unroll
                for (int ks = 0; ks < 2; ++ks)
#pragma unroll
                    for (int ct = 0; ct < 4; ++ct) af[ks][ct] = *(const bf16x8*)(WUPT + ((size_t)(d * 512 + 64 * h + 16 * ct + fr)) * 64 + 32 * ks + 8 * fq);
#pragma unroll
                for (int tt = 0; tt < 2; ++tt) { const LAS unsigned char* zrow = L + (16 * tt + fr) * ZS_STRIDE; const size_t tok = (size_t)(tok0 + 16 * tt + fr);
                    f32x4 acc[4] = {Z4, Z4, Z4, Z4};
#pragma unroll
                    for (int ks = 0; ks < 2; ++ks) { const bf16x8 bv = *(const LAS bf16x8*)(zrow + (ZR_WD + 64 * d + 32 * ks + 8 * fq) * 2);
#pragma unroll
                        for (int ct = 0; ct < 4; ++ct) acc[ct] = __builtin_amdgcn_mfma_f32_16x16x32_bf16(af[ks][ct], bv, acc[ct], 0, 0, 0); }
                    float dc[4][4];
#pragma unroll
                    for (int ct = 0; ct < 4; ++ct) { const int col = 64 * h + 16 * ct + 4 * fq; const f32x4 w0 = *(const LAS f32x4*)(prm + 2560 + d * 512 + col);
#pragma unroll
                        for (int j = 0; j < 4; ++j) dc[ct][j] = __expf(-0.606531f * sigm(w0[j] + acc[ct][j])); }
                    flush_rows(stg, TILE(WS_PW, tt) + (size_t)d * NTOK * 512, dc, fr, fq, lane); (void)tok;
                }
            }
            {
                asm volatile("" ::: "memory"); __builtin_amdgcn_sched_barrier(0);
                bf16x8 af[4][4];
#pragma unroll
                for (int ks = 0; ks < 4; ++ks)
#pragma unroll
                    for (int ct = 0; ct < 4; ++ct) af[ks][ct] = *(const bf16x8*)(GUPT + ((size_t)(64 * h + 16 * ct + fr)) * 128 + 32 * ks + 8 * fq);
#pragma unroll
                for (int tt = 0; tt < 2; ++tt) { const LAS unsigned char* zrow = L + (16 * tt + fr) * ZS_STRIDE; const size_t tok = (size_t)(tok0 + 16 * tt + fr);
                    f32x4 acc[4] = {Z4, Z4, Z4, Z4};
#pragma unroll
                    for (int ks = 0; ks < 4; ++ks) { const bf16x8 bv = *(const LAS bf16x8*)(zrow + (ZR_GD + 32 * ks + 8 * fq) * 2);
#pragma unroll
                        for (int ct = 0; ct < 4; ++ct) acc[ct] = __builtin_amdgcn_mfma_f32_16x16x32_bf16(af[ks][ct], bv, acc[ct], 0, 0, 0); }
                    float g4[4][4];
#pragma unroll
                    for (int ct = 0; ct < 4; ++ct) { g4[ct][0] = acc[ct][0]; g4[ct][1] = acc[ct][1]; g4[ct][2] = acc[ct][2]; g4[ct][3] = acc[ct][3]; }
                    flush_rows(stg, TILE(WS_PG, tt), g4, fr, fq, lane); (void)tok;
                }
            }
#pragma unroll
            for (int tt = 0; tt < 2; ++tt) { float b = bon[tt]; b += __shfl_xor(b, 16); b += __shfl_xor(b, 32);
                if (fq == 0) ((float*)(F.ws + WS_BON))[(size_t)(tok0 + 16 * tt + fr) * 8 + h] = b; }
        }
        asm volatile("" ::: "memory"); __builtin_amdgcn_sched_barrier(0);
        if (SM & 4) {
            int tid = F.tid; asm volatile("" : "+v"(tid));
            const bool lat = s >= 16;
            const int y = lat ? (t0 >> 6) : 0, W = lat ? 64 : 256, j0 = (tid >> 7) * 8, x0 = (lat ? (t0 & 63) : t0) + j0;
#pragma unroll 1
            for (int half = 0; half < 2; ++half) {
                const int c4 = (tid & 127) * 4 + half * 512;
                const float* cw = a.in[I_MCONV] + c4;
                float acc[8][4];
#pragma unroll
                for (int jj = 0; jj < 8; ++jj)
#pragma unroll
                    for (int e = 0; e < 4; ++e) acc[jj][e] = 0.f;
#pragma unroll 1
                for (int dy = -1; dy <= 1; ++dy) {
                    const bool rowok = dy == 0 || (lat && y + dy >= 0 && y + dy < 32);
                    const int dyo = rowok ? dy * 64 : 0; const float rmask = rowok ? 1.f : 0.f;
                    f32x4 wt[3];
#pragma unroll
                    for (int dx = 0; dx < 3; ++dx) wt[dx] = *(const f32x4*)(cw + ((dy + 1) * 3 + dx) * 1024) * rmask;
#pragma unroll
                    for (int i = 0; i < 10; ++i) { const int xx = x0 - 1 + i; const bool ok = xx >= 0 && xx < W;
                        const u32x2 raw = *(const u32x2*)(Z + ((long)(tok0 + j0 + dyo) + (i - 1)) * Z1C + ZM_Q + c4);
                        const float cm = ok ? 1.f : 0.f;
                        const f32x4 xv = (f32x4){bf2f(raw.x & 0xffffu), bf2f(raw.x >> 16), bf2f(raw.y & 0xffffu), bf2f(raw.y >> 16)} * cm;
#pragma unroll
                        for (int dx = -1; dx <= 1; ++dx) { const int jj = i - 1 - dx;
                            if (jj >= 0 && jj < 8) {
#pragma unroll
                                for (int e = 0; e < 4; ++e) acc[jj][e] += wt[dx + 1][e] * xv[e]; } }
                    }
                }
                const float sc = half == 0 ? 0.08838834764831845f : 1.f;
                bf16_t* dst = (half == 0 ? (bf16_t*)(F.ws + WS_MQ) : (bf16_t*)(F.ws + WS_MK)) + (tid & 127) * 4;
#pragma unroll
                for (int jj = 0; jj < 8; ++jj) {
#pragma unroll
                    for (int e = 0; e < 4; ++e) acc[jj][e] = silu(acc[jj][e]) * sc;
                    u32x2 o; o.x = cvt_pk(acc[jj][0], acc[jj][1]); o.y = cvt_pk(acc[jj][2], acc[jj][3]);
                    *(u32x2*)(dst + (size_t)(tok0 + j0 + jj) * 512) = o; }
                asm volatile("" ::: "memory"); __builtin_amdgcn_sched_barrier(0);
            }
            { const int j = tid >> 4, gi = tid & 15, tok = tok0 + j;
                const float val = bf2f(Z[(size_t)tok * Z1C + ZM_G + gi]) + a.in[I_MGB][gi];
                if (gi < 8) ((float*)(F.ws + WS_LI))[(size_t)gi * NTOK + tok] = val;
                else ((float*)(F.ws + WS_LF))[(size_t)(gi - 8) * NTOK + tok] = fminf(val, 0.f) - log1pf(__expf(-fabsf(val))); }
        }
    }
}

typedef short bf16x4 __attribute__((ext_vector_type(4)));
__device__ __forceinline__ bf16x4 to_b4(const f32x4 c) { u32x2 p; p.x = cvt_pk(c[0], c[1]); p.y = cvt_pk(c[2], c[3]); return __builtin_bit_cast(bf16x4, p); }
__device__ __forceinline__ bf16x8 cat8(const bf16x4 a, const bf16x4 b) { return __builtin_shufflevector(a, b, 0, 1, 2, 3, 4, 5, 6, 7); }
#define MM2(a0, b0, a1, b1, c) __builtin_amdgcn_mfma_f32_16x16x32_bf16(cat8(a0, a1), cat8(b0, b1), c, 0, 0, 0)
#define MM1(a, b, c) __builtin_amdgcn_mfma_f32_16x16x32_bf16(cat8(a, (bf16x4){0, 0, 0, 0}), cat8(b, (bf16x4){0, 0, 0, 0}), c, 0, 0, 0)
constexpr int R1_AA = 0, R1_BB = 2304, R1_KK = 4608, R1_RR = 6912, R1_BPT = 9216, R1_KPT = 12288, R1_VT = 15360, R1_GB = 18432, R1_BYTES = 18688;
__device__ __forceinline__ int r_slot0(int s, int dir, int h) { return s < 16 ? (((s * 2 + dir) * 8 + h) * 4) : 1024 + ((((s - 16) * 2 + dir) * 8 + h) * 32); }
template <int PM = 0>
__device__ __forceinline__ void rwkv_pass1(Frame& F, int unit) {
    int c, s, dir; const int h = unit & 7, g = unit >> 3;
    if (g < 128) { c = g & 3; s = g >> 3; dir = (g >> 2) & 1; } else { const int g2 = g - 128; c = g2 & 31; s = 16 + (g2 >> 6); dir = (g2 >> 5) & 1; }
    const int slot = r_slot0(s, dir, h) + c;
    const int sb = seq_base(s), T = seq_len(s), lane = F.lane, fr = lane & 15, fq = lane >> 4;
    LAS unsigned char* wl = F.lds + F.wave * R1_BYTES;
    const bf16_t* PR = (const bf16_t*)(F.ws + WS_PR) + h * 64; const bf16_t* PV = (const bf16_t*)(F.ws + WS_PV) + h * 64; const bf16_t* PKK = (const bf16_t*)(F.ws + WS_PKK) + h * 64;
    const bf16_t* PW = (const bf16_t*)(F.ws + WS_PW) + (size_t)dir * NTOK * 512 + h * 64; const bf16_t* PKD = (const bf16_t*)(F.ws + WS_PKD) + (size_t)dir * NTOK * 512 + h * 64;
    const bf16_t* PB = (const bf16_t*)(F.ws + WS_PB) + (size_t)dir * NTOK * 512 + h * 64;
    bf16_t* ybase = PM ? (bf16_t*)(F.ws + WS_PW) : (bf16_t*)F.out;
    bf16_t* YS = ybase + (size_t)dir * NTOK * 512 + h * 64; bf16_t* US = ybase + (size_t)(2 + dir) * NTOK * 512 + h * 64;
    f32x4 XT[4][8];
#pragma unroll
    for (int kt = 0; kt < 4; ++kt)
#pragma unroll
        for (int rt = 0; rt < 8; ++rt)
#pragma unroll
            for (int j = 0; j < 4; ++j) XT[kt][rt][j] = (rt >= 4 && (16 * kt + 4 * fq + j) == (16 * (rt - 4) + fr)) ? 1.f : 0.f;
#pragma unroll 1
    for (int blk = 0; blk < 4; ++blk) {
        const int pos0 = c * 64 + blk * 16;
        {
            const int t = lane >> 2, cp = (lane & 3) * 8, p = pos0 + t, tt = dir ? T - 1 - p : p; const size_t off = (size_t)(sb + tt) * 512 + cp;
            u32x4 raw[6][2];
            if (PM == 1) {
#pragma unroll
                for (int q = 0; q < 6; ++q) { raw[q][0] = (u32x4){0x3e003e00u + (unsigned)lane, 0x3e003e00u, 0x3e003e00u, 0x3e003e00u}; raw[q][1] = raw[q][0]; }
            } else {
                raw[0][0] = *(const u32x4*)(PKK + off); raw[0][1] = *(const u32x4*)(PKK + off + 32); raw[1][0] = *(const u32x4*)(PB + off); raw[1][1] = *(const u32x4*)(PB + off + 32);
                raw[2][0] = *(const u32x4*)(PKD + off); raw[2][1] = *(const u32x4*)(PKD + off + 32); raw[3][0] = *(const u32x4*)(PR + off); raw[3][1] = *(const u32x4*)(PR + off + 32);
                raw[4][0] = *(const u32x4*)(PW + off); raw[4][1] = *(const u32x4*)(PW + off + 32); raw[5][0] = *(const u32x4*)(PV + off); raw[5][1] = *(const u32x4*)(PV + off + 32);
            }
            const int lo = t * 144 + cp * 2;
            *(LAS u32x4*)(wl + R1_AA + lo) = raw[0][0]; *(LAS u32x4*)(wl + R1_AA + lo + 64) = raw[0][1]; *(LAS u32x4*)(wl + R1_BB + lo) = raw[1][0]; *(LAS u32x4*)(wl + R1_BB + lo + 64) = raw[1][1];
            *(LAS u32x4*)(wl + R1_KK + lo) = raw[2][0]; *(LAS u32x4*)(wl + R1_KK + lo + 64) = raw[2][1]; *(LAS u32x4*)(wl + R1_RR + lo) = raw[3][0]; *(LAS u32x4*)(wl + R1_RR + lo + 64) = raw[3][1];
            *(LAS u32x4*)(wl + R1_BPT + lo) = raw[4][0]; *(LAS u32x4*)(wl + R1_BPT + lo + 64) = raw[4][1]; *(LAS u32x4*)(wl + R1_KPT + lo) = raw[5][0]; *(LAS u32x4*)(wl + R1_KPT + lo + 64) = raw[5][1];
        }
        LDS_WAIT(); asm volatile("" ::: "memory");
        {
            float gt[16], vv[16], gB = 1.f;
#pragma unroll
            for (int t = 0; t < 16; ++t) { gB *= bf2f(*(const LAS bf16_t*)(wl + R1_BPT + t * 144 + lane * 2)); gt[t] = gB; vv[t] = bf2f(*(const LAS bf16_t*)(wl + R1_KPT + t * 144 + lane * 2)); }
            LDS_WAIT(); asm volatile("" ::: "memory");
#pragma unroll
            for (int tp = 0; tp < 8; ++tp) {
                float bp[2], kp[2];
#pragma unroll
                for (int e = 0; e < 2; ++e) { const int t = 2 * tp + e; const int lo = t * 144 + lane * 2;
                    const float kk = bf2f(*(const LAS bf16_t*)(wl + R1_AA + lo)), b = bf2f(*(const LAS bf16_t*)(wl + R1_BB + lo)), kd = bf2f(*(const LAS bf16_t*)(wl + R1_KK + lo)), r = bf2f(*(const LAS bf16_t*)(wl + R1_RR + lo));
                    const float g = gt[t], gm1 = t ? gt[t > 0 ? t - 1 : 0] : 1.f, inv = __builtin_amdgcn_rcpf(g), bb = b * inv, kq = kd * inv;
                    bp[e] = bb * gB; kp[e] = kq * gB;
                    *(LAS bf16_t*)(wl + R1_AA + lo) = (bf16_t)cvt_pk(gm1 * kk, 0.f); *(LAS bf16_t*)(wl + R1_BB + lo) = (bf16_t)cvt_pk(bb, 0.f);
                    *(LAS bf16_t*)(wl + R1_KK + lo) = (bf16_t)cvt_pk(kq, 0.f); *(LAS bf16_t*)(wl + R1_RR + lo) = (bf16_t)cvt_pk(g * r, 0.f); }
                *(LAS unsigned*)(wl + R1_BPT + lane * 48 + tp * 4) = cvt_pk(bp[0], bp[1]);
                *(LAS unsigned*)(wl + R1_KPT + lane * 48 + tp * 4) = cvt_pk(kp[0], kp[1]);
                *(LAS unsigned*)(wl + R1_VT + lane * 48 + tp * 4) = cvt_pk(vv[2 * tp], vv[2 * tp + 1]);
            }
            *(LAS float*)(wl + R1_GB + lane * 4) = gB;
        }
        LDS_WAIT(); asm volatile("" ::: "memory");
        bf16x4 fAA[4], fRR[4];
        f32x4 Nn = {0.f, 0.f, 0.f, 0.f}, NT = Nn, P2T = Nn, Q1T = Nn, Q2T = Nn;
        {
            bf16x4 fB[4], fK[4];
#pragma unroll
            for (int kt = 0; kt < 4; ++kt) { const int o1 = fr * 144 + (16 * kt + 4 * fq) * 2;
                fAA[kt] = *(const LAS bf16x4*)(wl + R1_AA + o1); fRR[kt] = *(const LAS bf16x4*)(wl + R1_RR + o1); fB[kt] = *(const LAS bf16x4*)(wl + R1_BB + o1); fK[kt] = *(const LAS bf16x4*)(wl + R1_KK + o1); }
#pragma unroll
            for (int kp = 0; kp < 4; kp += 2) {
                Nn = MM2(fAA[kp], fB[kp], fAA[kp + 1], fB[kp + 1], Nn); NT = MM2(fB[kp], fAA[kp], fB[kp + 1], fAA[kp + 1], NT); P2T = MM2(fK[kp], fAA[kp], fK[kp + 1], fAA[kp + 1], P2T);
                Q1T = MM2(fB[kp], fRR[kp], fB[kp + 1], fRR[kp + 1], Q1T); Q2T = MM2(fK[kp], fRR[kp], fK[kp + 1], fRR[kp + 1], Q2T); }
        }
        f32x4 Ic;
#pragma unroll
        for (int j = 0; j < 4; ++j) { const int m = 4 * fq + j, n = fr;
            Nn[j] = (n < m) ? Nn[j] : 0.f; NT[j] = (m < n) ? NT[j] : 0.f; P2T[j] = (m < n) ? P2T[j] : 0.f; Q1T[j] = (m <= n) ? Q1T[j] : 0.f; Q2T[j] = (m <= n) ? Q2T[j] : 0.f; Ic[j] = (m == n) ? 1.f : 0.f; }
        const f32x4 Z4 = {0.f, 0.f, 0.f, 0.f};
        const bf16x4 bNn = to_b4(Nn), bNT = to_b4(NT);
        const f32x4 N2 = MM1(bNT, bNn, Z4), N2T = MM1(bNn, bNT, Z4);
        const bf16x4 bN2 = to_b4(N2), bN2T = to_b4(N2T);
        const f32x4 N4 = MM1(bN2T, bN2, Z4), N4T = MM1(bN2, bN2T, Z4);
        const f32x4 N8 = MM1(to_b4(N4T), to_b4(N4), Z4);
        const f32x4 T2T = MM1(to_b4(Ic + N2), to_b4(Ic - NT), Z4);
        const f32x4 T3T = MM1(to_b4(Ic + N4), to_b4(T2T), Z4);
        const f32x4 TiT = MM1(to_b4(Ic + N8), to_b4(T3T), Z4);
        const bf16x4 bTn = to_b4(Z4 - TiT), bP2T = to_b4(P2T), bQ1T = to_b4(Q1T), bQ2T = to_b4(Q2T);
#pragma unroll
        for (int rt = 0; rt < (PM == 3 ? 0 : 8); ++rt) {
            bf16x4 bX[4];
#pragma unroll
            for (int kt = 0; kt < 4; ++kt) bX[kt] = to_b4(XT[kt][rt]);
            const bf16x4 z4b = {0, 0, 0, 0};
            f32x4 cg = MM2(fAA[0], bX[0], fAA[1], bX[1], Z4); cg = MM2(fAA[2], bX[2], fAA[3], bX[3], cg);
            bf16x4 bV = z4b;
            if (rt < 4) { bV = *(const LAS bf16x4*)(wl + R1_VT + (16 * rt + fr) * 48 + 8 * fq); cg = MM1(bP2T, bV, cg); }
            const bf16x4 bD = to_b4(MM1(bTn, to_b4(cg), Z4));
            f32x4 y = MM2(fRR[0], bX[0], fRR[1], bX[1], Z4); y = MM2(fRR[2], bX[2], fRR[3], bX[3], y);
            y = MM2(bQ1T, bD, (rt < 4 ? bQ2T : z4b), bV, y);
#pragma unroll
            for (int j = 0; j < 4; ++j) *(LAS bf16_t*)(wl + (4 * fq + j) * 256 + (16 * rt + fr) * 2) = (bf16_t)cvt_pk(y[j], 0.f);
#pragma unroll
            for (int kt = 0; kt < 4; ++kt) { const int o2 = (16 * kt + fr) * 48 + 8 * fq;
                const f32x4 x = XT[kt][rt] * *(const LAS f32x4*)(wl + R1_GB + (16 * kt + 4 * fq) * 4);
                XT[kt][rt] = MM2(*(const LAS bf16x4*)(wl + R1_BPT + o2), bD, (rt < 4 ? *(const LAS bf16x4*)(wl + R1_KPT + o2) : z4b), bV, x); }
            __builtin_amdgcn_sched_barrier(0);
        }
        LDS_WAIT(); asm volatile("" ::: "memory");
        if (PM != 2) {
            const int t = lane >> 2, part = lane & 3, p = pos0 + t, tt = dir ? T - 1 - p : p;
            bf16_t* yo = (part < 2 ? YS : US) + (size_t)(sb + tt) * 512 + 32 * (part & 1);
#pragma unroll
            for (int i = 0; i < 4; ++i) *(u32x4*)(yo + 8 * i) = *(const LAS u32x4*)(wl + t * 256 + part * 64 + 16 * i);
        }
        LDS_WAIT(); asm volatile("" ::: "memory");
    }
    if (PM) {
#pragma unroll
        for (int kt = 0; kt < 4; ++kt)
#pragma unroll
            for (int rt = 0; rt < 8; ++rt) asm volatile("" :: "v"(XT[kt][rt]));
        return; }
    bf16_t* sp = (bf16_t*)(F.ws + WS_SP) + (size_t)slot * 8192;
#pragma unroll
    for (int rt = 0; rt < 4; ++rt) {
        u32x4 o0, o1;
        o0.x = cvt_pk(XT[0][rt][0], XT[0][rt][1]); o0.y = cvt_pk(XT[0][rt][2], XT[0][rt][3]); o0.z = cvt_pk(XT[1][rt][0], XT[1][rt][1]); o0.w = cvt_pk(XT[1][rt][2], XT[1][rt][3]);
        o1.x = cvt_pk(XT[2][rt][0], XT[2][rt][1]); o1.y = cvt_pk(XT[2][rt][2], XT[2][rt][3]); o1.z = cvt_pk(XT[3][rt][0], XT[3][rt][1]); o1.w = cvt_pk(XT[3][rt][2], XT[3][rt][3]);
        *(u32x4*)(sp + 4096 + (16 * rt + fr) * 64 + fq * 16) = o0; *(u32x4*)(sp + 4096 + (16 * rt + fr) * 64 + fq * 16 + 8) = o1;
#pragma unroll
        for (int kt = 0; kt < 4; ++kt)
#pragma unroll
            for (int j = 0; j < 4; ++j) *(LAS bf16_t*)(wl + (16 * kt + 4 * fq + j) * 128 + ((fr >> 2) * 16 + rt * 4 + (fr & 3)) * 2) = (bf16_t)cvt_pk(XT[kt][4 + rt][j], 0.f);
    }
    LDS_WAIT(); asm volatile("" ::: "memory");
#pragma unroll
    for (int i = 0; i < 8; ++i) { const int id = lane + 64 * i; *(u32x4*)(sp + (id >> 3) * 64 + (id & 7) * 8) = *(const LAS u32x4*)(wl + (id >> 3) * 128 + (id & 7) * 16); }
}
struct PropStage { bf16x4 a[4][4]; u32x2 sl[4]; };
template <int MODE = 0>
__device__ __forceinline__ void rwkv_prop(Frame& F, int wu, size_t st_off = 0, bool fin = true) {
    const Args& a = *F.a;
    int s, dir, h, vt;
    if (wu < 128) { const int hs = wu >> 2; vt = wu & 3; s = 16 + (hs >> 4); dir = (hs >> 3) & 1; h = hs & 7; } else { const int u2 = wu - 128, hs = u2 >> 2; vt = u2 & 3; s = hs >> 4; dir = (hs >> 3) & 1; h = hs & 7; }
    const int nch = seq_len(s) / 64, lane = F.lane, fr = lane & 15, fq = lane >> 4;
    bf16_t* sp0 = (bf16_t*)(F.ws + WS_SP) + (size_t)r_slot0(s, dir, h) * 8192;
    bf16x4 bS[4]; f32x4 acc[4];
    if (s >= 16) { const float* s0 = a.in[I_SR] + ((((size_t)(s - 16) * 2 + dir) * 8 + h) * 4096) + (16 * vt + fr) * 64 + 4 * fq;
#pragma unroll
        for (int it = 0; it < 4; ++it) bS[it] = to_b4(*(const f32x4*)(s0 + 16 * it));
    } else {
#pragma unroll
        for (int it = 0; it < 4; ++it) bS[it] = (bf16x4){0, 0, 0, 0};
    }
#pragma unroll
    for (int kt = 0; kt < 4; ++kt) acc[kt] = (f32x4){0.f, 0.f, 0.f, 0.f};
    PropStage st[4];
#define PROP_LOAD(u, cidx) do { const bf16_t* spc = sp0 + (size_t)(cidx) * 8192; \
        _Pragma("unroll") for (int kt = 0; kt < 4; ++kt) { const u32x4 lo_ = *(const u32x4*)(spc + (16 * kt + fr) * 64 + fq * 16), hi_ = *(const u32x4*)(spc + (16 * kt + fr) * 64 + fq * 16 + 8); \
            st[u].a[kt][0] = __builtin_bit_cast(bf16x4, (u32x2){lo_.x, lo_.y}); st[u].a[kt][1] = __builtin_bit_cast(bf16x4, (u32x2){lo_.z, lo_.w}); \
            st[u].a[kt][2] = __builtin_bit_cast(bf16x4, (u32x2){hi_.x, hi_.y}); st[u].a[kt][3] = __builtin_bit_cast(bf16x4, (u32x2){hi_.z, hi_.w}); } \
        { const u32x4 lo_ = *(const u32x4*)(spc + 4096 + (16 * vt + fr) * 64 + fq * 16), hi_ = *(const u32x4*)(spc + 4096 + (16 * vt + fr) * 64 + fq * 16 + 8); \
            st[u].sl[0] = (u32x2){lo_.x, lo_.y}; st[u].sl[1] = (u32x2){lo_.z, lo_.w}; st[u].sl[2] = (u32x2){hi_.x, hi_.y}; st[u].sl[3] = (u32x2){hi_.z, hi_.w}; } } while (0)
#pragma unroll
    for (int u = 0; u < 4; ++u) PROP_LOAD(u, u);
    for (int c0 = 0; c0 < nch; c0 += 4) {
#pragma unroll
        for (int u = 0; u < 4; ++u) { const int c = c0 + u; bf16_t* spc = sp0 + (size_t)c * 8192;
#pragma unroll
            for (int kt = 0; kt < 4; ++kt) { acc[kt][0] = bf2f(st[u].sl[kt].x & 0xffffu); acc[kt][1] = bf2f(st[u].sl[kt].x >> 16); acc[kt][2] = bf2f(st[u].sl[kt].y & 0xffffu); acc[kt][3] = bf2f(st[u].sl[kt].y >> 16); }
#pragma unroll
            for (int it = 0; it < 4; ++it) *(bf16x4*)(spc + st_off + 4096 + (16 * vt + fr) * 64 + 16 * it + 4 * fq) = bS[it];
#pragma unroll
            for (int kt = 0; kt < 4; ++kt)
#pragma unroll
                for (int it = 0; it < 4; it += 2) { if (MODE == 2) { acc[kt][0] += __builtin_bit_cast(float, (int)st[u].a[kt][it][0] + (int)bS[it][0]); } else acc[kt] = MM2(st[u].a[kt][it], bS[it], st[u].a[kt][it + 1], bS[it + 1], acc[kt]); }
#pragma unroll
            for (int kt = 0; kt < 4; ++kt) bS[kt] = to_b4(acc[kt]);
            if (MODE != 1) { const int cn = c + 4 < nch ? c + 4 : nch - 1; PROP_LOAD(u, cn); }
        }
    }
#undef PROP_LOAD
    if (s < 16 && fin) { float* so = F.out + OUT_SR + ((((size_t)s * 2 + dir) * 8 + h) * 4096) + (16 * vt + fr) * 64 + 4 * fq;
#pragma unroll
        for (int kt = 0; kt < 4; ++kt) *(f32x4*)(so + 16 * kt) = acc[kt]; }
}
constexpr int RPL_SLOT = 11520, RPL_NS = 12, RPL_FLG = RPL_SLOT * RPL_NS;
__device__ __forceinline__ void rwkv_prop_lat(Frame& F, int wu) {
    const Args& a = *F.a;
    const int hs = wu >> 2, vt = wu & 3, s = 16 + (hs >> 4), dir = (hs >> 3) & 1, h = hs & 7;
    const int lane = F.lane, fr = lane & 15, fq = lane >> 4;
    bf16_t* sp0 = (bf16_t*)(F.ws + WS_SP) + (size_t)r_slot0(s, dir, h) * 8192;
    LAS unsigned char* L = F.lds; volatile LAS unsigned* flg = (volatile LAS unsigned*)(L + RPL_FLG);
    __syncthreads();
    if (F.tid < 64) flg[F.tid] = 0u;
    __syncthreads();
    if (F.wave == 0) {
        bf16x4 bS[4];
        { const float* s0 = a.in[I_SR] + ((((size_t)(s - 16) * 2 + dir) * 8 + h) * 4096) + (16 * vt + fr) * 64 + 4 * fq;
#pragma unroll
            for (int it = 0; it < 4; ++it) bS[it] = to_b4(*(const f32x4*)(s0 + 16 * it)); }
#pragma unroll 1
        for (int c = 0; c < 32; ++c) {
            while (flg[c] == 0u) __builtin_amdgcn_s_sleep(1);
            asm volatile("" ::: "memory");
            const LAS unsigned char* sl_ = L + (c % RPL_NS) * RPL_SLOT;
            bf16x4 af[4][4]; f32x4 acc[4];
#pragma unroll
            for (int kt = 0; kt < 4; ++kt) { const u32x4 lo_ = *(const LAS u32x4*)(sl_ + (16 * kt + fr) * 144 + fq * 32), hi_ = *(const LAS u32x4*)(sl_ + (16 * kt + fr) * 144 + fq * 32 + 16);
                af[kt][0] = __builtin_bit_cast(bf16x4, (u32x2){lo_.x, lo_.y}); af[kt][1] = __builtin_bit_cast(bf16x4, (u32x2){lo_.z, lo_.w});
                af[kt][2] = __builtin_bit_cast(bf16x4, (u32x2){hi_.x, hi_.y}); af[kt][3] = __builtin_bit_cast(bf16x4, (u32x2){hi_.z, hi_.w}); }
            { const u32x4 lo_ = *(const LAS u32x4*)(sl_ + 9216 + fr * 144 + fq * 32), hi_ = *(const LAS u32x4*)(sl_ + 9216 + fr * 144 + fq * 32 + 16);
                const unsigned w8[8] = {lo_.x, lo_.y, lo_.z, lo_.w, hi_.x, hi_.y, hi_.z, hi_.w};
#pragma unroll
                for (int kt = 0; kt < 4; ++kt) { acc[kt][0] = bf2f(w8[2 * kt] & 0xffffu); acc[kt][1] = bf2f(w8[2 * kt] >> 16); acc[kt][2] = bf2f(w8[2 * kt + 1] & 0xffffu); acc[kt][3] = bf2f(w8[2 * kt + 1] >> 16); } }
            LDS_WAIT(); asm volatile("" ::: "memory");
            flg[32] = (unsigned)(c + 1);
            bf16_t* spc = sp0 + (size_t)c * 8192;
#pragma unroll
            for (int it = 0; it < 4; ++it) *(bf16x4*)(spc + 4096 + (16 * vt + fr) * 64 + 16 * it + 4 * fq) = bS[it];
#pragma unroll
            for (int kt = 0; kt < 4; ++kt)
#pragma unroll
                for (int it = 0; it < 4; it += 2) acc[kt] = MM2(af[kt][it], bS[it], af[kt][it + 1], bS[it + 1], acc[kt]);
#pragma unroll
            for (int kt = 0; kt < 4; ++kt) bS[kt] = to_b4(acc[kt]);
        }
    } else {
#pragma unroll 1
        for (int c = F.wave - 1; c < 32; c += 14) {
            const int c2 = c + 7; const bool two = c2 < 32;
            const unsigned char* g1 = (const unsigned char*)(sp0 + (size_t)c * 8192); const unsigned char* g2 = (const unsigned char*)(sp0 + (size_t)(two ? c2 : c) * 8192);
            u32x4 r1[10], r2[10];
#pragma unroll
            for (int j = 0; j < 8; ++j) r1[j] = *(const u32x4*)(g1 + (lane + 64 * j) * 16);
#pragma unroll
            for (int j = 0; j < 2; ++j) r1[8 + j] = *(const u32x4*)(g1 + 8192 + vt * 2048 + (lane + 64 * j) * 16);
#pragma unroll
            for (int j = 0; j < 8; ++j) r2[j] = *(const u32x4*)(g2 + (lane + 64 * j) * 16);
#pragma unroll
            for (int j = 0; j < 2; ++j) r2[8 + j] = *(const u32x4*)(g2 + 8192 + vt * 2048 + (lane + 64 * j) * 16);
            while ((int)flg[32] < c - (RPL_NS - 1)) __builtin_amdgcn_s_sleep(1);
            { LAS unsigned char* d = L + (c % RPL_NS) * RPL_SLOT;
#pragma unroll
                for (int j = 0; j < 8; ++j) { const int idx = lane + 64 * j; *(LAS u32x4*)(d + (idx >> 3) * 144 + (idx & 7) * 16) = r1[j]; }
#pragma unroll
                for (int j = 0; j < 2; ++j) { const int idx = lane + 64 * j; *(LAS u32x4*)(d + 9216 + (idx >> 3) * 144 + (idx & 7) * 16) = r1[8 + j]; }
                LDS_WAIT(); asm volatile("" ::: "memory"); flg[c] = 1u; }
            if (two) {
                while ((int)flg[32] < c2 - (RPL_NS - 1)) __builtin_amdgcn_s_sleep(1);
                LAS unsigned char* d = L + (c2 % RPL_NS) * RPL_SLOT;
#pragma unroll
                for (int j = 0; j < 8; ++j) { const int idx = lane + 64 * j; *(LAS u32x4*)(d + (idx >> 3) * 144 + (idx & 7) * 16) = r2[j]; }
#pragma unroll
                for (int j = 0; j < 2; ++j) { const int idx = lane + 64 * j; *(LAS u32x4*)(d + 9216 + (idx >> 3) * 144 + (idx & 7) * 16) = r2[8 + j]; }
                LDS_WAIT(); asm volatile("" ::: "memory"); flg[c2] = 1u; }
        }
    }
}
__device__ __forceinline__ void rwkv_fix(Frame& F, int wu2) {
    const Args& a = *F.a; const int wu = wu2 >> 1, th = wu2 & 1;
    int s, cc, h;
    if (wu < 512) { const int cg = wu >> 3; h = wu & 7; s = cg >> 2; cc = cg & 3; } else { const int u2 = wu - 512, cg = u2 >> 3; h = u2 & 7; s = 16 + (cg >> 5); cc = cg & 31; }
    const int sb = seq_base(s), nch = seq_len(s) / 64, tok0 = sb + cc * 64, lane = F.lane, fr = lane & 15, fq = lane >> 4;
    f32x4 acc[4][2];
#pragma unroll
    for (int vt = 0; vt < 4; ++vt)
#pragma unroll
        for (int tt = 0; tt < 2; ++tt) acc[vt][tt] = (f32x4){0.f, 0.f, 0.f, 0.f};
#pragma unroll
    for (int d = 0; d < 2; ++d) {
        const bf16_t* sin = (const bf16_t*)(F.ws + WS_SP) + (size_t)(r_slot0(s, d, h) + (d ? nch - 1 - cc : cc)) * 8192 + 4096;
        const bf16_t* us = (const bf16_t*)F.out + (size_t)(2 + d) * NTOK * 512 + h * 64;
#pragma unroll
        for (int ks = 0; ks < 2; ++ks) { bf16x8 aS[4], bU[2];
#pragma unroll
            for (int i = 0; i < 4; ++i) aS[i] = *(const bf16x8*)(sin + (16 * i + fr) * 64 + 32 * ks + 8 * fq);
#pragma unroll
            for (int i = 0; i < 2; ++i) bU[i] = *(const bf16x8*)(us + (size_t)(tok0 + 32 * th + 16 * i + fr) * 512 + 32 * ks + 8 * fq);
#pragma unroll
            for (int vt = 0; vt < 4; ++vt)
#pragma unroll
                for (int tt = 0; tt < 2; ++tt) acc[vt][tt] = __builtin_amdgcn_mfma_f32_16x16x32_bf16(aS[vt], bU[tt], acc[vt][tt], 0, 0, 0); }
    }
    const bf16_t* YS = (const bf16_t*)F.out + h * 64 + 4 * fq;
#pragma unroll
    for (int tt = 0; tt < 2; ++tt) { const size_t tok = (size_t)(tok0 + 32 * th + 16 * tt + fr);
        float sm = 0.f;
#pragma unroll
        for (int vt = 0; vt < 4; ++vt) { const u32x2 y0 = *(const u32x2*)(YS + tok * 512 + 16 * vt), y1 = *(const u32x2*)(YS + ((size_t)NTOK + tok) * 512 + 16 * vt);
            acc[vt][tt][0] += bf2f(y0.x & 0xffffu) + bf2f(y1.x & 0xffffu); acc[vt][tt][1] += bf2f(y0.x >> 16) + bf2f(y1.x >> 16);
            acc[vt][tt][2] += bf2f(y0.y & 0xffffu) + bf2f(y1.y & 0xffffu); acc[vt][tt][3] += bf2f(y0.y >> 16) + bf2f(y1.y >> 16);
            sm += (acc[vt][tt][0] + acc[vt][tt][1]) + (acc[vt][tt][2] + acc[vt][tt][3]); }
        sm += __shfl_xor(sm, 16); sm += __shfl_xor(sm, 32);
        const float mean = sm * (1.f / 64.f); float vs = 0.f;
#pragma unroll
        for (int vt = 0; vt < 4; ++vt)
#pragma unroll
            for (int j = 0; j < 4; ++j) { acc[vt][tt][j] -= mean; vs += acc[vt][tt][j] * acc[vt][tt][j]; }
        vs += __shfl_xor(vs, 16); vs += __shfl_xor(vs, 32);
        const float rstd = rsqrtf(vs * (1.f / 64.f) + 64e-5f), bon = ((const float*)(F.ws + WS_BON))[tok * 8 + h];
#pragma unroll
        for (int vt = 0; vt < 4; ++vt) { const int c = h * 64 + 16 * vt + 4 * fq;
            const u32x2 vv = *(const u32x2*)((const bf16_t*)(F.ws + WS_PV) + tok * 512 + c), gg = *(const u32x2*)((const bf16_t*)(F.ws + WS_PG) + tok * 512 + c);
            const f32x4 lg = *(const f32x4*)(a.in[I_LNG] + c), lb = *(const f32x4*)(a.in[I_LNB] + c);
            const float v4[4] = {bf2f(vv.x & 0xffffu), bf2f(vv.x >> 16), bf2f(vv.y & 0xffffu), bf2f(vv.y >> 16)}, g4[4] = {bf2f(gg.x & 0xffffu), bf2f(gg.x >> 16), bf2f(gg.y & 0xffffu), bf2f(gg.y >> 16)};
            float r[4];
#pragma unroll
            for (int j = 0; j < 4; ++j) r[j] = (acc[vt][tt][j] * rstd * lg[j] + lb[j] + bon * v4[j]) * g4[j];
            u32x2 o; o.x = cvt_pk(r[0], r[1]); o.y = cvt_pk(r[2], r[3]);
            *(u32x2*)((bf16_t*)(F.ws + WS_YRB) + tok * 512 + c) = o; }
    }
}

__device__ __forceinline__ f32x4 mma16(const LAS unsigned char* A, int sa, const LAS unsigned char* B, int sb, int K, f32x4 acc, int fr, int fq) {
#pragma unroll
    for (int k0 = 0; k0 < K; k0 += 32) {
        const bf16x8 av = *(const LAS bf16x8*)(A + fr * sa + (k0 + fq * 8) * 2);
        const bf16x8 bv = *(const LAS bf16x8*)(B + fr * sb + (k0 + fq * 8) * 2);
        acc = __builtin_amdgcn_mfma_f32_16x16x32_bf16(av, bv, acc, 0, 0, 0);
    }
    return acc;
}
typedef short v4i16_t __attribute__((ext_vector_type(4)));
__device__ __forceinline__ bf16x4 tr_frag(const LAS unsigned char* tile, int rs, int r0, int c0, int lane) {
    const int g = lane >> 4, q = (lane & 15) >> 2, p = lane & 3;
    return __builtin_bit_cast(bf16x4, __builtin_amdgcn_ds_read_tr16_b64_v4i16((LAS v4i16_t*)(tile + (r0 + 4 * g + q) * rs + (c0 + 4 * p) * 2)));
}
__device__ __forceinline__ int m_slot(int s, int dir, int h, int c) { return s < 16 ? (((s * 2 + dir) * 4 + h) * 2 + c) : 256 + ((((s - 16) * 2 + dir) * 4 + h) * 16 + c); }
__device__ __forceinline__ bf16_t* dc_ptr(unsigned char* ws, int slot) { return (bf16_t*)(ws + WS_DCC) + (size_t)slot * 16384; }
__device__ __forceinline__ float wave_max(float v) {
#pragma unroll
    for (int o = 1; o < 64; o <<= 1) v = fmaxf(v, __shfl_xor(v, o));
    return v;
}
constexpr int PA_K = 0, PA_V = 36864, PA_F = 73728, PA_S = 288, PA_SET = 75264;
__device__ __forceinline__ void pa_decode(int slot, int& dir, int& h, int& tok0) {
    int s, c;
    if (slot < 256) { const int hs = slot >> 1; c = slot & 1; s = hs >> 3; dir = (hs >> 2) & 1; h = hs & 3; } else { const int u2 = slot - 256, hs = u2 >> 4; c = u2 & 15; s = 16 + (hs >> 3); dir = (hs >> 2) & 1; h = hs & 3; }
    const int T = seq_len(s), oc = dir ? T / 128 - 1 - c : c; tok0 = seq_base(s) + oc * 128;
}
__device__ __forceinline__ void mlstm_passA(Frame& F, int slotA) {
    const int tid = F.tid, lane = F.lane, w = F.wave, fr = lane & 15, fq = lane >> 4;
    LAS unsigned char* L = F.lds;
    __syncthreads();
#pragma unroll
    for (int p = 0; p < 2; ++p) { int dir, h, tok0; pa_decode(slotA + 256 * p, dir, h, tok0);
        LAS unsigned char* Lp = L + p * PA_SET; LAS float* fv = (LAS float*)(Lp + PA_F);
        const bf16_t* MK = (const bf16_t*)(F.ws + WS_MK) + h * 128; const bf16_t* ZV = (const bf16_t*)(F.ws + WS_Z2) + Z2_V + h * 128;
        const int j = tid >> 2, part = tid & 3; const size_t tok = (size_t)(tok0 + j);
#pragma unroll
        for (int q = 0; q < 4; ++q) { const int c8 = part * 32 + q * 8;
            *(LAS u32x4*)(Lp + PA_K + j * PA_S + c8 * 2) = *(const u32x4*)(MK + tok * 512 + c8); *(LAS u32x4*)(Lp + PA_V + j * PA_S + c8 * 2) = *(const u32x4*)(ZV + tok * Z2C + c8); }
        if (tid < 128) fv[tid] = ((const float*)(F.ws + WS_LI) + (size_t)(dir * 4 + h) * NTOK)[tok0 + tid];
        else if (tid < 256) fv[tid] = ((const float*)(F.ws + WS_LF) + (size_t)(dir * 4 + h) * NTOK)[tok0 + tid - 128]; }
    __syncthreads();
    if (w < 2) {
        int dir, h, tok0; pa_decode(slotA + 256 * w, dir, h, tok0); (void)h; (void)tok0;
        LAS float* fv = (LAS float*)(L + w * PA_SET + PA_F); LAS float *vli = fv, *vlf = fv + 128, *vwj = fv + 256;
        const int op0 = dir ? 127 - 2 * lane : 2 * lane, op1 = dir ? op0 - 1 : op0 + 1;
        const float f0 = vlf[op0], f1 = vlf[op1]; float sc = f0 + f1;
#pragma unroll
        for (int o = 1; o < 64; o <<= 1) { const float t = __shfl_up(sc, o); if (lane >= o) sc += t; }
        const float b1 = sc, b0 = sc - f1, a0 = vli[op0] - b0, a1 = vli[op1] - b1, mx = wave_max(fmaxf(a0, a1)), bL = __shfl(b1, 63);
        vwj[op0] = __expf(a0 - mx); vwj[op1] = __expf(a1 - mx);
        if (lane == 0) { float* ms = (float*)(F.ws + WS_MS) + (size_t)(slotA + 256 * w) * 4; ms[0] = mx; ms[1] = bL; }
    }
    __syncthreads();
#pragma unroll
    for (int p = 0; p < 2; ++p) { const int slot = slotA + 256 * p;
        const LAS unsigned char* Lp = L + p * PA_SET; const LAS float* vwj = (const LAS float*)(Lp + PA_F) + 256;
        bf16x4 bv[8], bw[8];
#pragma unroll
        for (int sl = 0; sl < 8; ++sl) { const u32x2 r = __builtin_bit_cast(u32x2, tr_frag(Lp + PA_V, PA_S, 16 * sl, 16 * w, lane)); const f32x4 wj4 = *(const LAS f32x4*)(vwj + 16 * sl + 4 * fq);
            u32x2 o; o.x = cvt_pk(bf2f(r.x & 0xffffu) * wj4[0], bf2f(r.x >> 16) * wj4[1]); o.y = cvt_pk(bf2f(r.y & 0xffffu) * wj4[2], bf2f(r.y >> 16) * wj4[3]);
            bv[sl] = __builtin_bit_cast(bf16x4, o);
            u32x2 ow; ow.x = cvt_pk(wj4[0], wj4[1]); ow.y = cvt_pk(wj4[2], wj4[3]); bw[sl] = __builtin_bit_cast(bf16x4, ow); }
        bf16_t* dc = dc_ptr(F.ws, slot);
#pragma unroll
        for (int kt = 0; kt < 8; ++kt) {
            f32x4 acc = {0.f, 0.f, 0.f, 0.f};
#pragma unroll
            for (int sl = 0; sl < 8; sl += 2) acc = MM2(tr_frag(Lp + PA_K, PA_S, 16 * sl, 16 * kt, lane), bv[sl], tr_frag(Lp + PA_K, PA_S, 16 * sl + 16, 16 * kt, lane), bv[sl + 1], acc);
            u32x2 o; o.x = cvt_pk(acc[0], acc[1]); o.y = cvt_pk(acc[2], acc[3]);
            *(u32x2*)(dc + (size_t)(16 * w + fr) * 128 + 16 * kt + 4 * fq) = o; }
        { f32x4 acc = {0.f, 0.f, 0.f, 0.f};
#pragma unroll
            for (int sl = 0; sl < 8; sl += 2) acc = MM2(tr_frag(Lp + PA_K, PA_S, 16 * sl, 16 * w, lane), bw[sl], tr_frag(Lp + PA_K, PA_S, 16 * sl + 16, 16 * w, lane), bw[sl + 1], acc);
            if (fr == 0) *(f32x4*)((float*)(F.ws + WS_DN) + (size_t)slot * 128 + 16 * w + 4 * fq) = acc; }
    }
}
constexpr int C3_SC = 0, C3_K = 4096, C3_VT = 4096 + 34816, C3_CIN = 4096 + 2 * 34816, C3_S = 272;
__device__ __forceinline__ void mlstm_passC3(Frame& F, int ch) {
    const Args& a = *F.a;
    int s, h, cc;
    if (ch < 128) { s = ch >> 3; h = (ch >> 1) & 3; cc = ch & 1; } else { const int u2 = ch - 128; s = 16 + (u2 >> 6); h = (u2 >> 4) & 3; cc = u2 & 15; }
    const int sb = seq_base(s), nch = seq_len(s) / 128, tok0 = sb + cc * 128, tid = F.tid, lane = F.lane, st = F.wave, fr = lane & 15, fq = lane >> 4;
    const size_t tok = (size_t)(tok0 + 16 * st + fr);
    const bf16_t* MQ = (const bf16_t*)(F.ws + WS_MQ) + h * 128; const bf16_t* MK = (const bf16_t*)(F.ws + WS_MK) + h * 128;
    const int slotd[2] = {m_slot(s, 0, h, cc), m_slot(s, 1, h, nch - 1 - cc)};
    LAS unsigned char* L = F.lds; LAS float* scl_ = (LAS float*)(L + C3_SC);
    __syncthreads();
    {
        const int j = tid >> 2, part = tid & 3; const size_t tj = (size_t)(tok0 + j);
        const bf16_t* Z2v = (const bf16_t*)(F.ws + WS_Z2) + Z2_V + h * 128;
#pragma unroll
        for (int q = 0; q < 4; ++q) { const int c8 = part * 32 + q * 8;
            *(LAS u32x4*)(L + C3_K + j * C3_S + c8 * 2) = *(const u32x4*)(MK + tj * 512 + c8);
            const u32x4 v0 = *(const u32x4*)(Z2v + tj * Z2C + c8); const unsigned vw[4] = {v0.x, v0.y, v0.z, v0.w};
#pragma unroll
            for (int i = 0; i < 4; ++i) { *(LAS bf16_t*)(L + C3_VT + (c8 + 2 * i) * C3_S + j * 2) = (bf16_t)(vw[i] & 0xffffu); *(LAS bf16_t*)(L + C3_VT + (c8 + 2 * i + 1) * C3_S + j * 2) = (bf16_t)(vw[i] >> 16); } }
        if (F.wave < 2) {
            const int d = F.wave; LAS float* dv = scl_ + d * 512;
            const float m_in = ((const float*)(F.ws + WS_MS))[(size_t)slotd[d] * 4 + 2];
            const float* LI = (const float*)(F.ws + WS_LI) + (size_t)(d * 4 + h) * NTOK + tok0; const float* LF = (const float*)(F.ws + WS_LF) + (size_t)(d * 4 + h) * NTOK + tok0;
            const int op0 = d ? 127 - 2 * lane : 2 * lane, op1 = d ? op0 - 1 : op0 + 1;
            const float f0 = LF[op0], f1 = LF[op1]; float sc = f0 + f1;
#pragma unroll
            for (int o = 1; o < 64; o <<= 1) { const float t = __shfl_up(sc, o); if (lane >= o) sc += t; }
            const float b1 = sc, b0 = sc - f1, a0 = LI[op0] - b0, a1 = LI[op1] - b1;
            float mxp = fmaxf(a0, a1);
#pragma unroll
            for (int o = 1; o < 64; o <<= 1) { const float t = __shfl_up(mxp, o); if (lane >= o) mxp = fmaxf(mxp, t); }
            float mprev = __shfl_up(mxp, 1); if (lane == 0) mprev = -3.0e38f;
            const float M0 = fmaxf(m_in, fmaxf(mprev, a0)), M1 = fmaxf(m_in, mxp);
            dv[op0] = a0; dv[128 + op0] = M0; dv[256 + op0] = __expf(m_in - M0); dv[384 + op0] = __expf(-b0 - M0);
            dv[op1] = a1; dv[128 + op1] = M1; dv[256 + op1] = __expf(m_in - M1); dv[384 + op1] = __expf(-b1 - M1); } }
    bf16x8 qf[4];
#pragma unroll
    for (int ks = 0; ks < 4; ++ks) qf[ks] = *(const bf16x8*)(MQ + tok * 512 + 32 * ks + 8 * fq);
    __syncthreads();
    f32x4 ST[8];
#pragma unroll
    for (int jt = 0; jt < 8; ++jt) { f32x4 acc = {0.f, 0.f, 0.f, 0.f};
#pragma unroll
        for (int ks = 0; ks < 4; ++ks) acc = __builtin_amdgcn_mfma_f32_16x16x32_bf16(*(const LAS bf16x8*)(L + C3_K + (16 * jt + fr) * C3_S + (32 * ks + 8 * fq) * 2), qf[ks], acc, 0, 0, 0);
        ST[jt] = acc; }
    const int sl = 16 * st + fr;
    float hv[8][4];
#pragma unroll
    for (int vt = 0; vt < 8; ++vt)
#pragma unroll
        for (int jj = 0; jj < 4; ++jj) hv[vt][jj] = 0.f;
#pragma unroll 1
    for (int d = 0; d < 2; ++d) {
        const LAS float* dv = scl_ + d * 512;
        __syncthreads();
        { const bf16_t* cin = dc_ptr(F.ws, slotd[d]);
#pragma unroll
            for (int r = 0; r < 4; ++r) { const int idx = tid + 512 * r, row = idx >> 4, c8 = (idx & 15) * 8; *(LAS u32x4*)(L + C3_CIN + row * C3_S + c8 * 2) = *(const u32x4*)(cin + (size_t)row * 128 + c8); } }
        const float Ms = dv[128 + sl], inter = dv[256 + sl], eneg = dv[384 + sl];
        bf16x4 bS[8]; float rs = 0.f;
#pragma unroll
        for (int jt = 0; jt < 8; ++jt) { const f32x4 a4 = *(const LAS f32x4*)(dv + 16 * jt + 4 * fq); f32x4 v;
#pragma unroll
            for (int jj = 0; jj < 4; ++jj) { const int j = 16 * jt + 4 * fq + jj; const bool keep = d ? (j >= sl) : (j <= sl); v[jj] = keep ? ST[jt][jj] * __expf(a4[jj] - Ms) : 0.f; rs += v[jj]; }
            bS[jt] = to_b4(v); }
        rs += __shfl_xor(rs, 16); rs += __shfl_xor(rs, 32);
        float qn = 0.f; { const float* nd = (const float*)(F.ws + WS_DN) + (size_t)slotd[d] * 128;
#pragma unroll
            for (int ks = 0; ks < 4; ++ks) { float qv[8]; unpack8(__builtin_bit_cast(u32x4, qf[ks]), qv); const f32x4 n0 = *(const f32x4*)(nd + 32 * ks + 8 * fq), n1 = *(const f32x4*)(nd + 32 * ks + 8 * fq + 4);
#pragma unroll
                for (int i = 0; i < 4; ++i) qn += qv[i] * n0[i] + qv[4 + i] * n1[i]; } }
        qn += __shfl_xor(qn, 16); qn += __shfl_xor(qn, 32);
        const float scl = __builtin_amdgcn_rcpf(fmaxf(fabsf(inter * qn + rs), eneg));
        __syncthreads();
#pragma unroll
        for (int vt = 0; vt < 8; ++vt) {
            f32x4 ai = {0.f, 0.f, 0.f, 0.f}, av = {0.f, 0.f, 0.f, 0.f};
#pragma unroll
            for (int ks = 0; ks < 4; ++ks) ai = __builtin_amdgcn_mfma_f32_16x16x32_bf16(*(const LAS bf16x8*)(L + C3_CIN + (16 * vt + fr) * C3_S + (32 * ks + 8 * fq) * 2), qf[ks], ai, 0, 0, 0);
#pragma unroll
            for (int jt = 0; jt < 8; jt += 2) av = MM2(*(const LAS bf16x4*)(L + C3_VT + (16 * vt + fr) * C3_S + (16 * jt + 4 * fq) * 2), bS[jt], *(const LAS bf16x4*)(L + C3_VT + (16 * vt + fr) * C3_S + (16 * jt + 16 + 4 * fq) * 2), bS[jt + 1], av);
#pragma unroll
            for (int jj = 0; jj < 4; ++jj) hv[vt][jj] += (inter * ai[jj] + av[jj]) * scl;
        }
    }
    float s1 = 0.f, s2 = 0.f;
#pragma unroll
    for (int vt = 0; vt < 8; ++vt)
#pragma unroll
        for (int jj = 0; jj < 4; ++jj) { s1 += hv[vt][jj]; s2 += hv[vt][jj] * hv[vt][jj]; }
    s1 += __shfl_xor(s1, 16); s1 += __shfl_xor(s1, 32); s2 += __shfl_xor(s2, 16); s2 += __shfl_xor(s2, 32);
    const float mean = s1 * (1.f / 128.f), rstd = rsqrtf(fmaxf(s2 * (1.f / 128.f) - mean * mean, 0.f) + 1e-5f);
#pragma unroll
    for (int vt = 0; vt < 8; ++vt) { const int c = h * 128 + 16 * vt + 4 * fq;
        const u32x2 ow = *(const u32x2*)((const bf16_t*)(F.ws + WS_Z2) + tok * Z2C + Z2_O + c); const f32x4 gg = *(const f32x4*)(a.in[I_MGNG] + c);
        const float o4[4] = {bf2f(ow.x & 0xffffu), bf2f(ow.x >> 16), bf2f(ow.y & 0xffffu), bf2f(ow.y >> 16)};
        u32x2 o; o.x = cvt_pk((hv[vt][0] - mean) * rstd * gg[0] * sigm(o4[0]), (hv[vt][1] - mean) * rstd * gg[1] * sigm(o4[1]));
        o.y = cvt_pk((hv[vt][2] - mean) * rstd * gg[2] * sigm(o4[2]), (hv[vt][3] - mean) * rstd * gg[3] * sigm(o4[3]));
        *(u32x2*)((bf16_t*)(F.ws + WS_YMB) + tok * 512 + c) = o; }
}
template <int EPT  , int NCH, int PF>
__device__ __forceinline__ void mlstm_prop_t(Frame& F, int s, int dir, int h, int slice) {
    const Args& a = *F.a;
    const int tid = F.tid, e0 = slice * (512 * EPT) + tid * EPT;
    const int slot0 = m_slot(s, dir, h, 0);
    float* MSp = (float*)(F.ws + WS_MS); float* DNp = (float*)(F.ws + WS_DN);
    LAS float* sc = (LAS float*)F.lds;
    __syncthreads();
    if (F.wave == 0) {
        float mx = 0.f, bL = 0.f; if (F.lane < NCH) { mx = MSp[(size_t)(slot0 + F.lane) * 4]; bL = MSp[(size_t)(slot0 + F.lane) * 4 + 1]; }
        float m = s >= 16 ? a.in[I_SM][((size_t)(s - 16) * 2 + dir) * 4 + h] : 0.f;
        for (int c = 0; c < NCH; ++c) { const float mxc = __shfl(mx, c), blc = __shfl(bL, c), Mf = fmaxf(m, mxc);
            if (F.lane == 0) { sc[2 * c] = __expf(m - Mf); sc[2 * c + 1] = __expf(mxc - Mf); if (slice == 0) MSp[(size_t)(slot0 + c) * 4 + 2] = m; }
            m = blc + Mf; }
        if (F.lane == 0 && slice == 0 && s < 16) F.out[OUT_SM + ((size_t)s * 2 + dir) * 4 + h] = m;
    }
    __syncthreads();
    float Cf[EPT];
    if (s >= 16) { const float* c0 = a.in[I_SC] + (((size_t)(s - 16) * 2 + dir) * 4 + h) * 16384 + e0;
#pragma unroll
        for (int i = 0; i < EPT / 4; ++i) { const f32x4 v = *(const f32x4*)(c0 + 4 * i); Cf[4 * i] = v.x; Cf[4 * i + 1] = v.y; Cf[4 * i + 2] = v.z; Cf[4 * i + 3] = v.w; }
    } else {
#pragma unroll
        for (int i = 0; i < EPT; ++i) Cf[i] = 0.f;
    }
    u32x2 ring[PF][EPT / 4];
#pragma unroll
    for (int u = 0; u < PF; ++u) { const bf16_t* dc = dc_ptr(F.ws, slot0 + u) + e0;
#pragma unroll
        for (int i = 0; i < EPT / 4; ++i) ring[u][i] = *(const u32x2*)(dc + 4 * i); }
    for (int c0 = 0; c0 < NCH; c0 += PF) {
#pragma unroll
        for (int u = 0; u < PF; ++u) { const int c = c0 + u; bf16_t* dcw = dc_ptr(F.ws, slot0 + c) + e0; const float e1 = sc[2 * c], e2 = sc[2 * c + 1];
#pragma unroll
            for (int i = 0; i < EPT / 4; ++i) { const u32x2 d = ring[u][i];
                u32x2 o; o.x = cvt_pk(Cf[4 * i], Cf[4 * i + 1]); o.y = cvt_pk(Cf[4 * i + 2], Cf[4 * i + 3]); *(u32x2*)(dcw + 4 * i) = o;
                Cf[4 * i] = e1 * Cf[4 * i] + e2 * bf2f(d.x & 0xffffu); Cf[4 * i + 1] = e1 * Cf[4 * i + 1] + e2 * bf2f(d.x >> 16);
                Cf[4 * i + 2] = e1 * Cf[4 * i + 2] + e2 * bf2f(d.y & 0xffffu); Cf[4 * i + 3] = e1 * Cf[4 * i + 3] + e2 * bf2f(d.y >> 16); }
            { const int cn = c + PF < NCH ? c + PF : NCH - 1; const bf16_t* dc = dc_ptr(F.ws, slot0 + cn) + e0;
#pragma unroll
                for (int i = 0; i < EPT / 4; ++i) ring[u][i] = *(const u32x2*)(dc + 4 * i); }
        }
    }
    if (slice == 0 && tid < 128) {
        float nf = s >= 16 ? a.in[I_SN][(((size_t)(s - 16) * 2 + dir) * 4 + h) * 128 + tid] : 0.f;
        float dn[NCH];
#pragma unroll
        for (int c = 0; c < NCH; ++c) dn[c] = DNp[(size_t)(slot0 + c) * 128 + tid];
#pragma unroll
        for (int c = 0; c < NCH; ++c) { DNp[(size_t)(slot0 + c) * 128 + tid] = nf; nf = sc[2 * c] * nf + sc[2 * c + 1] * dn[c]; }
        if (s < 16) F.out[OUT_SN + (((size_t)s * 2 + dir) * 4 + h) * 128 + tid] = nf;
    }
    if (s < 16) { float* co = F.out + OUT_SC + (((size_t)s * 2 + dir) * 4 + h) * 16384 + e0;
#pragma unroll
        for (int i = 0; i < EPT / 4; ++i) *(f32x4*)(co + 4 * i) = (f32x4){Cf[4 * i], Cf[4 * i + 1], Cf[4 * i + 2], Cf[4 * i + 3]}; }
}
__device__ __forceinline__ void p8_rows(Frame& F) {
    const Args& a = *F.a; const float* ng = a.in[I_NORMG];
    for (int row = F.gw; row < NTOK; row += F.NGW) {
        const f32x4* xr = (const f32x4*)xrow_ptr(a, row) + F.lane; const u32x2* orow = (const u32x2*)((const bf16_t*)(F.ws + WS_OUT1) + (size_t)row * D) + F.lane;
        const float* mod = (const float*)(F.ws + WS_MOD) + cond_of(row) * 6144;
        f32x4 v[4]; float ss = 0.f;
#pragma unroll
        for (int j = 0; j < 4; ++j) { const u32x2 p0 = orow[64 * j], p1 = orow[64 * j + (size_t)NTOK * D / 4];
            v[j] = (f32x4){bf2f(p0.x & 0xffffu) + bf2f(p1.x & 0xffffu), bf2f(p0.x >> 16) + bf2f(p1.x >> 16), bf2f(p0.y & 0xffffu) + bf2f(p1.y & 0xffffu), bf2f(p0.y >> 16) + bf2f(p1.y >> 16)};
            ss += (v[j].x * v[j].x + v[j].y * v[j].y) + (v[j].z * v[j].z + v[j].w * v[j].w); }
        const float rstd = rsqrtf(wave_sum(ss) * (1.f / D) + 1e-6f);
        u32x2* x1o = (u32x2*)((bf16_t*)(F.ws + WS_X1B) + (size_t)row * D) + F.lane; ss = 0.f;
#pragma unroll
        for (int j = 0; j < 4; ++j) { const int col = 4 * (64 * j + F.lane);
            const f32x4 g = *(const f32x4*)(ng + 1024 + col), g1 = *(const f32x4*)(mod + 2048 + col);
            v[j] = xr[64 * j] + g1 * (v[j] * rstd * g); { u32x2 w; w.x = cvt_pk(v[j].x, v[j].y); w.y = cvt_pk(v[j].z, v[j].w); x1o[64 * j] = w; }
            ss += (v[j].x * v[j].x + v[j].y * v[j].y) + (v[j].z * v[j].z + v[j].w * v[j].w); }
        const float rstd2 = rsqrtf(wave_sum(ss) * (1.f / D) + 1e-6f);
        u32x2* o = (u32x2*)((bf16_t*)(F.ws + WS_H) + (size_t)row * D) + F.lane;
#pragma unroll
        for (int j = 0; j < 4; ++j) { const int col = 4 * (64 * j + F.lane);
            const f32x4 g = *(const f32x4*)(ng + 2048 + col), sh = *(const f32x4*)(mod + 3072 + col), sc = *(const f32x4*)(mod + 4096 + col);
            const f32x4 h = v[j] * rstd2 * g * (sc + 1.f) + sh;
            u32x2 w; w.x = pk2(h.x, h.y); w.y = pk2(h.z, h.w); o[64 * j] = w; }
    }
}

template <int NT>
__device__ __forceinline__ void p10_item(Frame& F, int tok0, int c8) {
    const Args& a = *F.a;
    const bf16_t* U = (const bf16_t*)(F.ws + WS_Z); bf16_t* FIN = (bf16_t*)(F.ws + WS_FIN);
    const int uc = 256 * (c8 >> 7) + (c8 & 127);
    const int t0 = (tok0 - NCTX) & 2047, y = t0 >> 6, x0 = t0 & 63;
    const float* cw = a.in[I_FCONV] + c8;
    u32x4 vraw[NT];
#pragma unroll
    for (int jj = 0; jj < NT; ++jj) vraw[jj] = *(const u32x4*)(U + (size_t)(tok0 + jj) * UPC + uc + 128);
    float acc[NT][8];
    { const f32x4 b0 = *(const f32x4*)(a.in[I_FCB] + c8), b1 = *(const f32x4*)(a.in[I_FCB] + c8 + 4);
#pragma unroll
        for (int jj = 0; jj < NT; ++jj) { acc[jj][0] = b0[0]; acc[jj][1] = b0[1]; acc[jj][2] = b0[2]; acc[jj][3] = b0[3]; acc[jj][4] = b1[0]; acc[jj][5] = b1[1]; acc[jj][6] = b1[2]; acc[jj][7] = b1[3]; } }
#pragma unroll 1
    for (int dy = -1; dy <= 1; ++dy) {
        const bool rowok = y + dy >= 0 && y + dy < 32;
        if (!rowok) continue;
        float wt[3][8];
#pragma unroll
        for (int dx = 0; dx < 3; ++dx) { const f32x4 w0 = *(const f32x4*)(cw + ((dy + 1) * 3 + dx) * DFF), w1 = *(const f32x4*)(cw + ((dy + 1) * 3 + dx) * DFF + 4);
#pragma unroll
            for (int e = 0; e < 4; ++e) { wt[dx][e] = w0[e]; wt[dx][4 + e] = w1[e]; } }
#pragma unroll
        for (int i = 0; i < NT + 2; ++i) { const int xx = x0 - 1 + i; const bool ok = xx >= 0 && xx < 64;
            float xv[8]; unpack8(*(const u32x4*)(U + ((long)(tok0 + dy * 64) + (i - 1)) * UPC + uc), xv);
            const float cm = ok ? 1.f : 0.f;
#pragma unroll
            for (int dx = -1; dx <= 1; ++dx) { const int jj = i - 1 - dx;
                if (jj >= 0 && jj < NT) {
#pragma unroll
                    for (int e = 0; e < 8; ++e) acc[jj][e] += (wt[dx + 1][e] * cm) * xv[e]; } }
        }
    }
#pragma unroll
    for (int jj = 0; jj < NT; ++jj) { float x[8]; unpack8(vraw[jj], x);
        u32x4 o; o.x = cvt_pk(silu(acc[jj][0]) * x[0], silu(acc[jj][1]) * x[1]); o.y = cvt_pk(silu(acc[jj][2]) * x[2], silu(acc[jj][3]) * x[3]);
        o.z = cvt_pk(silu(acc[jj][4]) * x[4], silu(acc[jj][5]) * x[5]); o.w = cvt_pk(silu(acc[jj][6]) * x[6], silu(acc[jj][7]) * x[7]);
        *(u32x4*)(FIN + (size_t)(tok0 + jj) * DFF + c8) = o; }
}
__device__ __forceinline__ void p10_ffn_conv(Frame& F) {
    const int t = (int)blockIdx.x * 512 + F.tid;
    { const int sl = t / 352, c8 = (t - sl * 352) * 8; p10_item<8>(F, NCTX + sl * 8, c8); }
    asm volatile("" ::: "memory"); __builtin_amdgcn_sched_barrier(0);
    if (t < 98304) { const int it = 131072 + (t >> 1), sl = it / 352, c8 = (it - sl * 352) * 8; p10_item<4>(F, NCTX + sl * 8 + 4 * (t & 1), c8); }
}

__device__ __forceinline__ void p12_final(Frame& F) {
    const Args& a = *F.a; const float* ng = a.in[I_NORMG];
    for (int row = F.gw; row < NTOK; row += F.NGW) {
        const u32x2* fr_ = (const u32x2*)((const bf16_t*)(F.ws + WS_Z) + (size_t)row * D) + F.lane; f32x4* xo = (f32x4*)(F.out + (size_t)row * D) + F.lane;
        const float* mod = (const float*)(F.ws + WS_MOD) + cond_of(row) * 6144;
        f32x4 v[4]; float ss = 0.f;
#pragma unroll
        for (int j = 0; j < 4; ++j) { const u32x2 p0 = fr_[64 * j], p1 = fr_[64 * j + (size_t)NTOK * D / 4];
            v[j] = (f32x4){bf2f(p0.x & 0xffffu) + bf2f(p1.x & 0xffffu), bf2f(p0.x >> 16) + bf2f(p1.x >> 16), bf2f(p0.y & 0xffffu) + bf2f(p1.y & 0xffffu), bf2f(p0.y >> 16) + bf2f(p1.y >> 16)}; ss += (v[j].x * v[j].x + v[j].y * v[j].y) + (v[j].z * v[j].z + v[j].w * v[j].w); }
        const float rstd = rsqrtf(wave_sum(ss) * (1.f / D) + 1e-6f);
#pragma unroll
        for (int j = 0; j < 4; ++j) { const int col = 4 * (64 * j + F.lane);
            const f32x4 g = *(const f32x4*)(ng + 3072 + col), g2 = *(const f32x4*)(mod + 5120 + col);
            const u32x2 xw = ((const u32x2*)((const bf16_t*)(F.ws + WS_X1B) + (size_t)row * D) + F.lane)[64 * j];
            const f32x4 x1 = {bf2f(xw.x & 0xffffu), bf2f(xw.x >> 16), bf2f(xw.y & 0xffffu), bf2f(xw.y >> 16)};
            xo[64 * j] = x1 + g2 * (v[j] * rstd * g); }
    }
}

__global__ void __launch_bounds__(512, 2) trunk_fwd(Args args) {
    extern __shared__ __attribute__((aligned(16))) unsigned char lds_raw[];
    Frame F;
    F.lds = (LAS unsigned char*)lds_raw; F.a = &args;
    F.tid = threadIdx.x; F.lane = F.tid & 63; F.wave = __builtin_amdgcn_readfirstlane(F.tid >> 6);
    F.G = gridDim.x; { const int bx = blockIdx.x; F.vcu = (F.G % 8 == 0) ? (bx % 8) * (F.G / 8) + bx / 8 : bx; }
    F.gw = F.vcu * 8 + F.wave; F.NGW = F.G * 8;
    F.ws = args.ws; F.out = args.out;
    volatile LAS unsigned* MISC = (volatile LAS unsigned*)(F.lds + MISC_OFF);
    if (F.tid < 64) MISC[F.tid] = 0u;
    __syncthreads();
    XcdBarrier bar = xcd_barrier_post((unsigned*)(F.ws + WS_CTL) + 4096, MISC + 8);
#ifndef PROBE_MASK
#define PROBE_MASK 0
#endif
#define RELANE() do { int t_ = threadIdx.x; asm volatile("" : "+v"(t_)); F.tid = t_; F.lane = t_ & 63; } while (0)
#define PH(k, ...) do { { RELANE(); __VA_ARGS__ } if (((PROBE_MASK) >> (k)) & 1) { xcd_barrier(bar); { RELANE(); __VA_ARGS__ } } if ((k) != NPH - 1) xcd_barrier(bar); } while (0)
    PH(0, p0_prologue(F);
        if (F.tid == 0) { unsigned sp = 0; unsigned* cnt = (unsigned*)(F.ws + WS_CTL) + 1024;
            while (__hip_atomic_load(cnt, __ATOMIC_RELAXED, __HIP_MEMORY_SCOPE_AGENT) < 96u) { __builtin_amdgcn_s_sleep(2); if (++sp > (1u << 22)) break; }
            __builtin_amdgcn_fence(__ATOMIC_ACQUIRE, "agent"); asm volatile("s_waitcnt vmcnt(0)" ::: "memory"); }
        __syncthreads();
        p1_h1(F););
    PH(1, const pg8::Gemm g{D, D, D}; pg8::StaticOrder S; S.init(NTOK, ZC, 1, F.G, (int)blockIdx.x, g, (const bf16_t*)(F.ws + WS_H), (const bf16_t*)(F.ws + WS_WIN), nullptr, nullptr);
        pg8::EpiBf16 E{(bf16_t*)(F.ws + WS_Z1), Z1C, (bf16_t*)(F.ws + WS_Z2), 12}; pg8::gemm_phase(F.lds, g, S, E, F.tid););
#ifndef PROBE_XBAR
#define PROBE_XBAR 0
#endif
    for (int xb_ = 0; xb_ < PROBE_XBAR; ++xb_) xcd_barrier(bar);
    PH(2, p3_prep(F););
#ifndef PROBE_P3
#define PROBE_P3 0
#endif
    if (PROBE_P3) { RELANE(); p3_prep<(PROBE_P3 ? PROBE_P3 : 7)>(F); xcd_barrier(bar); }
    PH(3, mlstm_passA(F, (int)blockIdx.x); __syncthreads(); { const int u = (int)blockIdx.x * 8 + F.wave; rwkv_pass1(F, u); });
#ifndef PROBE_P1
#define PROBE_P1 (-1)
#endif
    if (PROBE_P1 >= 0) { RELANE(); const int u = (int)blockIdx.x * 8 + F.wave; rwkv_pass1<(PROBE_P1 < 0 ? 0 : PROBE_P1)>(F, u); xcd_barrier(bar); }
    PH(4, const int bi = blockIdx.x;
        if (bi < 128) { const int u = bi >> 3; mlstm_prop_t<4, 16, 8>(F, 16 + (u >> 3), (u >> 2) & 1, u & 3, bi & 7); rwkv_prop_lat(F, (((bi & 7) * 4 + (bi >> 5)) << 2) | ((bi >> 3) & 3)); }
        else { const int v = bi - 128; mlstm_prop_t<32, 2, 2>(F, v >> 3, (v >> 2) & 1, v & 3, 0); rwkv_prop(F, 128 + v * 8 + F.wave); });
    PH(5, { mlstm_passC3(F, (int)blockIdx.x); rwkv_fix(F, (int)blockIdx.x * 8 + F.wave); });
    PH(6, const pg8::Gemm g{512, 512, 512}; pg8::StaticOrder S;
        S.init(NTOK, D, 2, F.G, (int)blockIdx.x, g, (const bf16_t*)(F.ws + WS_YRB), (const bf16_t*)(F.ws + WS_WBR), (const bf16_t*)(F.ws + WS_YMB), (const bf16_t*)(F.ws + WS_WBM));
        pg8::EpiGate E{(bf16_t*)(F.ws + WS_PRM), (const bf16_t*)(F.ws + WS_Z2), Z2_GR}; pg8::gemm_phase(F.lds, g, S, E, F.tid););
    PH(7, const pg8::Gemm g{D, D, D}; pg8::StaticOrder S;
        S.init(NTOK, D, 2, F.G, (int)blockIdx.x, g, (const bf16_t*)(F.ws + WS_PRM), (const bf16_t*)(F.ws + WS_WOUT), (const bf16_t*)(F.ws + WS_PRM) + (size_t)NTOK * D, (const bf16_t*)(F.ws + WS_WOUT));
        pg8::EpiBf16 E{(bf16_t*)(F.ws + WS_OUT1), D, (bf16_t*)(F.ws + WS_OUT1), 1 << 20}; pg8::gemm_phase(F.lds, g, S, E, F.tid););
    PH(8, p8_rows(F););
    PH(9, const pg8::Gemm g{D, D, D}; pg8::StaticOrder S; S.init(NTOK, UPC, 1, F.G, (int)blockIdx.x, g, (const bf16_t*)(F.ws + WS_H), (const bf16_t*)(F.ws + WS_WUP), nullptr, nullptr);
        pg8::EpiFfnUp E{(bf16_t*)(F.ws + WS_Z), (bf16_t*)(F.ws + WS_FIN), F.a->in[I_FCONV], F.a->in[I_FCB], (LAS float*)(F.lds + 131072)}; pg8::gemm_phase(F.lds, g, S, E, F.tid);
        if (blockIdx.x >= 192) { LAS float* scr = (LAS float*)(F.lds + F.wave * 8448);
            for (int it = ((int)blockIdx.x - 192) * 8 + F.wave; it < 44 * 32; it += 512) transpose_item(0, F.a->in[I_FDN], 2816, 1024, (bf16_t*)(F.ws + WS_WDN), 32, scr, it, F.lane); });
    PH(10, p10_ffn_conv(F););
    PH(11, const pg8::Gemm g{DFF / 2, DFF, DFF}; pg8::StaticOrder S;
        S.init(NTOK, D, 2, F.G, (int)blockIdx.x, g, (const bf16_t*)(F.ws + WS_FIN), (const bf16_t*)(F.ws + WS_WDN), (const bf16_t*)(F.ws + WS_FIN) + DFF / 2, (const bf16_t*)(F.ws + WS_WDN) + DFF / 2);
        pg8::EpiBf16 E{(bf16_t*)(F.ws + WS_Z), D, (bf16_t*)(F.ws + WS_Z), 1 << 20}; pg8::gemm_phase(F.lds, g, S, E, F.tid););
    PH(12, p12_final(F););
#undef PH
}

extern "C" void kernel_launch(void* const* d_in, const int* in_sizes, int n_in, void* d_out, int out_size, void* d_ws, size_t ws_size, hipStream_t stream) {
    if (n_in != 33 || (size_t)out_size != OUT_TOTAL || ws_size < WS_END) {
        fprintf(stderr, "kernel_launch: unexpected problem (n_in %d, out %d, ws %zu)\n", n_in, out_size, ws_size); return; }
    (void)hipFuncSetAttribute((const void*)trunk_fwd, hipFuncAttributeMaxDynamicSharedMemorySize, LDS_BYTES);
    (void)hipMemsetAsync((char*)d_ws + WS_CTL, 0, CTL_ZERO_BYTES, stream);
    Args a{};
    for (int i = 0; i < 33; ++i) a.in[i] = (const float*)d_in[i];
    a.out = (float*)d_out; a.ws = (unsigned char*)d_ws;
    a.ph_lo = 0; a.ph_hi = NPH;
    hipLaunchKernelGGL(trunk_fwd, dim3(256), dim3(512), LDS_BYTES, stream, a);
}
```
